# Optimizing an MI355X kernel written in HIP

```python
import math
import jax, jax.numpy as jnp
from jax import lax
import numpy as np

D_MODEL = 2048
BATCH = 2
SEQ = 4096
DEPTH = 4

HEAD_DIM = 128
N_SB_HEADS = 8
N_DIFF_HEADS = 4
SB_WIDTH = N_SB_HEADS * HEAD_DIM
DIFF_QK_WIDTH = N_DIFF_HEADS * 2 * HEAD_DIM
DIFF_V_WIDTH = N_DIFF_HEADS * 2 * HEAD_DIM
D_MIX = SB_WIDTH + DIFF_V_WIDTH
D_IN = 3 * SB_WIDTH + 2 * DIFF_QK_WIDTH + DIFF_V_WIDTH
D_FF = 5632
Q_BLOCK = 128
ROPE_THETA = 10000.0
RMS_EPS = 1e-6
FFN_RESIDUAL_WEIGHT = 0.5

kernel_name = "hymba_stickbreak_diffattn_macaron"


def rmsnorm(x, g):
    xf = x.astype(jnp.float32)
    y = xf * lax.rsqrt(jnp.mean(xf * xf, axis=-1, keepdims=True) + RMS_EPS)
    return (y * g.astype(jnp.float32)).astype(x.dtype)


def swiglu(x, w_gate, w_up, w_down):
    return (jax.nn.silu(x @ w_gate) * (x @ w_up)) @ w_down


def rope_tables(seq):
    pos = jnp.arange(seq, dtype=jnp.float32)
    inv_freq = ROPE_THETA ** (-jnp.arange(0, HEAD_DIM, 2, dtype=jnp.float32) / HEAD_DIM)
    ang = pos[:, None] * inv_freq[None, :]
    ang = jnp.concatenate([ang, ang], axis=-1)
    return jnp.cos(ang), jnp.sin(ang)


def apply_rope(x, cos, sin):
    xf = x.astype(jnp.float32)
    half = HEAD_DIM // 2
    rot = jnp.concatenate([-xf[..., half:], xf[..., :half]], axis=-1)
    return (xf * cos + rot * sin).astype(x.dtype)


def to_blocks(q):
    b, h, s, d = q.shape
    return q.reshape(b, h, s // Q_BLOCK, Q_BLOCK, d).transpose(2, 0, 1, 3, 4)


def from_blocks(o):
    nb, b, h, qb, d = o.shape
    return o.transpose(1, 0, 3, 2, 4).reshape(b, nb * qb, h * d)


def stick_breaking_attention(q, k, v):
    seq = q.shape[2]
    scale = 1.0 / math.sqrt(HEAD_DIM)
    key_pos = jnp.arange(seq)

    def block(args):
        qb, i = args
        q_pos = i * Q_BLOCK + jnp.arange(Q_BLOCK)
        mask = key_pos[None, :] < q_pos[:, None]
        z = jnp.einsum('bhqd,bhkd->bhqk', qb, k).astype(jnp.float32) * scale
        log_beta = jax.nn.log_sigmoid(z)
        log_one_minus = jnp.where(mask, jax.nn.log_sigmoid(-z), 0.0)
        key_axis = log_one_minus.ndim - 1
        tail = lax.cumsum(log_one_minus, axis=key_axis, reverse=True) - log_one_minus
        w = jnp.where(mask, jnp.exp(log_beta + tail), 0.0)
        return jnp.einsum('bhqk,bhkd->bhqd', w.astype(v.dtype), v)

    nb = seq // Q_BLOCK
    out = lax.map(block, (to_blocks(q), jnp.arange(nb)))
    return from_blocks(out)


def differential_attention(q1, q2, k1, k2, v, lam):
    seq = q1.shape[2]
    scale = 1.0 / math.sqrt(HEAD_DIM)
    key_pos = jnp.arange(seq)

    def block(args):
        q1b, q2b, i = args
        q_pos = i * Q_BLOCK + jnp.arange(Q_BLOCK)
        mask = key_pos[None, :] <= q_pos[:, None]

        def probs(qb, kk):
            z = jnp.einsum('bhqd,bhkd->bhqk', qb, kk).astype(jnp.float32) * scale
            z = jnp.where(mask, z, -jnp.inf)
            return jax.nn.softmax(z, axis=-1)

        a = probs(q1b, k1) - lam * probs(q2b, k2)
        return jnp.einsum('bhqk,bhkd->bhqd', a.astype(v.dtype), v)

    nb = seq // Q_BLOCK
    out = lax.map(block, (to_blocks(q1), to_blocks(q2), jnp.arange(nb)))
    return out


def mixing_sublayer(h, w_in, lambda_q1, lambda_k1, lambda_q2, lambda_k2, subln, w_out,
                    cos, sin, lambda_init):
    b, s, _ = h.shape
    proj = h @ w_in
    splits = [int(c) for c in np.cumsum([SB_WIDTH, SB_WIDTH, SB_WIDTH, DIFF_QK_WIDTH, DIFF_QK_WIDTH])]
    sb_q, sb_k, sb_v, d_q, d_k, d_v = jnp.split(proj, splits, axis=-1)

    def heads(t, n, d):
        return t.reshape(b, s, n, d).transpose(0, 2, 1, 3)

    sb_out = stick_breaking_attention(heads(sb_q, N_SB_HEADS, HEAD_DIM),
                                      heads(sb_k, N_SB_HEADS, HEAD_DIM),
                                      heads(sb_v, N_SB_HEADS, HEAD_DIM))

    dq = d_q.reshape(b, s, N_DIFF_HEADS, 2, HEAD_DIM).transpose(3, 0, 2, 1, 4)
    dk = d_k.reshape(b, s, N_DIFF_HEADS, 2, HEAD_DIM).transpose(3, 0, 2, 1, 4)
    dv = heads(d_v, N_DIFF_HEADS, 2 * HEAD_DIM)
    q1, q2 = apply_rope(dq[0], cos, sin), apply_rope(dq[1], cos, sin)
    k1, k2 = apply_rope(dk[0], cos, sin), apply_rope(dk[1], cos, sin)
    lam = (jnp.exp(jnp.sum(lambda_q1.astype(jnp.float32) * lambda_k1.astype(jnp.float32)))
           - jnp.exp(jnp.sum(lambda_q2.astype(jnp.float32) * lambda_k2.astype(jnp.float32)))
           + lambda_init)
    d_heads = differential_attention(q1, q2, k1, k2, dv, lam)
    d_heads = rmsnorm(d_heads, subln) * (1.0 - lambda_init)
    diff_out = from_blocks(d_heads)

    mixed = jnp.concatenate([sb_out, diff_out], axis=-1)
    return mixed @ w_out


def setup_inputs(seed: int = 0) -> dict:
    key = jax.random.key(seed)
    ks = jax.random.split(key, 20)
    f32 = jnp.float32

    def normal(k, shape, scale):
        return jax.random.normal(k, shape, f32) * scale

    def gain(k, shape):
        return 1.0 + 0.01 * jax.random.normal(k, shape, f32)

    return {
        "x": normal(ks[0], (BATCH, SEQ, D_MODEL), 1.0),
        "norm_ffn1": gain(ks[1], (DEPTH, D_MODEL)),
        "w_ffn1_gate": normal(ks[2], (DEPTH, D_MODEL, D_FF), D_MODEL ** -0.5),
        "w_ffn1_up": normal(ks[3], (DEPTH, D_MODEL, D_FF), D_MODEL ** -0.5),
        "w_ffn1_down": normal(ks[4], (DEPTH, D_FF, D_MODEL), D_FF ** -0.5),
        "norm_mix": gain(ks[5], (DEPTH, D_MODEL)),
        "w_in": normal(ks[6], (DEPTH, D_MODEL, D_IN), D_MODEL ** -0.5),
        "lambda_q1": normal(ks[7], (DEPTH, HEAD_DIM), 0.1),
        "lambda_k1": normal(ks[8], (DEPTH, HEAD_DIM), 0.1),
        "lambda_q2": normal(ks[9], (DEPTH, HEAD_DIM), 0.1),
        "lambda_k2": normal(ks[10], (DEPTH, HEAD_DIM), 0.1),
        "diff_subln": gain(ks[11], (DEPTH, 2 * HEAD_DIM)),
        "w_out": normal(ks[12], (DEPTH, D_MIX, D_MODEL), D_MIX ** -0.5),
        "norm_ffn2": gain(ks[13], (DEPTH, D_MODEL)),
        "w_ffn2_gate": normal(ks[14], (DEPTH, D_MODEL, D_FF), D_MODEL ** -0.5),
        "w_ffn2_up": normal(ks[15], (DEPTH, D_MODEL, D_FF), D_MODEL ** -0.5),
        "w_ffn2_down": normal(ks[16], (DEPTH, D_FF, D_MODEL), D_FF ** -0.5),
        "norm_final": gain(ks[17], (D_MODEL,)),
    }


def reference(x, norm_ffn1, w_ffn1_gate, w_ffn1_up, w_ffn1_down, norm_mix, w_in,
              lambda_q1, lambda_k1, lambda_q2, lambda_k2, diff_subln, w_out,
              norm_ffn2, w_ffn2_gate, w_ffn2_up, w_ffn2_down, norm_final):
    cos, sin = rope_tables(x.shape[1])
    for layer in range(DEPTH):
        lambda_init = 0.8 - 0.6 * math.exp(-0.3 * layer)
        h = rmsnorm(x, norm_ffn1[layer])
        x = x + FFN_RESIDUAL_WEIGHT * swiglu(h, w_ffn1_gate[layer], w_ffn1_up[layer], w_ffn1_down[layer])
        h = rmsnorm(x, norm_mix[layer])
        x = x + mixing_sublayer(h, w_in[layer], lambda_q1[layer], lambda_k1[layer],
                                lambda_q2[layer], lambda_k2[layer], diff_subln[layer],
                                w_out[layer], cos, sin, lambda_init)
        h = rmsnorm(x, norm_ffn2[layer])
        x = x + FFN_RESIDUAL_WEIGHT * swiglu(h, w_ffn2_gate[layer], w_ffn2_up[layer], w_ffn2_down[layer])
    return rmsnorm(x, norm_final)
```

```cpp
#include <hip/hip_bf16.h>
#include <cmath>
#include <hip/hip_runtime.h>
#include <cstdio>
#include <cstdint>
namespace pg8 {
#define PG8_LAS __attribute__((address_space(3)))
typedef unsigned short bf16_t;
typedef short bf16x8 __attribute__((ext_vector_type(8)));
typedef float f32x4 __attribute__((ext_vector_type(4)));
typedef unsigned u32x4 __attribute__((ext_vector_type(4)));
constexpr int BM = 256, BK = 64, HALF = 128, HTB = HALF * BK * 2  , STAGE_BYTES = 8 * HTB, NXCD = 8, WGM = 8;

__host__ __device__ __forceinline__ int lds_byte(int r, int c) { const int st = (r >> 4) * 2 + (c >> 5), rr = r & 15, cc = c & 31, ob = rr * 64 + cc * 2; return st * 1024 + (ob ^ (((ob >> 9) & 1) << 5)); }
__host__ __device__ __forceinline__ void stage_rc(int b, int& R, int& C) { const int st = b / 1024, sb = b % 1024, swz = sb ^ (((sb >> 9) & 1) << 5); R = (st >> 1) * 16 + swz / 64; C = (st & 1) * 32 + (swz % 64) / 2; }
__host__ __device__ __forceinline__ int perm32(int rho) { const int n = rho >> 4, i = rho & 15; return 8 * (i >> 2) + 4 * n + (i & 3); }

struct Unit { int pm, pn; };
struct Gemm { const bf16_t* A; const bf16_t* Bt; int M, N, K; };

struct StaticOrder {
    int nM, nN, nwg, G, c;
    __host__ __device__ void init(int M, int N, int G_, int c_) { nM = M / BM; nN = N / BM; nwg = nM * nN; G = G_; c = c_; }
    __host__ __device__ bool next(int i, Unit& u) const {
        const long L = (long)i * G + c; if (L >= nwg) return false;
        int wgid = (int)L; { const int q = nwg / NXCD, r = nwg % NXCD, xcd = wgid % NXCD, off = wgid / NXCD; wgid = (xcd < r ? xcd * (q + 1) : r * (q + 1) + (xcd - r) * q) + off; }
        const int nig = WGM * nN, gid = wgid / nig, fm = gid * WGM, gsz = (nM - fm) < WGM ? (nM - fm) : WGM;
        u.pm = fm + ((wgid % nig) % gsz); u.pn = (wgid % nig) / gsz; return true;
    }
    __device__ __forceinline__ void a_ready(const Unit&) const {}
    __device__ __forceinline__ void done(const Unit&) const {}
};

__device__ __forceinline__ unsigned cvt_pk_bf16(float lo, float hi) { unsigned r; asm volatile("v_cvt_pk_bf16_f32 %0, %1, %2" : "=v"(r) : "v"(lo), "v"(hi)); return r; }
typedef float f32x2 __attribute__((ext_vector_type(2)));
constexpr int DM_ = 2048, FF_ = 5632, DIN_ = 6144, SEQ_ = 4096;
constexpr float RMS_EPS_ = 1e-6f;
__device__ __forceinline__ float row_rstd(const float* ssq, int row) {
    const f32x4 a = *(const f32x4*)(ssq + (size_t)row * 8), b = *(const f32x4*)(ssq + (size_t)row * 8 + 4);
    const float s = ((a[0] + a[1]) + (a[2] + a[3])) + ((b[0] + b[1]) + (b[2] + b[3]));
    return 1.0f / sqrtf(s * (1.0f / DM_) + RMS_EPS_);
}
struct EpiSwiGLU {
    static constexpr bool PERM = true, AFTER_DRAIN = false;
    bf16_t* H; const float* ssq;
    __device__ __forceinline__ void operator()(const f32x4 (&acc)[2][2][4][2], const Unit& u, int wr, int wc, int fr, int fq) const {
        const int row0 = u.pm * BM + wr * 64 + fr, col0 = u.pn * HALF + wc * 32 + 8 * fq;
#pragma unroll
        for (int ai = 0; ai < 2; ++ai)
#pragma unroll
            for (int m = 0; m < 4; ++m) { const int row = row0 + ai * HALF + m * 16; const float rs = row_rstd(ssq, row);
                float h[8];
#pragma unroll
                for (int n = 0; n < 2; ++n)
#pragma unroll
                    for (int j = 0; j < 4; ++j) { const float g = acc[ai][0][m][n][j] * rs, up = acc[ai][1][m][n][j] * rs;
                        const float e = __builtin_amdgcn_exp2f(g * -1.4426950408889634f);
                        h[n * 4 + j] = g * __builtin_amdgcn_rcpf(1.0f + e) * up; }
                u32x4 w; w.x = cvt_pk_bf16(h[0], h[1]); w.y = cvt_pk_bf16(h[2], h[3]); w.z = cvt_pk_bf16(h[4], h[5]); w.w = cvt_pk_bf16(h[6], h[7]);
                *(u32x4*)(H + (size_t)row * FF_ + col0) = w; }
    }
};
struct EpiQKV {
    static constexpr bool PERM = true, AFTER_DRAIN = false;
    bf16_t* QKV; const float* ssq; const float* rope; float qscale;
    __device__ __forceinline__ void operator()(const f32x4 (&acc)[2][2][4][2], const Unit& u, int wr, int wc, int fr, int fq) const {
        typedef unsigned u32x2 __attribute__((ext_vector_type(2)));
        const int sec = u.pn >> 2; const bool rp = (sec == 3) || (sec == 4); const float qs = (sec == 0) ? qscale : 1.0f;
        const int row0 = u.pm * BM + wr * 64 + fr, i0 = 16 * wc + 4 * fq;
#pragma unroll
        for (int ai = 0; ai < 2; ++ai)
#pragma unroll
            for (int m = 0; m < 4; ++m) { const int row = row0 + ai * HALF + m * 16; const float rs = row_rstd(ssq, row) * qs; const int pos = row & (SEQ_ - 1);
                f32x4 cs = (f32x4){1.f, 1.f, 1.f, 1.f}, sn = (f32x4){0.f, 0.f, 0.f, 0.f};
                if (rp) { cs = *(const f32x4*)(rope + (size_t)pos * 64 + i0); sn = *(const f32x4*)(rope + (size_t)SEQ_ * 64 + (size_t)pos * 64 + i0); }
#pragma unroll
                for (int bj = 0; bj < 2; ++bj) { const f32x4 lo = acc[ai][bj][m][0] * rs, hi = acc[ai][bj][m][1] * rs;
                    const f32x4 nlo = lo * cs - hi * sn, nhi = hi * cs + lo * sn;
                    bf16_t* p = QKV + (size_t)row * DIN_ + u.pn * BM + bj * HALF + i0;
                    u32x2 a, b; a.x = cvt_pk_bf16(nlo[0], nlo[1]); a.y = cvt_pk_bf16(nlo[2], nlo[3]); b.x = cvt_pk_bf16(nhi[0], nhi[1]); b.y = cvt_pk_bf16(nhi[2], nhi[3]);
                    *(u32x2*)p = a; *(u32x2*)(p + 64) = b; } }
    }
};
struct EpiResid {
    static constexpr bool PERM = false, AFTER_DRAIN = true;
    const float* base; float* X; bf16_t* XB; float* ssq; float alpha;
    __device__ __forceinline__ void fused(f32x4 (&acc)[2][2][4][2], const Unit& u, int wr, int wc, int fr, int fq, PG8_LAS unsigned char* lds, int wid, int lane) const {
        typedef unsigned u32x2 __attribute__((ext_vector_type(2)));
        PG8_LAS float* P = (PG8_LAS float*)lds;
        const int col0 = u.pn * BM + wc * 32 + 4 * fq;
#pragma unroll
        for (int ai = 0; ai < 2; ++ai)
#pragma unroll
            for (int m = 0; m < 4; ++m) { const int r = ai * HALF + wr * 64 + m * 16 + fr; const size_t off = (size_t)(u.pm * BM + r) * DM_ + col0; float s = 0.f;
#pragma unroll
                for (int bj = 0; bj < 2; ++bj)
#pragma unroll
                    for (int n = 0; n < 2; ++n) { const f32x4 bs = *(const f32x4*)(base + off + bj * HALF + n * 16); const f32x4 v = bs + acc[ai][bj][m][n] * alpha;
                        *(f32x4*)(X + off + bj * HALF + n * 16) = v; u32x2 w; w.x = cvt_pk_bf16(v[0], v[1]); w.y = cvt_pk_bf16(v[2], v[3]); *(u32x2*)(XB + off + bj * HALF + n * 16) = w;
                        s += (v[0] * v[0] + v[1] * v[1]) + (v[2] * v[2] + v[3] * v[3]); }
                s += __shfl_xor(s, 16); s += __shfl_xor(s, 32);
                if (fq == 0) P[r * 4 + wc] = s;
                if (m & 1) asm volatile("" ::: "memory"); }
        asm volatile("s_waitcnt lgkmcnt(0)" ::: "memory"); __builtin_amdgcn_s_barrier(); asm volatile("" ::: "memory");
        const int t = wid * 64 + lane;
        if (t < 256) { const f32x4 p = *(const PG8_LAS f32x4*)(P + t * 4); ssq[(size_t)(u.pm * BM + t) * 8 + u.pn] = (p[0] + p[1]) + (p[2] + p[3]); }
        asm volatile("s_waitcnt lgkmcnt(0)" ::: "memory"); __builtin_amdgcn_s_barrier(); asm volatile("" ::: "memory");
    }
};

template <class Epi, class Sched, bool ALIGN_EPI = false, bool SP2 = false>
__device__ __forceinline__ void gemm_phase(PG8_LAS unsigned char* lds, const Gemm g, const Sched& S, const Epi& E) {
    int tid_ = threadIdx.x; asm volatile("" : "+v"(tid_));
    const int tid = tid_, wid = __builtin_amdgcn_readfirstlane(tid >> 6), lane = tid & 63, wr = wid >> 2, wc = wid & 3, fr = lane & 15, fq = lane >> 4;
    const int K = g.K, nt = K / BK;
    unsigned voffA[2], voffB[2];
#pragma unroll
    for (int i = 0; i < 2; ++i) { int R, C; stage_rc(tid * 16 + i * 8192, R, C); const int Rb = Epi::PERM ? ((R & ~31) + perm32(R & 31)) : R;
        voffA[i] = (unsigned)(R * K + C) * 2u; voffB[i] = (unsigned)(Rb * K + C) * 2u; }
    const size_t kstep = (size_t)(BK * 2);
    const size_t hstep = (size_t)HALF * K * 2;
    const size_t tstep = 2 * hstep;
    const unsigned ldsw = (unsigned)wid * 1024u;
    const int aoff = lds_byte(wr * 64 + fr, fq * 8), boff = lds_byte(wc * 32 + fr, fq * 8);
#define PG8_SA(b, h) (((b) * 2 + (h)) * HTB)
#define PG8_SB(b, h) ((4 + (b) * 2 + (h)) * HTB)
#define PG8_STAGE(bufoff, gbase, voff) do { _Pragma("unroll") for (int _i = 0; _i < 2; ++_i) \
        __builtin_amdgcn_global_load_lds((const unsigned*)((const char*)(gbase) + (voff)[_i]), (PG8_LAS unsigned*)(lds + (bufoff) + ldsw + _i * 8192), 16, 0, 0); } while (0)
#define PG8_LDA(dst, b, h) do { _Pragma("unroll") for (int m = 0; m < 4; ++m) _Pragma("unroll") for (int k = 0; k < 2; ++k) dst[m][k] = *(const PG8_LAS bf16x8*)(lds + PG8_SA(b, h) + aoff + m * 2048 + k * 1024); } while (0)
#define PG8_LDB(dst, b, h) do { _Pragma("unroll") for (int n = 0; n < 2; ++n) _Pragma("unroll") for (int k = 0; k < 2; ++k) dst[n][k] = *(const PG8_LAS bf16x8*)(lds + PG8_SB(b, h) + boff + n * 2048 + k * 1024); } while (0)
#define PG8_MMA(ai, bj, At, Bt) do { __builtin_amdgcn_s_setprio(1); _Pragma("unroll") for (int m = 0; m < 4; ++m) _Pragma("unroll") for (int n = 0; n < 2; ++n) _Pragma("unroll") for (int k = 0; k < 2; ++k) \
        acc[ai][bj][m][n] = __builtin_amdgcn_mfma_f32_16x16x32_bf16(Bt[n][k], At[m][k], acc[ai][bj][m][n], 0, 0, 0); __builtin_amdgcn_s_setprio(0); } while (0)
#define PG8_WAIT_V(n) asm volatile("s_waitcnt vmcnt(" #n ")" ::: "memory")
#define PG8_WAIT_L(n) asm volatile("s_waitcnt lgkmcnt(" #n ")" ::: "memory")
#define PG8_BAR __builtin_amdgcn_s_barrier()
#define PG8_SCHED __builtin_amdgcn_sched_barrier(0)
    Unit cur, nxt; int ui = 0;
    if (!S.next(0, cur)) return;
    f32x4 acc[2][2][4][2];
#pragma unroll
    for (int a = 0; a < 2; ++a)
#pragma unroll
        for (int b = 0; b < 2; ++b)
#pragma unroll
            for (int m = 0; m < 4; ++m)
#pragma unroll
                for (int n = 0; n < 2; ++n) acc[a][b][m][n] = (f32x4){0.f, 0.f, 0.f, 0.f};
    bf16x8 At[4][2], B0[2][2], B1[2][2];
    const char* cA = (const char*)g.A + (size_t)cur.pm * tstep; const char* cB = (const char*)g.Bt + (size_t)cur.pn * tstep;
    S.a_ready(cur);
    if constexpr (SP2) {
        PG8_STAGE(PG8_SB(0, 0), cB, voffB); PG8_STAGE(PG8_SB(0, 1), cB + hstep, voffB); PG8_STAGE(PG8_SA(0, 0), cA, voffA); PG8_STAGE(PG8_SA(0, 1), cA + hstep, voffA);
        if (wr == 1) PG8_BAR;
        PG8_WAIT_V(2); PG8_BAR;
        PG8_STAGE(PG8_SB(1, 0), cB + kstep, voffB); PG8_STAGE(PG8_SA(1, 0), cA + kstep, voffA); PG8_STAGE(PG8_SB(1, 1), cB + hstep + kstep, voffB);
        PG8_WAIT_V(6); PG8_BAR;
    } else {
        PG8_STAGE(PG8_SB(0, 0), cB, voffB); PG8_STAGE(PG8_SA(0, 0), cA, voffA); PG8_STAGE(PG8_SB(0, 1), cB + hstep, voffB); PG8_STAGE(PG8_SA(0, 1), cA + hstep, voffA);
        if (wr == 1) PG8_BAR;
        PG8_WAIT_V(4); PG8_BAR;
        PG8_STAGE(PG8_SB(1, 0), cB + kstep, voffB); PG8_STAGE(PG8_SA(1, 0), cA + kstep, voffA); PG8_STAGE(PG8_SB(1, 1), cB + hstep + kstep, voffB);
        PG8_WAIT_V(6); PG8_BAR;
    }
    for (;;) {
        const bool has_next = S.next(ui + 1, nxt);
        const char* nA = has_next ? (const char*)g.A + (size_t)nxt.pm * tstep : cA; const char* nB = has_next ? (const char*)g.Bt + (size_t)nxt.pn * tstep : cB;
        for (int t = 0; t < nt; t += 2) {
            const bool last = (t == nt - 2);
            const char* a1 = cA + (size_t)(t + 1) * kstep;
            const char* a2 = last ? nA : cA + (size_t)(t + 2) * kstep; const char* b2 = last ? nB : cB + (size_t)(t + 2) * kstep;
            const char* a3 = a2 + kstep; const char* b3 = b2 + kstep;
            if (last && has_next) S.a_ready(nxt);
            if constexpr (SP2) {
            PG8_LDB(B0, 0, 0); PG8_LDB(B1, 0, 1); PG8_SCHED; PG8_LDA(At, 0, 0); PG8_STAGE(PG8_SA(1, 1), a1 + hstep, voffA);
            PG8_WAIT_V(8); PG8_WAIT_L(0); PG8_BAR; PG8_MMA(0, 0, At, B0); PG8_MMA(0, 1, At, B1); PG8_BAR; PG8_SCHED;
            PG8_LDA(At, 0, 1); PG8_STAGE(PG8_SB(0, 0), b2, voffB); PG8_STAGE(PG8_SB(0, 1), b2 + hstep, voffB); PG8_STAGE(PG8_SA(0, 0), a2, voffA);
            PG8_WAIT_V(8); PG8_WAIT_L(0); PG8_BAR; PG8_MMA(1, 0, At, B0); PG8_MMA(1, 1, At, B1); PG8_BAR; PG8_SCHED;
            PG8_LDB(B0, 1, 0); PG8_LDB(B1, 1, 1); PG8_SCHED; PG8_LDA(At, 1, 0); PG8_STAGE(PG8_SA(0, 1), a2 + hstep, voffA);
            PG8_WAIT_V(8); PG8_WAIT_L(0); PG8_BAR; PG8_MMA(0, 0, At, B0); PG8_MMA(0, 1, At, B1); PG8_BAR; PG8_SCHED;
            PG8_LDA(At, 1, 1); PG8_STAGE(PG8_SB(1, 0), b3, voffB); PG8_STAGE(PG8_SB(1, 1), b3 + hstep, voffB); PG8_STAGE(PG8_SA(1, 0), a3, voffA);
            PG8_WAIT_V(8); PG8_WAIT_L(0); PG8_BAR; PG8_MMA(1, 0, At, B0); PG8_MMA(1, 1, At, B1); PG8_BAR; PG8_SCHED;
            } else {
            PG8_LDB(B0, 0, 0); PG8_SCHED; PG8_LDA(At, 0, 0); PG8_STAGE(PG8_SA(1, 1), a1 + hstep, voffA);
            PG8_WAIT_L(8); PG8_BAR; PG8_WAIT_L(0); PG8_MMA(0, 0, At, B0); PG8_BAR; PG8_SCHED;
            PG8_LDB(B1, 0, 1); PG8_STAGE(PG8_SB(0, 0), b2, voffB);
            PG8_BAR; PG8_WAIT_L(0); PG8_MMA(0, 1, At, B1); PG8_BAR;
            PG8_LDA(At, 0, 1); PG8_STAGE(PG8_SA(0, 0), a2, voffA);
            PG8_BAR; PG8_WAIT_L(0); PG8_MMA(1, 0, At, B0); PG8_BAR; PG8_SCHED;
            PG8_STAGE(PG8_SB(0, 1), b2 + hstep, voffB);
            PG8_WAIT_V(6); PG8_BAR; PG8_MMA(1, 1, At, B1); PG8_BAR;
            PG8_LDB(B0, 1, 0); PG8_SCHED; PG8_LDA(At, 1, 0); PG8_STAGE(PG8_SA(0, 1), a2 + hstep, voffA);
            PG8_WAIT_L(8); PG8_BAR; PG8_WAIT_L(0); PG8_MMA(0, 0, At, B0); PG8_BAR; PG8_SCHED;
            PG8_LDB(B1, 1, 1); PG8_STAGE(PG8_SB(1, 0), b3, voffB);
            PG8_BAR; PG8_WAIT_L(0); PG8_MMA(0, 1, At, B1); PG8_BAR;
            PG8_LDA(At, 1, 1); PG8_STAGE(PG8_SA(1, 0), a3, voffA);
            PG8_BAR; PG8_WAIT_L(0); PG8_MMA(1, 0, At, B0); PG8_BAR; PG8_SCHED;
            PG8_STAGE(PG8_SB(1, 1), b3 + hstep, voffB);
            PG8_WAIT_V(6); PG8_BAR; PG8_MMA(1, 1, At, B1); PG8_BAR;
            }
        }
        if constexpr (ALIGN_EPI) { if (wr == 0) PG8_BAR; }
        if constexpr (!Epi::AFTER_DRAIN) { E(acc, cur, wr, wc, fr, fq); S.done(cur); }
        if (!has_next) break;
#pragma unroll
        for (int a = 0; a < 2; ++a)
#pragma unroll
            for (int b = 0; b < 2; ++b)
#pragma unroll
                for (int m = 0; m < 4; ++m)
#pragma unroll
                    for (int n = 0; n < 2; ++n) acc[a][b][m][n] = (f32x4){0.f, 0.f, 0.f, 0.f};
        cur = nxt; cA = nA; cB = nB; ++ui;
        if constexpr (ALIGN_EPI) { if (wr == 1) PG8_BAR; }
    }
    PG8_WAIT_V(0);
    if constexpr (!ALIGN_EPI) { if (wr == 0) PG8_BAR; }
    PG8_BAR;
    if constexpr (Epi::AFTER_DRAIN) { E.fused(acc, cur, wr, wc, fr, fq, lds, wid, lane); S.done(cur); }
#undef PG8_SA
#undef PG8_SB
#undef PG8_STAGE
#undef PG8_LDA
#undef PG8_LDB
#undef PG8_MMA
#undef PG8_WAIT_V
#undef PG8_WAIT_L
#undef PG8_BAR
#undef PG8_SCHED
}
}
namespace dattn {
constexpr int D = 128;
constexpr int QP = 6144, KVP = 6144, OP = 1024;
constexpr float THR = 8.f;
constexpr bool WSKIP = false;
constexpr float SCALE = 0.08838834764831845f;
constexpr int NW = 8, QBLK = 32, KVBLK = 64, QB = NW * QBLK;
constexpr int SHM_V = KVBLK * D * 2, SHM_K = KVBLK * D * 2;
constexpr int LDS_BYTES = 2 * SHM_V + 2 * SHM_K + NW * 64 * 4;
using bf16 = __hip_bfloat16;
typedef short bf16x8 __attribute__((ext_vector_type(8)));
typedef short s16x4 __attribute__((ext_vector_type(4)));
typedef float f32x16 __attribute__((ext_vector_type(16)));
typedef float f32x4 __attribute__((ext_vector_type(4)));
typedef unsigned u32x4 __attribute__((ext_vector_type(4)));
template <class A, class Bt> struct same_t { static constexpr bool v = false; };
template <class A> struct same_t<A, A> { static constexpr bool v = true; };

#define KSWZ(row, colB) ((row) * 256 + ((colB) ^ (((row) & 7) << 4)))
#define SBAR() __builtin_amdgcn_sched_barrier(0)
__device__ __forceinline__ int v_st(int k, int c) { const int kk = (k & ~0xC) | ((k & 4) << 1) | ((k & 8) >> 1); return ((kk >> 3) * 4 + (c >> 5)) * 512 + ((kk & 7) * 32 + (c & 31)) * 2; }
__device__ __forceinline__ int v_rd_base(int lane) { return ((lane & 3) << 3) | (((lane >> 2) & 3) << 6) | (((lane >> 4) & 1) << 5) | (((lane >> 5) & 1) << 8); }
constexpr int v_rd_off(int d0, int ks, int half) { return d0 * 512 + ks * 4096 + half * 2048; }
__device__ __forceinline__ int crow(int r, int hi) { return (r & 3) + 8 * (r >> 2) + 4 * hi; }
__device__ __forceinline__ unsigned cvtpk(float lo, float hi) {
    unsigned r; asm volatile("v_cvt_pk_bf16_f32 %0, %1, %2" : "=v"(r) : "v"(lo), "v"(hi)); return r;
}
__device__ __forceinline__ bf16x8 pack8(f32x4 a, f32x4 b) {
    u32x4 w = {cvtpk(a[0], a[1]), cvtpk(a[2], a[3]), cvtpk(b[0], b[1]), cvtpk(b[2], b[3])};
    return *reinterpret_cast<bf16x8*>(&w);
}
template <class T> __device__ __forceinline__ bf16x8 load8(const T* p) {
    if constexpr (same_t<T, float>::v) { return pack8(*(const f32x4*)p, *(const f32x4*)(p + 4)); }
    else { return *reinterpret_cast<const bf16x8*>(p); }
}
__device__ __forceinline__ void mask_tile(f32x16& p0, f32x16& p1, int dq, unsigned W) {
    const float NEG = -__builtin_inff();
#pragma unroll
    for (int r = 0; r < 16; ++r) {
        const int c = (r & 3) + 8 * (r >> 2);
        if ((unsigned)(dq - c) >= W) p0[r] = NEG;
        if ((unsigned)(dq - c - 32) >= W) p1[r] = NEG;
    }
}
__device__ __forceinline__ void partialSM(f32x16& p0, f32x16& p1, float& m_reg, float& mn, float& alpha) {
    float pmax = p0[0]; for (int r = 1; r < 16; ++r) pmax = fmaxf(pmax, p0[r]); for (int r = 0; r < 16; ++r) pmax = fmaxf(pmax, p1[r]);
    { auto rr = __builtin_amdgcn_permlane32_swap(__float_as_uint(pmax), __float_as_uint(pmax), false, false);
      pmax = fmaxf(__uint_as_float(rr[0]), __uint_as_float(rr[1])); }
    constexpr float C2 = 1.4426950408889634f * SCALE;
    if (__builtin_expect(__all((pmax - m_reg) * SCALE <= THR), 1)) { mn = m_reg; alpha = 1.f; }
    else { mn = fmaxf(m_reg, pmax); alpha = __builtin_amdgcn_exp2f((m_reg - mn) * C2); m_reg = mn; }
    const float mnL = -mn * C2;
    for (int r = 0; r < 16; ++r) p0[r] = fmaf(p0[r], C2, mnL); for (int r = 0; r < 16; ++r) p1[r] = fmaf(p1[r], C2, mnL);
    for (int r = 0; r < 16; ++r) p0[r] = __builtin_amdgcn_exp2f(p0[r]);
}
__device__ __forceinline__ void finishSM(f32x16& p0, f32x16& p1, float alpha, float& l_reg, bf16x8& pa0, bf16x8& pa1, bf16x8& pa2, bf16x8& pa3) {
    for (int r = 0; r < 16; ++r) p1[r] = __builtin_amdgcn_exp2f(p1[r]);
    float ps = 0; for (int r = 0; r < 16; ++r) ps += p0[r]; for (int r = 0; r < 16; ++r) ps += p1[r];
    { auto rr = __builtin_amdgcn_permlane32_swap(__float_as_uint(ps), __float_as_uint(ps), false, false);
      ps = __uint_as_float(rr[0]) + __uint_as_float(rr[1]); }
    l_reg = l_reg * alpha + ps;
#define PK4(P, B_, OUT) do { unsigned a0 = cvtpk(P[B_+0], P[B_+1]), a1 = cvtpk(P[B_+2], P[B_+3]);                          \
        unsigned b0 = cvtpk(P[B_+4], P[B_+5]), b1 = cvtpk(P[B_+6], P[B_+7]);                                             \
        auto r0 = __builtin_amdgcn_permlane32_swap(a0, b0, false, false); auto r1 = __builtin_amdgcn_permlane32_swap(a1, b1, false, false); \
        u32x4 w = {r0[0], r1[0], r0[1], r1[1]}; OUT = *reinterpret_cast<bf16x8*>(&w); } while (0)
    PK4(p0, 0, pa0); PK4(p0, 8, pa1); PK4(p1, 0, pa2); PK4(p1, 8, pa3);
#undef PK4
}
template <int KB, bool SK>
__device__ __forceinline__ void qkt(f32x16& p0, f32x16& p1, const char* K_lds, int r32, int hi, const bf16x8* qr, bool act) {
    if (SK && !act) { const float NEG = -__builtin_inff();
#pragma unroll
        for (int r = 0; r < 16; ++r) { p0[r] = NEG; p1[r] = NEG; } return; }
    p0 = f32x16{}; p1 = f32x16{};
    const char* kb[4];
#pragma unroll
    for (int dd = 0; dd < 4; ++dd) kb[dd] = K_lds + KB * SHM_K + KSWZ(r32, (dd * 16 + hi * 8) * 2);
#pragma unroll
    for (int d0 = 0; d0 < 8; ++d0) { const char* a = kb[d0 & 3] + (d0 >> 2) * 128;
        bf16x8 b0 = *reinterpret_cast<const bf16x8*>(a);
        bf16x8 b1 = *reinterpret_cast<const bf16x8*>(a + 32 * 256);
        p0 = __builtin_amdgcn_mfma_f32_32x32x16_bf16(b0, qr[d0], p0, 0, 0, 0);
        p1 = __builtin_amdgcn_mfma_f32_32x32x16_bf16(b1, qr[d0], p1, 0, 0, 0); }
}
template <int VB, bool SK>
__device__ __forceinline__ void pv_tile(f32x16* o, int vb0, bf16x8 pa0, bf16x8 pa1, bf16x8 pa2, bf16x8 pa3, bool act) {
    if (SK && !act) return;
#define TRRD(dst, off) asm volatile("ds_read_b64_tr_b16 %0, %1 offset:%2" : "=&v"(dst) : "v"(vb0), "i"(off) : "memory")
#define PV_D0(d0) do { s16x4 l0, l1, l2, l3, h0, h1, h2, h3; constexpr int b_ = VB * SHM_V + v_rd_off(d0, 0, 0);     \
        TRRD(l0, b_); TRRD(h0, b_ + 2048); TRRD(l1, b_ + 4096); TRRD(h1, b_ + 6144); TRRD(l2, b_ + 8192); TRRD(h2, b_ + 10240); TRRD(l3, b_ + 12288); TRRD(h3, b_ + 14336); \
        asm volatile("s_waitcnt lgkmcnt(0)" ::: "memory"); SBAR();                 \
        o[d0] = __builtin_amdgcn_mfma_f32_32x32x16_bf16(pa0, (bf16x8){l0[0], l0[1], l0[2], l0[3], h0[0], h0[1], h0[2], h0[3]}, o[d0], 0, 0, 0);   \
        o[d0] = __builtin_amdgcn_mfma_f32_32x32x16_bf16(pa1, (bf16x8){l1[0], l1[1], l1[2], l1[3], h1[0], h1[1], h1[2], h1[3]}, o[d0], 0, 0, 0);   \
        o[d0] = __builtin_amdgcn_mfma_f32_32x32x16_bf16(pa2, (bf16x8){l2[0], l2[1], l2[2], l2[3], h2[0], h2[1], h2[2], h2[3]}, o[d0], 0, 0, 0);   \
        o[d0] = __builtin_amdgcn_mfma_f32_32x32x16_bf16(pa3, (bf16x8){l3[0], l3[1], l3[2], l3[3], h3[0], h3[1], h3[2], h3[3]}, o[d0], 0, 0, 0); } while (0)
    PV_D0(0); PV_D0(1); PV_D0(2); PV_D0(3);
#undef PV_D0
#undef TRRD
}

template <class TIn, class TOut> struct BlockRef { const TIn* Q; const TIn* K; const TIn* V; TOut* O; int P0; };
template <class TIn> struct Seam {
    bf16x8 qr[8];
    bf16x8 st_v0, st_v1, st_k0, st_k1; f32x4 sf0, sf1, sf2, sf3;
    f32x4 tq[16];
};
__device__ __forceinline__ int swa_jlo(int P0, int W) { const int lowk = P0 - W + 1; return lowk > 0 ? lowk / KVBLK : 0; }
#define ROW(p, k0, rr) ((p) + (size_t)((k0) + (rr)) * KVP + sc)
#define VMW() asm volatile("s_waitcnt vmcnt(0)" ::: "memory")
#define VMWN(n) asm volatile("s_waitcnt vmcnt(%0)" :: "i"(n) : "memory")
#define SLOAD_H(Kp, Vp, k0) do { S.st_v0 = load8<TIn>(ROW(Vp, k0, sr)); S.st_v1 = load8<TIn>(ROW(Vp, k0, 32 + sr));              \
                         S.st_k0 = load8<TIn>(ROW(Kp, k0, sr)); S.st_k1 = load8<TIn>(ROW(Kp, k0, 32 + sr)); } while (0)
#define SWRITE_HK(bf) do { *(bf16x8*)(K_lds + (bf) * SHM_K + kws) = S.st_k0; *(bf16x8*)(K_lds + (bf) * SHM_K + kws + 32 * 256) = S.st_k1; } while (0)
#define SWRITE_HV(bf) do { *(bf16x8*)(V_lds + (bf) * SHM_V + vst0) = S.st_v0; *(bf16x8*)(V_lds + (bf) * SHM_V + vst1) = S.st_v1; } while (0)
#define SWRITE_H(bf) do { SWRITE_HV(bf); SWRITE_HK(bf); } while (0)
#define SLOAD_F(p, k0) do { S.sf0 = *(const f32x4*)ROW(p, k0, sr); S.sf1 = *(const f32x4*)(ROW(p, k0, sr) + 4);                \
                            S.sf2 = *(const f32x4*)ROW(p, k0, 32 + sr); S.sf3 = *(const f32x4*)(ROW(p, k0, 32 + sr) + 4); } while (0)
#define SWRITE_KF(bf) do { *(bf16x8*)(K_lds + (bf) * SHM_K + kws) = pack8(S.sf0, S.sf1); *(bf16x8*)(K_lds + (bf) * SHM_K + kws + 32 * 256) = pack8(S.sf2, S.sf3); } while (0)
#define SWRITE_VF(bf) do { *(bf16x8*)(V_lds + (bf) * SHM_V + vst0) = pack8(S.sf0, S.sf1); *(bf16x8*)(V_lds + (bf) * SHM_V + vst1) = pack8(S.sf2, S.sf3); } while (0)
template <class TIn, class TOut>
__device__ __forceinline__ void causal_swa_prime(const BlockRef<TIn, TOut>& cur, int W, char* lds, Seam<TIn>& S) {
    constexpr bool F32 = same_t<TIn, float>::v;
    int tid_ = threadIdx.x; asm volatile("" : "+v"(tid_));
    const int tid = tid_, wid = __builtin_amdgcn_readfirstlane(tid >> 6), lane = tid & 63, r32 = lane & 31, hi = lane >> 5;
    const int sr = tid >> 4, sc = (tid & 15) * 8, kws = KSWZ(sr, sc * 2); char* K_lds = lds + 2 * SHM_V;
    const int kb0 = swa_jlo(cur.P0, W) * KVBLK;
    for (int d0 = 0; d0 < 8; ++d0) S.qr[d0] = load8<TIn>(cur.Q + (size_t)(wid * QBLK + r32) * QP + d0 * 16 + hi * 8);
    if constexpr (F32) { SLOAD_F((const float*)cur.K, kb0); VMW(); SWRITE_KF(0); SBAR(); SLOAD_F((const float*)cur.V, kb0); }
    else { SLOAD_H(cur.K, cur.V, kb0); VMW(); SWRITE_HK(0); }
    __syncthreads();
}
template <class TIn, class TOut>
__device__ __forceinline__ void causal_swa_block(const BlockRef<TIn, TOut>& cur, const BlockRef<TIn, TOut>& nxt, int skv, int W, char* lds, Seam<TIn>& S) {
    constexpr bool F32 = same_t<TIn, float>::v;
    int tid_ = threadIdx.x; asm volatile("" : "+v"(tid_));
    const int tid = tid_, wid = __builtin_amdgcn_readfirstlane(tid >> 6), lane = tid & 63, r32 = lane & 31, hi = lane >> 5;
    const int j_lo = swa_jlo(cur.P0, W);
    int j_hi = (cur.P0 + QB - 1) / KVBLK + 1; if (j_hi > skv / KVBLK) j_hi = skv / KVBLK;
    const int NT = j_hi - j_lo;
    const int kbn = swa_jlo(nxt.P0, W) * KVBLK;
    const int qlo = cur.P0 + wid * QBLK, qm = qlo + r32 - 4 * hi;
    char* V_lds = lds; char* K_lds = lds + 2 * SHM_V;
    float* ws = (float*)(lds + 2 * SHM_V + 2 * SHM_K) + wid * 64; float* li_l = ws, * al_l = ws + 32;
    float m_reg = -1e30f, l_reg = 0; f32x16 o[4] = {};
    const int sr = tid >> 4, sc = (tid & 15) * 8, vst0 = v_st(sr, sc), vst1 = v_st(32 + sr, sc), kws = KSWZ(sr, sc * 2);
    const int vb0 = (int)(uintptr_t)V_lds + v_rd_base(lane);
    const TIn* Kh = cur.K; const TIn* Vh = cur.V;
#define RESC(a) do { if (__any((a) < 1.f)) { if (hi == 0) al_l[r32] = (a); asm volatile("s_waitcnt lgkmcnt(0)" ::: "memory");              \
                     for (int d_ = 0; d_ < 4; ++d_) for (int r = 0; r < 16; ++r) o[d_][r] *= al_l[crow(r, hi)]; } } while (0)
#define KBASE(t) ((j_lo + (t)) * KVBLK)
#define ACT(t) (KBASE(t) <= qlo + QBLK - 1 && KBASE(t) + KVBLK - 1 >= qlo - W + 1)
#define MASKT(P0_, P1_, t) do { const int kb_ = KBASE(t); if ((!SK || ACT(t)) && (kb_ + KVBLK - 1 > qlo || kb_ <= qlo + QBLK - 1 - W)) mask_tile(P0_, P1_, qm - kb_, (unsigned)W); } while (0)
    constexpr int NQL = F32 ? 16 : 8;
    constexpr bool SK = WSKIP && !F32;
#define SEAM_K0() do { VMWN(NQL); if constexpr (F32) { SWRITE_KF(0); SBAR(); SLOAD_F((const float*)nxt.V, kbn); } else { SWRITE_HK(0); } SBAR(); } while (0)
    f32x16 pA0, pA1, pB0, pB1; float mnA, mnB, alA, alB; bf16x8 pa0, pa1, pa2, pa3;
    if constexpr (F32) { VMW(); SWRITE_VF(0); SBAR(); } else { SWRITE_HV(0); SBAR(); }
    if (NT > 1) { if constexpr (F32) SLOAD_F((const float*)Kh, KBASE(1)); else SLOAD_H(Kh, Vh, KBASE(1)); }
    SBAR(); qkt<0, SK>(pA0, pA1, K_lds, r32, hi, S.qr, ACT(0));
    if constexpr (F32) { if (NT > 1) { VMW(); SWRITE_KF(1); SBAR(); SLOAD_F((const float*)Vh, KBASE(1)); } }
    MASKT(pA0, pA1, 0); partialSM(pA0, pA1, m_reg, mnA, alA);
    if (NT > 1) { VMW(); if constexpr (F32) { SWRITE_VF(1); SBAR(); if (NT > 2) SLOAD_F((const float*)Kh, KBASE(2)); } else SWRITE_H(1); }
    __syncthreads();
#define HALF_STEP(PX0, PX1, mnX, alX, PY0, PY1, alY, t, KB, VB, SB) do {                                                      \
        SBAR(); qkt<KB, SK>(PX0, PX1, K_lds, r32, hi, S.qr, ACT(t));                                             \
        finishSM(PY0, PY1, alY, l_reg, pa0, pa1, pa2, pa3); SBAR();                                                           \
        if ((t) + 1 < NT) { if constexpr (F32) { VMW(); SWRITE_KF(SB); SBAR(); SLOAD_F((const float*)Vh, KBASE((t) + 1)); }  \
                            else { SLOAD_H(Kh, Vh, KBASE((t) + 1)); } SBAR(); }                                               \
        pv_tile<VB, SK>(o, vb0, pa0, pa1, pa2, pa3, ACT((t) - 1)); MASKT(PX0, PX1, (t)); partialSM(PX0, PX1, m_reg, mnX, alX);                                        \
        __syncthreads();                                                                                                      \
        if ((t) + 1 < NT) { VMW(); if constexpr (F32) { SWRITE_VF(SB); SBAR(); if ((t) + 2 < NT) SLOAD_F((const float*)Kh, KBASE((t) + 2)); } \
                            else { SWRITE_H(SB); } }                                                                          \
        RESC(alX); __syncthreads(); } while (0)
    for (int t = 1; t + 1 < NT; t += 2) {
        HALF_STEP(pB0, pB1, mnB, alB, pA0, pA1, alA, t, 1, 0, 0);
        HALF_STEP(pA0, pA1, mnA, alA, pB0, pB1, alB, t + 1, 0, 1, 1);
    }
    const bool even = (NT & 1) == 0;
    if (even) { SBAR(); qkt<1, SK>(pB0, pB1, K_lds, r32, hi, S.qr, ACT(NT - 1)); SBAR(); }
#define QROW(e) (nxt.Q + (size_t)(wid * QBLK + r32) * QP + ((e) >> 1) * 16 + hi * 8 + ((e) & 1) * 4)
    if constexpr (F32) { SLOAD_F((const float*)nxt.K, kbn); SBAR();
#pragma unroll
        for (int e = 0; e < 8; ++e) S.tq[e] = *(const f32x4*)QROW(e); }
    else { SLOAD_H(nxt.K, nxt.V, kbn); SBAR();
#pragma unroll
        for (int d0 = 0; d0 < 8; ++d0) S.qr[d0] = load8<TIn>(nxt.Q + (size_t)(wid * QBLK + r32) * QP + d0 * 16 + hi * 8); }
    SBAR();
    finishSM(pA0, pA1, alA, l_reg, pa0, pa1, pa2, pa3); SBAR();
    if constexpr (F32) {
#pragma unroll
        for (int e = 8; e < 16; ++e) S.tq[e] = *(const f32x4*)QROW(e); SBAR(); }
#undef QROW
    pv_tile<0, SK>(o, vb0, pa0, pa1, pa2, pa3, ACT(even ? NT - 2 : NT - 1));
    if (even) { MASKT(pB0, pB1, NT - 1); partialSM(pB0, pB1, m_reg, mnB, alB); __syncthreads(); RESC(alB);
        finishSM(pB0, pB1, alB, l_reg, pa0, pa1, pa2, pa3); SBAR(); pv_tile<1, SK>(o, vb0, pa0, pa1, pa2, pa3, ACT(NT - 1)); }
    SBAR(); SEAM_K0();
    if (hi == 0) li_l[r32] = l_reg; asm volatile("s_waitcnt lgkmcnt(0)" ::: "memory");
    float rli[16];
#pragma unroll
    for (int r = 0; r < 16; ++r) rli[r] = __builtin_amdgcn_rcpf(li_l[crow(r, hi)]);
    TOut* Ow = cur.O + (size_t)(wid * QBLK) * OP;
#pragma unroll
    for (int r = 0; r < 16; ++r) { const int orow = crow(r, hi);
#pragma unroll
        for (int d0 = 0; d0 < 4; ++d0) { const float v = o[d0][r] * rli[r];
            if constexpr (same_t<TOut, float>::v) { Ow[(size_t)orow * OP + d0 * 32 + r32] = v; }
            else { const float vn = __shfl_xor(v, 1);
                   if ((r32 & 1) == 0) *(unsigned*)(Ow + (size_t)orow * OP + d0 * 32 + r32) = cvtpk(v, vn); } } }
    if constexpr (F32) {
#pragma unroll
        for (int d0 = 0; d0 < 8; ++d0) S.qr[d0] = pack8(S.tq[2 * d0], S.tq[2 * d0 + 1]); }
    __syncthreads();
#undef RESC
#undef KBASE
#undef ACT
#undef MASKT
#undef SEAM_K0
#undef HALF_STEP
}
#undef ROW
#undef VMW
#undef VMWN
#undef SLOAD_H
#undef SWRITE_HK
#undef SWRITE_HV
#undef SWRITE_H
#undef SLOAD_F
#undef SWRITE_KF
#undef SWRITE_VF


}
constexpr int NWAVES = 8;
constexpr int BATCH = 2, SEQ = 4096, DM = 2048, FF = 5632, DIN = 6144, DEPTH = 4, HD = 128;
constexpr int M = BATCH * SEQ;
constexpr float RMS_EPS = 1e-6f;
constexpr float QK_C2 = 0.08838834764831845f * 1.4426950408889634f;
constexpr float SB_EXIT = 151.0f;
constexpr size_t MiB = 1u << 20;
constexpr size_t WS_CTL = 0, CTL_ZERO_BYTES = 1 * MiB;
constexpr size_t WS_ROPE = 1 * MiB;
constexpr size_t WS_SSQ = 3 * MiB;
constexpr size_t WS_X = 4 * MiB;
constexpr size_t WS_XB = 68 * MiB;
constexpr size_t WS_H = 100 * MiB;
constexpr size_t WS_QKV = 188 * MiB;
constexpr size_t WS_MIX = 284 * MiB;
constexpr size_t WS_OD = 316 * MiB;
constexpr size_t WS_W = 380 * MiB;
constexpr size_t W_GU = (size_t)2 * FF * DM * 2, W_D = (size_t)DM * FF * 2, W_IN = (size_t)DIN * DM * 2, W_OUT = (size_t)DM * DM * 2;
constexpr size_t WO_GU1 = 0, WO_D1 = W_GU, WO_IN = WO_D1 + W_D, WO_OUT = WO_IN + W_IN, WO_GU2 = WO_OUT + W_OUT, WO_D2 = WO_GU2 + W_GU, W_LAYER = WO_D2 + W_D;
constexpr size_t WS_END = WS_W + DEPTH * W_LAYER;
static_assert(W_LAYER == 164 * MiB, "weights per layer");
constexpr int CW_TMO = 0, CW_CODE = 1, CW_BAR = 4096;
constexpr int RING_OFF = 0, RING_BYTES = 135168;
constexpr int LDSCTL_OFF = RING_BYTES, MISC_OFF = LDSCTL_OFF + 320;
constexpr int LDS_BYTES = 147456;
static_assert(MISC_OFF + 128 <= LDS_BYTES && 8 * 16640 <= RING_BYTES, "LDS map");

#define GAS __attribute__((address_space(1)))
#define LAS __attribute__((address_space(3)))
typedef unsigned short bf16;
typedef unsigned v4u __attribute__((ext_vector_type(4)));
typedef float f32x4 __attribute__((ext_vector_type(4)));
typedef short bf16x8 __attribute__((ext_vector_type(8)));
typedef GAS unsigned gu32;
typedef GAS unsigned long long gu64;
#define RLX_AGENT __ATOMIC_RELAXED, __HIP_MEMORY_SCOPE_AGENT
#define LDS_WAIT() asm volatile("s_waitcnt lgkmcnt(0)" ::: "memory")
#define VM_WAIT() asm volatile("s_waitcnt vmcnt(0)" ::: "memory")
__device__ __forceinline__ unsigned long long rt() { return __builtin_amdgcn_s_memrealtime(); }
#define XB_TMO      128
#define XB_XCNT(j)  (256  + 64 * (j))
#define XB_XSUB(j)  (1280 + 64 * (j))
#define XB_XGEN(j)  (2304 + 64 * (j))
#define XB_TOP      3328
#define XB_TOPGEN   3392
#define XCD_BAR_WORDS 3456
#define XB_SPIN_CAP (1u << 18)

__device__ __forceinline__ unsigned xb_ld(unsigned* p)              { return __hip_atomic_load(p, __ATOMIC_RELAXED, __HIP_MEMORY_SCOPE_AGENT); }
__device__ __forceinline__ unsigned xb_add(unsigned* p, unsigned v) { return __hip_atomic_fetch_add(p, v, __ATOMIC_RELAXED, __HIP_MEMORY_SCOPE_AGENT); }
__device__ __forceinline__ unsigned xb_xcc_id() { return (unsigned)__builtin_amdgcn_s_getreg((3 << 11) | 20) & 0xFu; }
#define XB_SPIN(cond, bar) do { unsigned _sp = 0; while (cond) { __builtin_amdgcn_s_sleep(1); \
    if ((++_sp & 255u) == 0u) { if (xb_ld(&(bar)[XB_TMO])) break; if (_sp > XB_SPIN_CAP) { atomicAdd(&(bar)[XB_TMO], 1u); break; } } } } while (0)

struct XcdBarrier {
    unsigned* bar; unsigned x;
    volatile LAS unsigned* st;
};

__device__ __forceinline__ XcdBarrier xcd_barrier_post(unsigned* bar, volatile LAS unsigned* st) {
    XcdBarrier b; b.bar = bar; b.x = xb_xcc_id(); b.st = st;
    if (threadIdx.x == 0) (void)xb_add(&bar[XB_XCNT(b.x)], 1u);
    return b;
}
__device__ __forceinline__ void xcd_barrier_complete(unsigned* bar, unsigned x, unsigned& nloc, unsigned& nx) {
    const unsigned G = gridDim.x * gridDim.y * gridDim.z;
    unsigned sum, cnt, mine, sp = 0u;
    for (;;) {
        sum = 0u; cnt = 0u; mine = 0u;
#pragma unroll
        for (unsigned j = 0; j < 16; ++j) { const unsigned c = xb_ld(&bar[XB_XCNT(j)]); sum += c; cnt += (c > 0u) ? 1u : 0u; mine = (j == x) ? c : mine; }
        if (sum == G) break;
        __builtin_amdgcn_s_sleep(1);
        if ((++sp & 255u) == 0u) { if (xb_ld(&bar[XB_TMO])) break; if (sp > XB_SPIN_CAP) { atomicAdd(&bar[XB_TMO], 1u); break; } }
    }
    nloc = mine > 0u ? mine : 1u; nx = cnt > 0u ? cnt : 1u;
}

__device__ __forceinline__ void xcd_barrier(const XcdBarrier& b) {
    asm volatile("s_waitcnt vmcnt(0)" ::: "memory");
    __syncthreads();
    if (threadIdx.x == 0) {
        unsigned* bar = b.bar;
        __builtin_amdgcn_s_waitcnt(0);
        unsigned nloc = b.st[0], nx = b.st[1];
        if (nloc == 0u) { xcd_barrier_complete(bar, b.x, nloc, nx); b.st[0] = nloc; b.st[1] = nx; }
        const unsigned old = xb_add(&bar[XB_XSUB(b.x)], 1u);
        const unsigned gen = old / nloc;
        if (old + 1u == (gen + 1u) * nloc) {
            __builtin_amdgcn_fence(__ATOMIC_RELEASE, "agent");
            asm volatile("s_waitcnt vmcnt(0)" ::: "memory");
            const unsigned og = xb_add(&bar[XB_TOP], 1u);
            const unsigned tg = og / nx;
            if (og + 1u == (tg + 1u) * nx) xb_add(&bar[XB_TOPGEN], 1u);
            else XB_SPIN(xb_ld(&bar[XB_TOPGEN]) == tg, bar);
            __builtin_amdgcn_fence(__ATOMIC_ACQUIRE, "agent");
            xb_add(&bar[XB_XGEN(b.x)], 1u);
            asm volatile("s_waitcnt vmcnt(0)" ::: "memory");
        } else {
            XB_SPIN(xb_ld(&bar[XB_XGEN(b.x)]) == gen, bar);
            __builtin_amdgcn_fence(__ATOMIC_ACQUIRE, "agent");
            asm volatile("s_waitcnt vmcnt(0)" ::: "memory");
        }
    }
    __syncthreads();
}

__device__ __forceinline__ float wave_sum(float v) {
#pragma unroll
    for (int o = 1; o < 64; o <<= 1) v += __shfl_xor(v, o);
    return v;
}
__device__ __forceinline__ unsigned pk2(float lo, float hi) { return pg8::cvt_pk_bf16(lo, hi); }
template <int MODE> __device__ __forceinline__ int w_rowmap(int n) {
    if (MODE == 0) return n;
    if (MODE == 1) return ((n >> 7) << 8) + (n & 127);
    if (MODE == 2) return ((n >> 7) << 8) + 128 + (n & 127);
    const int l = n & 127, nh = l >> 6, i = l & 63; return (n & ~127) + 32 * (i >> 4) + 8 * ((i >> 2) & 3) + 4 * nh + (i & 3);
}
template <int MODE> __device__ __forceinline__ void p0_item(const float* W, int K, int N, const float* gain, bf16* dst, LAS float* scr, int item, int lane) {
    const int nblk = N / 64, kb = item / nblk, nb = item % nblk, k0 = 64 * kb, n0 = 64 * nb;
    const int kk = lane >> 4, nn = 4 * (lane & 15);
#pragma unroll 4
    for (int i = 0; i < 16; ++i) { const int k = 4 * i + kk; const f32x4 v = *(const GAS f32x4*)(W + (size_t)(k0 + k) * N + n0 + nn); const float g = gain ? gain[k0 + k] : 1.0f;
        LAS float* s = scr + k * 65 + nn; s[0] = v[0] * g; s[1] = v[1] * g; s[2] = v[2] * g; s[3] = v[3] * g; }
    LDS_WAIT(); asm volatile("" ::: "memory");
    const int c = lane & 7;
#pragma unroll
    for (int j = 0; j < 8; ++j) { const int n = (lane >> 3) + 8 * j; const LAS float* s = scr + (8 * c) * 65 + n;
        v4u o; o.x = pk2(s[0 * 65], s[1 * 65]); o.y = pk2(s[2 * 65], s[3 * 65]); o.z = pk2(s[4 * 65], s[5 * 65]); o.w = pk2(s[6 * 65], s[7 * 65]);
        *(GAS v4u*)(dst + (size_t)w_rowmap<MODE>(n0 + n) * K + k0 + 8 * c) = o; }
    LDS_WAIT(); asm volatile("" ::: "memory");
}
__device__ __forceinline__ void rope_entry(int pos, int i, float& c, float& s) {
    const double R1 = 0.86596432336006535, R2 = R1 * R1, R4 = R2 * R2, R8 = R4 * R4, R16 = R8 * R8, R32 = R16 * R16;
    double f = 1.0; if (i & 1) f *= R1; if (i & 2) f *= R2; if (i & 4) f *= R4; if (i & 8) f *= R8; if (i & 16) f *= R16; if (i & 32) f *= R32;
    const float ff = (float)f;
    const float angf = (float)pos * ff;
    const double ang = (double)angf;
    const double TWO_PI_HI = 6.283185307179586, TWO_PI_LO = 2.4492935982947064e-16, INV_2PI = 0.15915494309189535;
    const double n = __builtin_rint(ang * INV_2PI);
    double r = __builtin_fma(-n, TWO_PI_HI, ang); r = __builtin_fma(-n, TWO_PI_LO, r);
    const double r2 = r * r;
    double sc = 1.0, ss = 1.0;
#pragma unroll
    for (int k = 15; k >= 1; --k) { sc = 1.0 - sc * r2 / (double)((2 * k - 1) * (2 * k)); ss = 1.0 - ss * r2 / (double)((2 * k) * (2 * k + 1)); }
    c = (float)sc; s = (float)(ss * r);
}

__device__ __forceinline__ void sb_naive_phase(const bf16* QKV, bf16* MIX, int gw, int NGW, int lane) {
    for (int idx = gw; idx < M * 8; idx += NGW) {
        const int row = idx >> 3, h = idx & 7, t = row & (SEQ - 1), rb = row - t;
        const unsigned qq = *(const GAS unsigned*)(QKV + (size_t)row * DIN + h * HD + 2 * lane);
        const float q0 = __uint_as_float(qq << 16), q1 = __uint_as_float(qq & 0xffff0000u);
        float R = 0.f, o0 = 0.f, o1 = 0.f;
        for (int s = t - 1; s >= 0; --s) {
            const bf16* kr = QKV + (size_t)(rb + s) * DIN + 1024 + h * HD + 2 * lane;
            const unsigned kk = *(const GAS unsigned*)kr, vv = *(const GAS unsigned*)(kr + 1024);
            const float zz = wave_sum(q0 * __uint_as_float(kk << 16) + q1 * __uint_as_float(kk & 0xffff0000u));
            const float sp = fmaxf(zz, 0.f) + __builtin_amdgcn_logf(1.0f + __builtin_amdgcn_exp2f(-fabsf(zz)));
            const float w = __builtin_amdgcn_exp2f(zz - sp + R);
            R -= sp;
            o0 += w * __uint_as_float(vv << 16); o1 += w * __uint_as_float(vv & 0xffff0000u);
            if (R < -SB_EXIT) break;
        }
        *(GAS unsigned*)(MIX + (size_t)row * DM + h * HD + 2 * lane) = pk2(o0, o1);
    }
}

struct Args { const float* in[18]; float* out; unsigned char* ws; float linit[4]; int ph_lo, ph_hi; };
enum { I_X = 0, I_NF1, I_G1, I_U1, I_D1, I_NMIX, I_WIN, I_LQ1, I_LK1, I_LQ2, I_LK2, I_SUBLN, I_WOUT, I_NF2, I_G2, I_U2, I_D2, I_NFIN };

struct Ctx { int tid, lane, wave, bx, G, gw, NGW; unsigned char* ws; gu32* ctl; float* ROPE; float* SSQ; float* X; bf16* XB; bf16* H; bf16* QKV; bf16* MIX; float* OD; };
__device__ __forceinline__ Ctx make_ctx(unsigned char* ws_in) {
    Ctx c; int t = threadIdx.x; asm volatile("" : "+v"(t)); int b = blockIdx.x; asm volatile("" : "+s"(b)); unsigned char* ws = ws_in; asm volatile("" : "+s"(ws));
    c.tid = t; c.lane = t & 63; c.wave = __builtin_amdgcn_readfirstlane(t >> 6); c.bx = b; c.G = gridDim.x;
    const int vcu = (c.G % 8 == 0) ? (b % 8) * (c.G / 8) + b / 8 : b; c.gw = vcu * NWAVES + c.wave; c.NGW = c.G * NWAVES;
    c.ws = ws; c.ctl = (gu32*)(ws + WS_CTL); c.ROPE = (float*)(ws + WS_ROPE); c.SSQ = (float*)(ws + WS_SSQ); c.X = (float*)(ws + WS_X); c.XB = (bf16*)(ws + WS_XB); c.H = (bf16*)(ws + WS_H);
    c.QKV = (bf16*)(ws + WS_QKV); c.MIX = (bf16*)(ws + WS_MIX); c.OD = (float*)(ws + WS_OD);
    return c;
}
__device__ __forceinline__ int opaque_s(int x) { asm volatile("" : "+s"(x)); return x; }
#define INP(i) (args.in[opaque_s(i)])

__global__ void __launch_bounds__(NWAVES * 64, 2) mk_fwd(Args args) {
    extern __shared__ __attribute__((aligned(16))) unsigned char lds[];
    LAS unsigned char* L = (LAS unsigned char*)lds;
    volatile LAS unsigned* MISC = (volatile LAS unsigned*)(L + MISC_OFF);
    for (int u = threadIdx.x; u < (LDS_BYTES - LDSCTL_OFF) / 4; u += NWAVES * 64) ((LAS unsigned*)(L + LDSCTL_OFF))[u] = 0u;
    __syncthreads();
    XcdBarrier bar = xcd_barrier_post((unsigned*)(args.ws + WS_CTL) + CW_BAR, MISC + 8);
    const int lo = args.ph_lo, hi = args.ph_hi; int pc = 0;
#define PH_ON() (lo <= pc && pc < hi)
#define PH_END() do { if (lo <= pc && pc + 1 < hi) xcd_barrier(bar); ++pc; } while (0)

    if (PH_ON()) {
        const Ctx c = make_ctx(args.ws); const int lane = c.lane, gw = c.gw, NGW = c.NGW;
        LAS float* scr = (LAS float*)(L + RING_OFF + c.wave * 16640);
        constexpr int I_GU = (DM / 64) * (FF / 64), I_DN = (FF / 64) * (DM / 64), I_IN = (DM / 64) * (DIN / 64), I_OUT = (DM / 64) * (DM / 64);
        constexpr int I_LAYER = 4 * I_GU + 2 * I_DN + I_IN + I_OUT;
        for (int it = gw; it < DEPTH * I_LAYER; it += NGW) {
            const int layer = it / I_LAYER; int r = it % I_LAYER;
            unsigned char* wl = c.ws + WS_W + (size_t)layer * W_LAYER;
            const size_t ofg = (size_t)layer * DM * FF, ofd = (size_t)layer * FF * DM;
            if (r < I_GU) { p0_item<1>(INP(I_G1) + ofg, DM, FF, INP(I_NF1) + layer * DM, (bf16*)(wl + WO_GU1), scr, r, lane); continue; } r -= I_GU;
            if (r < I_GU) { p0_item<2>(INP(I_U1) + ofg, DM, FF, INP(I_NF1) + layer * DM, (bf16*)(wl + WO_GU1), scr, r, lane); continue; } r -= I_GU;
            if (r < I_DN) { p0_item<0>(INP(I_D1) + ofd, FF, DM, nullptr, (bf16*)(wl + WO_D1), scr, r, lane); continue; } r -= I_DN;
            if (r < I_IN) { p0_item<3>(INP(I_WIN) + (size_t)layer * DM * DIN, DM, DIN, INP(I_NMIX) + layer * DM, (bf16*)(wl + WO_IN), scr, r, lane); continue; } r -= I_IN;
            if (r < I_OUT) { p0_item<0>(INP(I_WOUT) + (size_t)layer * DM * DM, DM, DM, nullptr, (bf16*)(wl + WO_OUT), scr, r, lane); continue; } r -= I_OUT;
            if (r < I_GU) { p0_item<1>(INP(I_G2) + ofg, DM, FF, INP(I_NF2) + layer * DM, (bf16*)(wl + WO_GU2), scr, r, lane); continue; } r -= I_GU;
            if (r < I_GU) { p0_item<2>(INP(I_U2) + ofg, DM, FF, INP(I_NF2) + layer * DM, (bf16*)(wl + WO_GU2), scr, r, lane); continue; } r -= I_GU;
            p0_item<0>(INP(I_D2) + ofd, FF, DM, nullptr, (bf16*)(wl + WO_D2), scr, r, lane);
        }
        for (int e = c.bx * (NWAVES * 64) + c.tid; e < SEQ * 64; e += c.G * NWAVES * 64) { float cs, sn; rope_entry(e >> 6, e & 63, cs, sn); c.ROPE[e] = cs; c.ROPE[SEQ * 64 + e] = sn; }
        const float* xin = INP(I_X);
        for (int m = gw; m < M; m += NGW) {
            const GAS f32x4* xr = (const GAS f32x4*)(xin + (size_t)m * DM) + lane; GAS unsigned long long* o8 = (GAS unsigned long long*)(c.XB + (size_t)m * DM) + lane; float s = 0.f;
#pragma unroll
            for (int j = 0; j < 8; ++j) { const f32x4 v = xr[64 * j]; s += (v[0] * v[0] + v[1] * v[1]) + (v[2] * v[2] + v[3] * v[3]);
                o8[64 * j] = (unsigned long long)pk2(v[0], v[1]) | ((unsigned long long)pk2(v[2], v[3]) << 32); }
            s = wave_sum(s);
            if (lane < 8) c.SSQ[(size_t)m * 8 + lane] = (lane == 0) ? s : 0.f;
        }
    }
    PH_END();

    for (int step = 0; step < 2 * DEPTH; ++step) {
        const int layer = step >> 1, half = step & 1;
        if (PH_ON()) {
            const Ctx c = make_ctx(args.ws); unsigned char* wl = c.ws + WS_W + (size_t)layer * W_LAYER;
            pg8::Gemm g{c.XB, (const bf16*)(wl + (half ? WO_GU2 : WO_GU1)), M, 2 * FF, DM}; pg8::StaticOrder S; S.init(M, 2 * FF, c.G, c.bx);
            pg8::EpiSwiGLU E{c.H, c.SSQ};
            pg8::gemm_phase<pg8::EpiSwiGLU, pg8::StaticOrder, true, true>(L + RING_OFF, g, S, E);
        }
        PH_END();
        if (PH_ON()) {
            const Ctx c = make_ctx(args.ws); unsigned char* wl = c.ws + WS_W + (size_t)layer * W_LAYER;
            pg8::Gemm g{c.H, (const bf16*)(wl + (half ? WO_D2 : WO_D1)), M, DM, FF}; pg8::StaticOrder S; S.init(M, DM, c.G, c.bx);
            pg8::EpiResid E{(step == 0) ? INP(I_X) : (const float*)c.X, c.X, c.XB, c.SSQ, 0.5f};
            pg8::gemm_phase<pg8::EpiResid, pg8::StaticOrder, false, true>(L + RING_OFF, g, S, E);
        }
        PH_END();
        if (half == 0) {
            if (PH_ON()) {
                const Ctx c = make_ctx(args.ws); unsigned char* wl = c.ws + WS_W + (size_t)layer * W_LAYER;
                pg8::Gemm g{c.XB, (const bf16*)(wl + WO_IN), M, DIN, DM}; pg8::StaticOrder S; S.init(M, DIN, c.G, c.bx);
                pg8::EpiQKV E{c.QKV, c.SSQ, c.ROPE, QK_C2};
                pg8::gemm_phase<pg8::EpiQKV, pg8::StaticOrder, true, true>(L + RING_OFF, g, S, E);
            }
            PH_END();
            if (PH_ON()) {
                { const Ctx c = make_ctx(args.ws); sb_naive_phase(c.QKV, c.MIX, c.gw, c.NGW, c.lane); }
                {
                    using namespace dattn;
                    const Ctx c = make_ctx(args.ws);
                    const int bh = c.bx & 7, j = c.bx >> 3, br = j >> 4, vh = (j >> 3) & 1, x = j & 7, b = bh >> 2, h = bh & 3;
                    const __hip_bfloat16* Qb = (const __hip_bfloat16*)c.QKV + (size_t)(b * SEQ) * DIN + 3072 + h * 256 + br * 128;
                    const __hip_bfloat16* Kb = (const __hip_bfloat16*)c.QKV + (size_t)(b * SEQ) * DIN + 4096 + h * 256 + br * 128;
                    const __hip_bfloat16* Vb = (const __hip_bfloat16*)c.QKV + (size_t)(b * SEQ) * DIN + 5120 + h * 256 + vh * 128;
                    float* Ob = c.OD + (size_t)br * M * 1024 + (size_t)(b * SEQ) * 1024 + h * 256 + vh * 128;
                    const int qa = x, qb2 = 15 - x;
                    BlockRef<__hip_bfloat16, float> c0{Qb + (size_t)qa * QB * QP, Kb, Vb, Ob + (size_t)qa * QB * OP, qa * QB};
                    BlockRef<__hip_bfloat16, float> c1{Qb + (size_t)qb2 * QB * QP, Kb, Vb, Ob + (size_t)qb2 * QB * OP, qb2 * QB};
                    Seam<__hip_bfloat16> S;
                    __syncthreads();
                    causal_swa_prime<__hip_bfloat16, float>(c0, SEQ, (char*)lds + RING_OFF, S);
                    causal_swa_block<__hip_bfloat16, float>(c0, c1, SEQ, SEQ, (char*)lds + RING_OFF, S);
                    causal_swa_block<__hip_bfloat16, float>(c1, c1, SEQ, SEQ, (char*)lds + RING_OFF, S);
                }
            }
            PH_END();
            if (PH_ON()) {
                const Ctx c = make_ctx(args.ws); const int lane = c.lane;
                const float linit = args.linit[opaque_s(layer)];
                const float* lq1 = INP(I_LQ1) + layer * HD; const float* lk1 = INP(I_LK1) + layer * HD; const float* lq2 = INP(I_LQ2) + layer * HD; const float* lk2 = INP(I_LK2) + layer * HD;
                const float s1 = wave_sum(lq1[lane] * lk1[lane] + lq1[lane + 64] * lk1[lane + 64]), s2 = wave_sum(lq2[lane] * lk2[lane] + lq2[lane + 64] * lk2[lane + 64]);
                const float lam = expf(s1) - expf(s2) + linit;
                const f32x4 gsub = *(const GAS f32x4*)(INP(I_SUBLN) + layer * 256 + 4 * lane);
                const float* OD = c.OD; bf16* MIX = c.MIX;
                for (int idx = c.gw; idx < M * 4; idx += c.NGW) { const int row = idx >> 2, h = idx & 3;
                    const f32x4 o1 = *(const GAS f32x4*)(OD + (size_t)row * 1024 + h * 256 + 4 * lane), o2 = *(const GAS f32x4*)(OD + (size_t)M * 1024 + (size_t)row * 1024 + h * 256 + 4 * lane);
                    const f32x4 d = o1 - o2 * lam;
                    const float ss = wave_sum((d[0] * d[0] + d[1] * d[1]) + (d[2] * d[2] + d[3] * d[3]));
                    const float r = (1.0f / sqrtf(ss * (1.0f / 256.0f) + RMS_EPS)) * (1.0f - linit);
                    const f32x4 y = d * gsub * r;
                    *(GAS unsigned long long*)(MIX + (size_t)row * DM + 1024 + h * 256 + 4 * lane) = (unsigned long long)pk2(y[0], y[1]) | ((unsigned long long)pk2(y[2], y[3]) << 32); }
            }
            PH_END();
            if (PH_ON()) {
                const Ctx c = make_ctx(args.ws); unsigned char* wl = c.ws + WS_W + (size_t)layer * W_LAYER;
                pg8::Gemm g{c.MIX, (const bf16*)(wl + WO_OUT), M, DM, DM}; pg8::StaticOrder S; S.init(M, DM, c.G, c.bx);
                pg8::EpiResid E{c.X, c.X, c.XB, c.SSQ, 1.0f};
                pg8::gemm_phase<pg8::EpiResid, pg8::StaticOrder, false, true>(L + RING_OFF, g, S, E);
            }
            PH_END();
        }
    }
    if (PH_ON()) {
        const Ctx c = make_ctx(args.ws); const int lane = c.lane;
        const bool bad = (__hip_atomic_load(c.ctl + CW_BAR + XB_TMO, RLX_AGENT) != 0u);
        const float* gf = INP(I_NFIN); float* out = args.out;
        for (int m = c.gw; m < M; m += c.NGW) {
            const GAS f32x4* xr = (const GAS f32x4*)(c.X + (size_t)m * DM) + lane; GAS f32x4* o = (GAS f32x4*)(out + (size_t)m * DM) + lane; f32x4 v[8]; float s = 0.f;
#pragma unroll
            for (int j = 0; j < 8; ++j) { v[j] = xr[64 * j]; s += (v[j][0] * v[j][0] + v[j][1] * v[j][1]) + (v[j][2] * v[j][2] + v[j][3] * v[j][3]); }
            float r = 1.0f / sqrtf(wave_sum(s) * (1.0f / DM) + RMS_EPS); if (bad) r = __builtin_nanf("");
#pragma unroll
            for (int j = 0; j < 8; ++j) o[64 * j] = v[j] * *((const GAS f32x4*)gf + lane + 64 * j) * r;
        }
    }
    PH_END();
#undef PH_ON
#undef PH_END
}
constexpr int N_PHASES = 1 + 2 * DEPTH * 2 + DEPTH * 4 + 1;

#ifndef MK_MULTI
#define MK_MULTI 0
#endif
extern "C" void kernel_launch(void* const* d_in, const int* in_sizes, int n_in, void* d_out, int out_size, void* d_ws, size_t ws_size, hipStream_t stream) {
    static int grid = 0;
    if (grid == 0) {
        if (n_in != 18 || in_sizes[0] != M * DM || out_size != M * DM || ws_size < WS_END) { fprintf(stderr, "kernel_launch: shape/workspace mismatch (n_in %d, in0 %d, out %d, ws %zu < %zu)\n", n_in, n_in > 0 ? in_sizes[0] : -1, out_size, ws_size, (size_t)WS_END); grid = -1; return; }
        if (hipFuncSetAttribute((const void*)mk_fwd, hipFuncAttributeMaxDynamicSharedMemorySize, LDS_BYTES) != hipSuccess) { fprintf(stderr, "kernel_launch: hipFuncSetAttribute failed\n"); grid = -1; return; }
        int per_cu = 0;
        if (hipOccupancyMaxActiveBlocksPerMultiprocessor(&per_cu, (const void*)mk_fwd, NWAVES * 64, LDS_BYTES) != hipSuccess || per_cu < 1) fprintf(stderr, "kernel_launch: occupancy query reports %d\n", per_cu);
        (void)hipGetLastError();
        grid = 256;
    }
    if (grid < 0) return;
    (void)hipMemsetAsync((char*)d_ws + WS_CTL, 0, CTL_ZERO_BYTES, stream);
    Args a{};
    for (int i = 0; i < 18; ++i) a.in[i] = (const float*)d_in[i];
    a.out = (float*)d_out; a.ws = (unsigned char*)d_ws;
    for (int l = 0; l < DEPTH; ++l) a.linit[l] = (float)(0.8 - 0.6 * exp(-0.3 * (double)l));
#if MK_MULTI
    for (int p = 0; p < N_PHASES; ++p) { a.ph_lo = p; a.ph_hi = p + 1; hipLaunchKernelGGL(mk_fwd, dim3(grid), dim3(NWAVES * 64), LDS_BYTES, stream, a); }
#else
    a.ph_lo = 0; a.ph_hi = N_PHASES;
    hipLaunchKernelGGL(mk_fwd, dim3(grid), dim3(NWAVES * 64), LDS_BYTES, stream, a);
#endif
    const hipError_t le = hipPeekAtLastError();
    if (le != hipSuccess) fprintf(stderr, "kernel_launch: launch failed: %s\n", hipGetErrorName(le));
}
```

```cpp
#include <hip/hip_bf16.h>
#include <cmath>
#include <hip/hip_runtime.h>
#include <cstdio>
#include <cstdint>
namespace pg8 {
#define PG8_LAS __attribute__((address_space(3)))
typedef unsigned short bf16_t;
typedef short bf16x8 __attribute__((ext_vector_type(8)));
typedef float f32x4 __attribute__((ext_vector_type(4)));
typedef unsigned u32x4 __attribute__((ext_vector_type(4)));
constexpr int BM = 256, BK = 64, HALF = 128, HTB = HALF * BK * 2  , STAGE_BYTES = 8 * HTB, NXCD = 8, WGM = 4;

__host__ __device__ __forceinline__ int lds_byte(int r, int c) { const int st = (r >> 4) * 2 + (c >> 5), rr = r & 15, cc = c & 31, ob = rr * 64 + cc * 2; return st * 1024 + (ob ^ (((ob >> 9) & 1) << 5)); }
__host__ __device__ __forceinline__ void stage_rc(int b, int& R, int& C) { const int st = b / 1024, sb = b % 1024, swz = sb ^ (((sb >> 9) & 1) << 5); R = (st >> 1) * 16 + swz / 64; C = (st & 1) * 32 + (swz % 64) / 2; }
__host__ __device__ __forceinline__ int perm32(int rho) { const int n = rho >> 4, i = rho & 15; return 8 * (i >> 2) + 4 * n + (i & 3); }

struct Unit { int pm, pn; };
struct Gemm { const bf16_t* A; const bf16_t* Bt; int M, N, K; };

struct StaticOrder {
    int nM, nN, nwg, G, c;
    __host__ __device__ void init(int M, int N, int G_, int c_) { nM = M / BM; nN = N / BM; nwg = nM * nN; G = G_; c = c_; }
    __host__ __device__ bool next(int i, Unit& u) const {
        const long L = (long)i * G + c; if (L >= nwg) return false;
        int wgid = (int)L; { const int q = nwg / NXCD, r = nwg % NXCD, xcd = wgid % NXCD, off = wgid / NXCD; wgid = (xcd < r ? xcd * (q + 1) : r * (q + 1) + (xcd - r) * q) + off; }
        const int nig = WGM * nN, gid = wgid / nig, fm = gid * WGM, gsz = (nM - fm) < WGM ? (nM - fm) : WGM;
        u.pm = fm + ((wgid % nig) % gsz); u.pn = (wgid % nig) / gsz; return true;
    }
    __device__ __forceinline__ void a_ready(const Unit&) const {}
    __device__ __forceinline__ void done(const Unit&) const {}
};

typedef float f32x2_t_ __attribute__((ext_vector_type(2))); typedef __bf16 bf16x2_t_ __attribute__((ext_vector_type(2)));
__device__ __forceinline__ unsigned cvt_pk_bf16(float lo, float hi) { f32x2_t_ v = {lo, hi}; bf16x2_t_ b = __builtin_convertvector(v, bf16x2_t_); return __builtin_bit_cast(unsigned, b); }
constexpr int DM_ = 2048, FF_ = 5632, DIN_ = 6144, SEQ_ = 4096;
constexpr float RMS_EPS_ = 1e-6f;
template <int PAT> __device__ __forceinline__ float swz_xor(float v) { return __int_as_float(__builtin_amdgcn_ds_swizzle(__float_as_int(v), PAT)); }
__device__ __forceinline__ float half_swap_sum(float v) { auto rr = __builtin_amdgcn_permlane32_swap(__float_as_uint(v), __float_as_uint(v), false, false); return __uint_as_float(rr[0]) + __uint_as_float(rr[1]); }
__device__ __forceinline__ float wave_sum_nolane(float v) { v += swz_xor<0x041F>(v); v += swz_xor<0x081F>(v); v += swz_xor<0x101F>(v); v += swz_xor<0x201F>(v); v += swz_xor<0x401F>(v); return half_swap_sum(v); }
__device__ __forceinline__ float row_rstd(const float* ssq, int row) {
    const f32x4 a = *(const f32x4*)(ssq + (size_t)row * 8), b = *(const f32x4*)(ssq + (size_t)row * 8 + 4);
    const float s = ((a[0] + a[1]) + (a[2] + a[3])) + ((b[0] + b[1]) + (b[2] + b[3]));
    return 1.0f / sqrtf(s * (1.0f / DM_) + RMS_EPS_);
}
struct EpiSwiGLU {
    static constexpr bool PERM = true, AFTER_DRAIN = false;
    bf16_t* H; const float* ssq;
    __device__ __forceinline__ void operator()(const f32x4 (&acc)[2][2][4][2], const Unit& u, int wr, int wc, int fr, int fq) const {
        const int row0 = u.pm * BM + wr * 64 + fr, col0 = u.pn * HALF + wc * 32 + 8 * fq;
        float rsv[8];
#pragma unroll
        for (int q = 0; q < 8; ++q) rsv[q] = row_rstd(ssq, row0 + (q >> 2) * HALF + (q & 3) * 16);
#pragma unroll
        for (int ai = 0; ai < 2; ++ai)
#pragma unroll
            for (int m = 0; m < 4; ++m) { const int row = row0 + ai * HALF + m * 16; const float rs = rsv[ai * 4 + m], rsn = rs * -1.4426950408889634f, rs2 = rs * rs;
                f32x4 hv[2];
#pragma unroll
                for (int n = 0; n < 2; ++n) { const f32x4 g = acc[ai][0][m][n], up = acc[ai][1][m][n]; const f32x4 a = g * rsn; f32x4 e;
                    e[0] = __builtin_amdgcn_exp2f(a[0]); e[1] = __builtin_amdgcn_exp2f(a[1]); e[2] = __builtin_amdgcn_exp2f(a[2]); e[3] = __builtin_amdgcn_exp2f(a[3]);
                    const f32x4 d = e + 1.0f; f32x4 r; r[0] = __builtin_amdgcn_rcpf(d[0]); r[1] = __builtin_amdgcn_rcpf(d[1]); r[2] = __builtin_amdgcn_rcpf(d[2]); r[3] = __builtin_amdgcn_rcpf(d[3]);
                    hv[n] = (g * up) * (r * rs2); }
                u32x4 w; w.x = cvt_pk_bf16(hv[0][0], hv[0][1]); w.y = cvt_pk_bf16(hv[0][2], hv[0][3]); w.z = cvt_pk_bf16(hv[1][0], hv[1][1]); w.w = cvt_pk_bf16(hv[1][2], hv[1][3]);
                *(u32x4*)(H + (size_t)row * FF_ + col0) = w; }
    }
};
struct EpiQKV {
    static constexpr bool PERM = true, AFTER_DRAIN = false;
    bf16_t* QKV; const float* ssq; const float* rope; float qscale;
    __device__ __forceinline__ void operator()(const f32x4 (&acc)[2][2][4][2], const Unit& u, int wr, int wc, int fr, int fq) const {
        const int sec = u.pn >> 2; const bool rp = (sec == 3) || (sec == 4); const float qs = (sec == 0) ? qscale : 1.0f;
        const int row0 = u.pm * BM + wr * 64 + fr, i0 = 32 * (wc & 1) + 8 * fq;
        float rsv[8];
#pragma unroll
        for (int q = 0; q < 8; ++q) rsv[q] = row_rstd(ssq, row0 + (q >> 2) * HALF + (q & 3) * 16) * qs;
        bf16_t* pbase = QKV + (size_t)row0 * DIN_ + u.pn * BM + (wc >> 1) * HALF + i0;
        if (!rp) {
#pragma unroll
            for (int ai = 0; ai < 2; ++ai)
#pragma unroll
                for (int m = 0; m < 4; ++m) { const float rs = rsv[ai * 4 + m];
#pragma unroll
                    for (int bj = 0; bj < 2; ++bj) { const f32x4 v0 = acc[ai][bj][m][0] * rs, v1 = acc[ai][bj][m][1] * rs;
                        u32x4 w; w.x = cvt_pk_bf16(v0[0], v0[1]); w.y = cvt_pk_bf16(v0[2], v0[3]); w.z = cvt_pk_bf16(v1[0], v1[1]); w.w = cvt_pk_bf16(v1[2], v1[3]);
                        *(u32x4*)(pbase + (size_t)(ai * HALF + m * 16) * DIN_ + bj * 64) = w; } }
        } else {
#pragma unroll
            for (int ai = 0; ai < 2; ++ai)
#pragma unroll
                for (int mp = 0; mp < 2; ++mp) {
                    f32x4 csv[2][2], snv[2][2];
#pragma unroll
                    for (int k = 0; k < 2; ++k) { const int pos = (row0 + ai * HALF + (2 * mp + k) * 16) & (SEQ_ - 1);
#pragma unroll
                        for (int n = 0; n < 2; ++n) { csv[k][n] = *(const f32x4*)(rope + (size_t)pos * 64 + i0 + 4 * n); snv[k][n] = *(const f32x4*)(rope + (size_t)SEQ_ * 64 + (size_t)pos * 64 + i0 + 4 * n); } }
                    asm volatile("" ::: "memory");
#pragma unroll
                    for (int k = 0; k < 2; ++k) { const int m = 2 * mp + k; const float rs = rsv[ai * 4 + m];
                        f32x4 o0[2], o1[2];
#pragma unroll
                        for (int n = 0; n < 2; ++n) { const f32x4 lo = acc[ai][0][m][n] * rs, hi = acc[ai][1][m][n] * rs; o0[n] = lo * csv[k][n] - hi * snv[k][n]; o1[n] = hi * csv[k][n] + lo * snv[k][n]; }
                        bf16_t* p = pbase + (size_t)(ai * HALF + m * 16) * DIN_;
                        u32x4 a, b; a.x = cvt_pk_bf16(o0[0][0], o0[0][1]); a.y = cvt_pk_bf16(o0[0][2], o0[0][3]); a.z = cvt_pk_bf16(o0[1][0], o0[1][1]); a.w = cvt_pk_bf16(o0[1][2], o0[1][3]);
                        b.x = cvt_pk_bf16(o1[0][0], o1[0][1]); b.y = cvt_pk_bf16(o1[0][2], o1[0][3]); b.z = cvt_pk_bf16(o1[1][0], o1[1][1]); b.w = cvt_pk_bf16(o1[1][2], o1[1][3]);
                        *(u32x4*)p = a; *(u32x4*)(p + 64) = b; }
                    asm volatile("" ::: "memory"); }
        }
    }
};
typedef float f32x2v_ __attribute__((ext_vector_type(2)));
constexpr float LO_SCALE = 512.0f, LO_INV = 1.0f / 512.0f, LO_MAX = 224.0f;
__device__ __forceinline__ float lo_clamp(float d) { return __builtin_fminf(__builtin_fmaxf(d * LO_SCALE, -LO_MAX), LO_MAX); }
struct EpiResid {
    static constexpr bool PERM = true, AFTER_DRAIN = true;
    bf16_t* XB; unsigned char* XL; float* ssq; float alpha;
    __device__ __forceinline__ void fused(f32x4 (&acc)[2][2][4][2], const Unit& u, int wr, int wc, int fr, int fq, PG8_LAS unsigned char* lds, int wid, int lane) const {
        typedef unsigned u32x2 __attribute__((ext_vector_type(2)));
        PG8_LAS float* P = (PG8_LAS float*)lds;
        const int col0 = u.pn * BM + wc * 32 + 8 * fq;
#pragma unroll
        for (int ai = 0; ai < 2; ++ai) {
            u32x4 ph[4][2]; u32x2 pl[4][2];
#pragma unroll
            for (int m = 0; m < 4; ++m) { const size_t off = (size_t)(u.pm * BM + ai * HALF + wr * 64 + m * 16 + fr) * DM_ + col0;
#pragma unroll
                for (int bj = 0; bj < 2; ++bj) { ph[m][bj] = *(const u32x4*)(XB + off + bj * HALF); pl[m][bj] = *(const u32x2*)(XL + off + bj * HALF); } }
            asm volatile("" ::: "memory");
#pragma unroll
            for (int m = 0; m < 4; ++m) { const int r = ai * HALF + wr * 64 + m * 16 + fr; const size_t off = (size_t)(u.pm * BM + r) * DM_ + col0; float s = 0.f;
#pragma unroll
                for (int bj = 0; bj < 2; ++bj) { const u32x4 a = ph[m][bj]; const u32x2 b = pl[m][bj]; u32x4 wh; int wl0 = 0, wl1 = 0;
#pragma unroll
                    for (int q = 0; q < 4; ++q) {
                        const f32x2v_ l = (q & 1) ? __builtin_amdgcn_cvt_pk_f32_fp8((int)(q < 2 ? b.x : b.y), true) : __builtin_amdgcn_cvt_pk_f32_fp8((int)(q < 2 ? b.x : b.y), false);
                        const float x0 = __uint_as_float(a[q] << 16) + l.x * LO_INV, x1 = __uint_as_float(a[q] & 0xffff0000u) + l.y * LO_INV;
                        const float v0 = x0 + acc[ai][bj][m][q >> 1][(q & 1) * 2] * alpha, v1 = x1 + acc[ai][bj][m][q >> 1][(q & 1) * 2 + 1] * alpha;
                        const unsigned h = cvt_pk_bf16(v0, v1); wh[q] = h;
                        const float d0 = lo_clamp(v0 - __uint_as_float(h << 16)), d1 = lo_clamp(v1 - __uint_as_float(h & 0xffff0000u));
                        if (q == 0) wl0 = __builtin_amdgcn_cvt_pk_fp8_f32(d0, d1, wl0, false); else if (q == 1) wl0 = __builtin_amdgcn_cvt_pk_fp8_f32(d0, d1, wl0, true);
                        else if (q == 2) wl1 = __builtin_amdgcn_cvt_pk_fp8_f32(d0, d1, wl1, false); else wl1 = __builtin_amdgcn_cvt_pk_fp8_f32(d0, d1, wl1, true);
                        s += v0 * v0 + v1 * v1; }
                    *(u32x4*)(XB + off + bj * HALF) = wh; u32x2 wl; wl.x = (unsigned)wl0; wl.y = (unsigned)wl1; *(u32x2*)(XL + off + bj * HALF) = wl; }
                s += swz_xor<0x401F>(s); s = half_swap_sum(s);
                if (fq == 0) P[r * 4 + wc] = s; }
            asm volatile("" ::: "memory"); }
        asm volatile("s_waitcnt lgkmcnt(0)" ::: "memory"); __builtin_amdgcn_s_barrier(); asm volatile("" ::: "memory");
        const int t = wid * 64 + lane;
        if (t < 256) { const f32x4 p = *(const PG8_LAS f32x4*)(P + t * 4); ssq[(size_t)(u.pm * BM + t) * 8 + u.pn] = (p[0] + p[1]) + (p[2] + p[3]); }
        asm volatile("s_waitcnt lgkmcnt(0)" ::: "memory"); __builtin_amdgcn_s_barrier(); asm volatile("" ::: "memory");
    }
};

template <class Epi, class Sched, bool ALIGN_EPI = false, bool SP2 = false>
__device__ __forceinline__ void gemm_phase(PG8_LAS unsigned char* lds, const Gemm g, const Sched& S, const Epi& E, int tid_in) {
    int tid_ = tid_in; asm volatile("" : "+v"(tid_));
    const int tid = tid_, wid = __builtin_amdgcn_readfirstlane(tid >> 6), lane = tid & 63, wr = wid >> 2, wc = wid & 3, fr = lane & 15, fq = lane >> 4;
    const int K = g.K, nt = K / BK;
    unsigned voffA[2], voffB[2];
#pragma unroll
    for (int i = 0; i < 2; ++i) { int R, C; stage_rc(tid * 16 + i * 8192, R, C); const int Rb = Epi::PERM ? ((R & ~31) + perm32(R & 31)) : R;
        voffA[i] = (unsigned)(R * K + C) * 2u; voffB[i] = (unsigned)(Rb * K + C) * 2u; }
    const long kstep = (long)(BK * 2);
    const size_t hstep = (size_t)HALF * K * 2;
    const size_t tstep = 2 * hstep;
    const unsigned ldsw = (unsigned)wid * 1024u;
    const int aoff = lds_byte(wr * 64 + fr, fq * 8), boff = lds_byte(wc * 32 + fr, fq * 8);
#define PG8_SA(b, h) (((b) * 2 + (h)) * HTB)
#define PG8_SB(b, h) ((4 + (b) * 2 + (h)) * HTB)
#define PG8_STAGE(bufoff, gbase, voff) do { _Pragma("unroll") for (int _i = 0; _i < 2; ++_i) \
        __builtin_amdgcn_global_load_lds((const unsigned*)((const char*)(gbase) + (voff)[_i]), (PG8_LAS unsigned*)(lds + (bufoff) + ldsw + _i * 8192), 16, 0, 0); } while (0)
#define PG8_LDA(dst, b, h) do { _Pragma("unroll") for (int m = 0; m < 4; ++m) _Pragma("unroll") for (int k = 0; k < 2; ++k) dst[m][k] = *(const PG8_LAS bf16x8*)(lds + PG8_SA(b, h) + aoff + m * 2048 + k * 1024); } while (0)
#define PG8_LDB(dst, b, h) do { _Pragma("unroll") for (int n = 0; n < 2; ++n) _Pragma("unroll") for (int k = 0; k < 2; ++k) dst[n][k] = *(const PG8_LAS bf16x8*)(lds + PG8_SB(b, h) + boff + n * 2048 + k * 1024); } while (0)
#define PG8_MMA(ai, bj, At, Bt) do { __builtin_amdgcn_s_setprio(1); _Pragma("unroll") for (int m = 0; m < 4; ++m) _Pragma("unroll") for (int n = 0; n < 2; ++n) _Pragma("unroll") for (int k = 0; k < 2; ++k) \
        acc[ai][bj][m][n] = __builtin_amdgcn_mfma_f32_16x16x32_bf16(Bt[n][k], At[m][k], acc[ai][bj][m][n], 0, 0, 0); __builtin_amdgcn_s_setprio(0); } while (0)
#define PG8_WAIT_V(n) asm volatile("s_waitcnt vmcnt(" #n ")" ::: "memory")
#define PG8_WAIT_L(n) asm volatile("s_waitcnt lgkmcnt(" #n ")" ::: "memory")
#define PG8_BAR __builtin_amdgcn_s_barrier()
#define PG8_SCHED __builtin_amdgcn_sched_barrier(0)
    Unit cur, nxt; int ui = 0;
    if (!S.next(0, cur)) return;
    f32x4 acc[2][2][4][2];
#pragma unroll
    for (int a = 0; a < 2; ++a)
#pragma unroll
        for (int b = 0; b < 2; ++b)
#pragma unroll
            for (int m = 0; m < 4; ++m)
#pragma unroll
                for (int n = 0; n < 2; ++n) acc[a][b][m][n] = (f32x4){0.f, 0.f, 0.f, 0.f};
    bf16x8 At[4][2], B0[2][2], B1[2][2];
    const char* cA = (const char*)g.A + (size_t)cur.pm * tstep; const char* cB = (const char*)g.Bt + (size_t)cur.pn * tstep;
    long ks = kstep;
    S.a_ready(cur);
    if constexpr (SP2) {
        PG8_STAGE(PG8_SB(0, 0), cB, voffB); PG8_STAGE(PG8_SB(0, 1), cB + hstep, voffB); PG8_STAGE(PG8_SA(0, 0), cA, voffA); PG8_STAGE(PG8_SA(0, 1), cA + hstep, voffA);
        if (wr == 1) PG8_BAR;
        PG8_WAIT_V(2); PG8_BAR;
        PG8_STAGE(PG8_SB(1, 0), cB + kstep, voffB); PG8_STAGE(PG8_SA(1, 0), cA + kstep, voffA); PG8_STAGE(PG8_SB(1, 1), cB + hstep + kstep, voffB);
        PG8_WAIT_V(6); PG8_BAR;
    } else {
        PG8_STAGE(PG8_SB(0, 0), cB, voffB); PG8_STAGE(PG8_SA(0, 0), cA, voffA); PG8_STAGE(PG8_SB(0, 1), cB + hstep, voffB); PG8_STAGE(PG8_SA(0, 1), cA + hstep, voffA);
        if (wr == 1) PG8_BAR;
        PG8_WAIT_V(4); PG8_BAR;
        PG8_STAGE(PG8_SB(1, 0), cB + kstep, voffB); PG8_STAGE(PG8_SA(1, 0), cA + kstep, voffA); PG8_STAGE(PG8_SB(1, 1), cB + hstep + kstep, voffB);
        PG8_WAIT_V(6); PG8_BAR;
    }
    for (;;) {
        const bool has_next = S.next(ui + 1, nxt);
        const long nks = has_next ? -ks : ks; const size_t noff = (nks < 0) ? (size_t)(nt - 1) * (size_t)kstep : 0;
        const char* nA = has_next ? (const char*)g.A + (size_t)nxt.pm * tstep + noff : cA; const char* nB = has_next ? (const char*)g.Bt + (size_t)nxt.pn * tstep + noff : cB;
        for (int t = 0; t < nt; t += 2) {
            const bool last = (t == nt - 2);
            const char* a1 = cA + (long)(t + 1) * ks;
            const char* a2 = last ? nA : cA + (long)(t + 2) * ks; const char* b2 = last ? nB : cB + (long)(t + 2) * ks;
            const long ks3 = last ? nks : ks; const char* a3 = a2 + ks3; const char* b3 = b2 + ks3;
            if (last && has_next) S.a_ready(nxt);
            if constexpr (SP2) {
            PG8_LDB(B0, 0, 0); PG8_LDB(B1, 0, 1); PG8_SCHED; PG8_LDA(At, 0, 0); PG8_STAGE(PG8_SA(1, 1), a1 + hstep, voffA);
            PG8_WAIT_V(8); PG8_WAIT_L(0); PG8_BAR; PG8_MMA(0, 0, At, B0); PG8_MMA(0, 1, At, B1); PG8_BAR; PG8_SCHED;
            PG8_LDA(At, 0, 1); PG8_STAGE(PG8_SB(0, 0), b2, voffB); PG8_STAGE(PG8_SB(0, 1), b2 + hstep, voffB); PG8_STAGE(PG8_SA(0, 0), a2, voffA);
            PG8_WAIT_V(8); PG8_WAIT_L(0); PG8_BAR; PG8_MMA(1, 0, At, B0); PG8_MMA(1, 1, At, B1); PG8_BAR; PG8_SCHED;
            PG8_LDB(B0, 1, 0); PG8_LDB(B1, 1, 1); PG8_SCHED; PG8_LDA(At, 1, 0); PG8_STAGE(PG8_SA(0, 1), a2 + hstep, voffA);
            PG8_WAIT_V(8); PG8_WAIT_L(0); PG8_BAR; PG8_MMA(0, 0, At, B0); PG8_MMA(0, 1, At, B1); PG8_BAR; PG8_SCHED;
            PG8_LDA(At, 1, 1); PG8_STAGE(PG8_SB(1, 0), b3, voffB); PG8_STAGE(PG8_SB(1, 1), b3 + hstep, voffB); PG8_STAGE(PG8_SA(1, 0), a3, voffA);
            PG8_WAIT_V(8); PG8_WAIT_L(0); PG8_BAR; PG8_MMA(1, 0, At, B0); PG8_MMA(1, 1, At, B1); PG8_BAR; PG8_SCHED;
            } else {
            PG8_LDB(B0, 0, 0); PG8_SCHED; PG8_LDA(At, 0, 0); PG8_STAGE(PG8_SA(1, 1), a1 + hstep, voffA);
            PG8_WAIT_L(8); PG8_BAR; PG8_WAIT_L(0); PG8_MMA(0, 0, At, B0); PG8_BAR; PG8_SCHED;
            PG8_LDB(B1, 0, 1); PG8_STAGE(PG8_SB(0, 0), b2, voffB);
            PG8_BAR; PG8_WAIT_L(0); PG8_MMA(0, 1, At, B1); PG8_BAR;
            PG8_LDA(At, 0, 1); PG8_STAGE(PG8_SA(0, 0), a2, voffA);
            PG8_BAR; PG8_WAIT_L(0); PG8_MMA(1, 0, At, B0); PG8_BAR; PG8_SCHED;
            PG8_STAGE(PG8_SB(0, 1), b2 + hstep, voffB);
            PG8_WAIT_V(6); PG8_BAR; PG8_MMA(1, 1, At, B1); PG8_BAR;
            PG8_LDB(B0, 1, 0); PG8_SCHED; PG8_LDA(At, 1, 0); PG8_STAGE(PG8_SA(0, 1), a2 + hstep, voffA);
            PG8_WAIT_L(8); PG8_BAR; PG8_WAIT_L(0); PG8_MMA(0, 0, At, B0); PG8_BAR; PG8_SCHED;
            PG8_LDB(B1, 1, 1); PG8_STAGE(PG8_SB(1, 0), b3, voffB);
            PG8_BAR; PG8_WAIT_L(0); PG8_MMA(0, 1, At, B1); PG8_BAR;
            PG8_LDA(At, 1, 1); PG8_STAGE(PG8_SA(1, 0), a3, voffA);
            PG8_BAR; PG8_WAIT_L(0); PG8_MMA(1, 0, At, B0); PG8_BAR; PG8_SCHED;
            PG8_STAGE(PG8_SB(1, 1), b3 + hstep, voffB);
            PG8_WAIT_V(6); PG8_BAR; PG8_MMA(1, 1, At, B1); PG8_BAR;
            }
        }
        if constexpr (ALIGN_EPI) { if (wr == 0) PG8_BAR; }
        if constexpr (!Epi::AFTER_DRAIN) { E(acc, cur, wr, wc, fr, fq); S.done(cur); }
        if (!has_next) break;
#pragma unroll
        for (int a = 0; a < 2; ++a)
#pragma unroll
            for (int b = 0; b < 2; ++b)
#pragma unroll
                for (int m = 0; m < 4; ++m)
#pragma unroll
                    for (int n = 0; n < 2; ++n) acc[a][b][m][n] = (f32x4){0.f, 0.f, 0.f, 0.f};
        cur = nxt; cA = nA; cB = nB; ks = nks; ++ui;
        if constexpr (ALIGN_EPI) { if (wr == 1) PG8_BAR; }
    }
    PG8_WAIT_V(0);
    if constexpr (!ALIGN_EPI) { if (wr == 0) PG8_BAR; }
    PG8_BAR;
    if constexpr (Epi::AFTER_DRAIN) { E.fused(acc, cur, wr, wc, fr, fq, lds, wid, lane); S.done(cur); }
#undef PG8_SA
#undef PG8_SB
#undef PG8_STAGE
#undef PG8_LDA
#undef PG8_LDB
#undef PG8_MMA
#undef PG8_WAIT_V
#undef PG8_WAIT_L
#undef PG8_BAR
#undef PG8_SCHED
}
}
namespace dattn {
constexpr int D = 128;
constexpr int QP = 6144, KVP = 6144, OP = 1024;
constexpr float THR = 8.f;
constexpr bool WSKIP = false;
constexpr float SCALE = 0.08838834764831845f;
constexpr int NW = 8, QBLK = 32, KVBLK = 64, QB = NW * QBLK;
constexpr int SHM_V = KVBLK * D * 2, SHM_K = KVBLK * D * 2;
constexpr int LDS_BYTES = 2 * SHM_V + 2 * SHM_K + NW * 64 * 4;
using bf16 = __hip_bfloat16;
typedef short bf16x8 __attribute__((ext_vector_type(8)));
typedef short s16x4 __attribute__((ext_vector_type(4)));
typedef float f32x16 __attribute__((ext_vector_type(16)));
typedef float f32x4 __attribute__((ext_vector_type(4)));
typedef unsigned u32x4 __attribute__((ext_vector_type(4)));
template <class A, class Bt> struct same_t { static constexpr bool v = false; };
template <class A> struct same_t<A, A> { static constexpr bool v = true; };

#define KSWZ(row, colB) ((row) * 256 + ((colB) ^ (((row) & 7) << 4)))
#define SBAR() __builtin_amdgcn_sched_barrier(0)
__device__ __forceinline__ int v_st(int k, int c) { const int kk = (k & ~0xC) | ((k & 4) << 1) | ((k & 8) >> 1); return ((kk >> 3) * 4 + (c >> 5)) * 512 + ((kk & 7) * 32 + (c & 31)) * 2; }
__device__ __forceinline__ int v_rd_base(int lane) { return ((lane & 3) << 3) | (((lane >> 2) & 3) << 6) | (((lane >> 4) & 1) << 5) | (((lane >> 5) & 1) << 8); }
constexpr int v_rd_off(int d0, int ks, int half) { return d0 * 512 + ks * 4096 + half * 2048; }
__device__ __forceinline__ int crow(int r, int hi) { return (r & 3) + 8 * (r >> 2) + 4 * hi; }
__device__ __forceinline__ unsigned cvtpk(float lo, float hi) {
    unsigned r; asm volatile("v_cvt_pk_bf16_f32 %0, %1, %2" : "=v"(r) : "v"(lo), "v"(hi)); return r;
}
__device__ __forceinline__ bf16x8 pack8(f32x4 a, f32x4 b) {
    u32x4 w = {cvtpk(a[0], a[1]), cvtpk(a[2], a[3]), cvtpk(b[0], b[1]), cvtpk(b[2], b[3])};
    return *reinterpret_cast<bf16x8*>(&w);
}
template <class T> __device__ __forceinline__ bf16x8 load8(const T* p) {
    if constexpr (same_t<T, float>::v) { return pack8(*(const f32x4*)p, *(const f32x4*)(p + 4)); }
    else { return *reinterpret_cast<const bf16x8*>(p); }
}
__device__ __forceinline__ void mask_tile(f32x16& p0, f32x16& p1, int dq, unsigned W) {
    const float NEG = -__builtin_inff();
#pragma unroll
    for (int r = 0; r < 16; ++r) {
        const int c = (r & 3) + 8 * (r >> 2);
        if ((unsigned)(dq - c) >= W) p0[r] = NEG;
        if ((unsigned)(dq - c - 32) >= W) p1[r] = NEG;
    }
}
__device__ __forceinline__ void partialSM(f32x16& p0, f32x16& p1, float& m_reg, float& mn, float& alpha) {
    float pmax = p0[0]; for (int r = 1; r < 16; ++r) pmax = fmaxf(pmax, p0[r]); for (int r = 0; r < 16; ++r) pmax = fmaxf(pmax, p1[r]);
    { auto rr = __builtin_amdgcn_permlane32_swap(__float_as_uint(pmax), __float_as_uint(pmax), false, false);
      pmax = fmaxf(__uint_as_float(rr[0]), __uint_as_float(rr[1])); }
    constexpr float C2 = 1.4426950408889634f * SCALE;
    if (__builtin_expect(__all((pmax - m_reg) * SCALE <= THR), 1)) { mn = m_reg; alpha = 1.f; }
    else { mn = fmaxf(m_reg, pmax); alpha = __builtin_amdgcn_exp2f((m_reg - mn) * C2); m_reg = mn; }
    const float mnL = -mn * C2;
    for (int r = 0; r < 16; ++r) p0[r] = fmaf(p0[r], C2, mnL); for (int r = 0; r < 16; ++r) p1[r] = fmaf(p1[r], C2, mnL);
    for (int r = 0; r < 16; ++r) p0[r] = __builtin_amdgcn_exp2f(p0[r]);
}
__device__ __forceinline__ void finishSM(f32x16& p0, f32x16& p1, float alpha, float& l_reg, bf16x8& pa0, bf16x8& pa1, bf16x8& pa2, bf16x8& pa3) {
    for (int r = 0; r < 16; ++r) p1[r] = __builtin_amdgcn_exp2f(p1[r]);
    float ps = 0; for (int r = 0; r < 16; ++r) ps += p0[r]; for (int r = 0; r < 16; ++r) ps += p1[r];
    { auto rr = __builtin_amdgcn_permlane32_swap(__float_as_uint(ps), __float_as_uint(ps), false, false);
      ps = __uint_as_float(rr[0]) + __uint_as_float(rr[1]); }
    l_reg = l_reg * alpha + ps;
#define PK4(P, B_, OUT) do { unsigned a0 = cvtpk(P[B_+0], P[B_+1]), a1 = cvtpk(P[B_+2], P[B_+3]);                          \
        unsigned b0 = cvtpk(P[B_+4], P[B_+5]), b1 = cvtpk(P[B_+6], P[B_+7]);                                             \
        auto r0 = __builtin_amdgcn_permlane32_swap(a0, b0, false, false); auto r1 = __builtin_amdgcn_permlane32_swap(a1, b1, false, false); \
        u32x4 w = {r0[0], r1[0], r0[1], r1[1]}; OUT = *reinterpret_cast<bf16x8*>(&w); } while (0)
    PK4(p0, 0, pa0); PK4(p0, 8, pa1); PK4(p1, 0, pa2); PK4(p1, 8, pa3);
#undef PK4
}
template <int KB, bool SK>
__device__ __forceinline__ void qkt(f32x16& p0, f32x16& p1, const char* K_lds, int r32, int hi, const bf16x8* qr, bool act) {
    if (SK && !act) { const float NEG = -__builtin_inff();
#pragma unroll
        for (int r = 0; r < 16; ++r) { p0[r] = NEG; p1[r] = NEG; } return; }
    p0 = f32x16{}; p1 = f32x16{};
    const char* kb[4];
#pragma unroll
    for (int dd = 0; dd < 4; ++dd) kb[dd] = K_lds + KB * SHM_K + KSWZ(r32, (dd * 16 + hi * 8) * 2);
#pragma unroll
    for (int d0 = 0; d0 < 8; ++d0) { const char* a = kb[d0 & 3] + (d0 >> 2) * 128;
        bf16x8 b0 = *reinterpret_cast<const bf16x8*>(a);
        bf16x8 b1 = *reinterpret_cast<const bf16x8*>(a + 32 * 256);
        p0 = __builtin_amdgcn_mfma_f32_32x32x16_bf16(b0, qr[d0], p0, 0, 0, 0);
        p1 = __builtin_amdgcn_mfma_f32_32x32x16_bf16(b1, qr[d0], p1, 0, 0, 0); }
}
template <int VB, bool SK>
__device__ __forceinline__ void pv_tile(f32x16* o, int vb0, bf16x8 pa0, bf16x8 pa1, bf16x8 pa2, bf16x8 pa3, bool act) {
    if (SK && !act) return;
#define TRRD(dst, off) asm volatile("ds_read_b64_tr_b16 %0, %1 offset:%2" : "=&v"(dst) : "v"(vb0), "i"(off) : "memory")
#define PV_D0(d0) do { s16x4 l0, l1, l2, l3, h0, h1, h2, h3; constexpr int b_ = VB * SHM_V + v_rd_off(d0, 0, 0);     \
        TRRD(l0, b_); TRRD(h0, b_ + 2048); TRRD(l1, b_ + 4096); TRRD(h1, b_ + 6144); TRRD(l2, b_ + 8192); TRRD(h2, b_ + 10240); TRRD(l3, b_ + 12288); TRRD(h3, b_ + 14336); \
        asm volatile("s_waitcnt lgkmcnt(0)" ::: "memory"); SBAR();                 \
        o[d0] = __builtin_amdgcn_mfma_f32_32x32x16_bf16(pa0, (bf16x8){l0[0], l0[1], l0[2], l0[3], h0[0], h0[1], h0[2], h0[3]}, o[d0], 0, 0, 0);   \
        o[d0] = __builtin_amdgcn_mfma_f32_32x32x16_bf16(pa1, (bf16x8){l1[0], l1[1], l1[2], l1[3], h1[0], h1[1], h1[2], h1[3]}, o[d0], 0, 0, 0);   \
        o[d0] = __builtin_amdgcn_mfma_f32_32x32x16_bf16(pa2, (bf16x8){l2[0], l2[1], l2[2], l2[3], h2[0], h2[1], h2[2], h2[3]}, o[d0], 0, 0, 0);   \
        o[d0] = __builtin_amdgcn_mfma_f32_32x32x16_bf16(pa3, (bf16x8){l3[0], l3[1], l3[2], l3[3], h3[0], h3[1], h3[2], h3[3]}, o[d0], 0, 0, 0); } while (0)
    PV_D0(0); PV_D0(1); PV_D0(2); PV_D0(3);
#undef PV_D0
#undef TRRD
}

template <class TIn, class TOut> struct BlockRef { const TIn* Q; const TIn* K; const TIn* V; TOut* O; int P0; };
template <class TIn> struct Seam {
    bf16x8 qr[8];
    bf16x8 st_v0, st_v1, st_k0, st_k1; f32x4 sf0, sf1, sf2, sf3;
    f32x4 tq[16];
};
__device__ __forceinline__ int swa_jlo(int P0, int W) { const int lowk = P0 - W + 1; return lowk > 0 ? lowk / KVBLK : 0; }
#define ROW(p, k0, rr) ((p) + (size_t)((k0) + (rr)) * KVP + sc)
#define VMW() asm volatile("s_waitcnt vmcnt(0)" ::: "memory")
#define VMWN(n) asm volatile("s_waitcnt vmcnt(%0)" :: "i"(n) : "memory")
#define SLOAD_H(Kp, Vp, k0) do { S.st_v0 = load8<TIn>(ROW(Vp, k0, sr)); S.st_v1 = load8<TIn>(ROW(Vp, k0, 32 + sr));              \
                         S.st_k0 = load8<TIn>(ROW(Kp, k0, sr)); S.st_k1 = load8<TIn>(ROW(Kp, k0, 32 + sr)); } while (0)
#define SWRITE_HK(bf) do { *(bf16x8*)(K_lds + (bf) * SHM_K + kws) = S.st_k0; *(bf16x8*)(K_lds + (bf) * SHM_K + kws + 32 * 256) = S.st_k1; } while (0)
#define SWRITE_HV(bf) do { *(bf16x8*)(V_lds + (bf) * SHM_V + vst0) = S.st_v0; *(bf16x8*)(V_lds + (bf) * SHM_V + vst1) = S.st_v1; } while (0)
#define SWRITE_H(bf) do { SWRITE_HV(bf); SWRITE_HK(bf); } while (0)
#define SLOAD_F(p, k0) do { S.sf0 = *(const f32x4*)ROW(p, k0, sr); S.sf1 = *(const f32x4*)(ROW(p, k0, sr) + 4);                \
                            S.sf2 = *(const f32x4*)ROW(p, k0, 32 + sr); S.sf3 = *(const f32x4*)(ROW(p, k0, 32 + sr) + 4); } while (0)
#define SWRITE_KF(bf) do { *(bf16x8*)(K_lds + (bf) * SHM_K + kws) = pack8(S.sf0, S.sf1); *(bf16x8*)(K_lds + (bf) * SHM_K + kws + 32 * 256) = pack8(S.sf2, S.sf3); } while (0)
#define SWRITE_VF(bf) do { *(bf16x8*)(V_lds + (bf) * SHM_V + vst0) = pack8(S.sf0, S.sf1); *(bf16x8*)(V_lds + (bf) * SHM_V + vst1) = pack8(S.sf2, S.sf3); } while (0)
template <class TIn, class TOut>
__device__ __forceinline__ void causal_swa_prime(const BlockRef<TIn, TOut>& cur, int W, char* lds, Seam<TIn>& S, int tid_in) {
    constexpr bool F32 = same_t<TIn, float>::v;
    int tid_ = tid_in; asm volatile("" : "+v"(tid_));
    const int tid = tid_, wid = __builtin_amdgcn_readfirstlane(tid >> 6), lane = tid & 63, r32 = lane & 31, hi = lane >> 5;
    const int sr = tid >> 4, sc = (tid & 15) * 8, kws = KSWZ(sr, sc * 2); char* K_lds = lds + 2 * SHM_V;
    const int kb0 = swa_jlo(cur.P0, W) * KVBLK;
    for (int d0 = 0; d0 < 8; ++d0) S.qr[d0] = load8<TIn>(cur.Q + (size_t)(wid * QBLK + r32) * QP + d0 * 16 + hi * 8);
    if constexpr (F32) { SLOAD_F((const float*)cur.K, kb0); VMW(); SWRITE_KF(0); SBAR(); SLOAD_F((const float*)cur.V, kb0); }
    else { SLOAD_H(cur.K, cur.V, kb0); VMW(); SWRITE_HK(0); }
    __syncthreads();
}
template <class TIn, class TOut>
__device__ __forceinline__ void causal_swa_block(const BlockRef<TIn, TOut>& cur, const BlockRef<TIn, TOut>& nxt, int skv, int W, char* lds, Seam<TIn>& S, int tid_in) {
    constexpr bool F32 = same_t<TIn, float>::v;
    int tid_ = tid_in; asm volatile("" : "+v"(tid_));
    const int tid = tid_, wid = __builtin_amdgcn_readfirstlane(tid >> 6), lane = tid & 63, r32 = lane & 31, hi = lane >> 5;
    const int j_lo = swa_jlo(cur.P0, W);
    int j_hi = (cur.P0 + QB - 1) / KVBLK + 1; if (j_hi > skv / KVBLK) j_hi = skv / KVBLK;
    const int NT = j_hi - j_lo;
    const int kbn = swa_jlo(nxt.P0, W) * KVBLK;
    const int qlo = cur.P0 + wid * QBLK, qm = qlo + r32 - 4 * hi;
    char* V_lds = lds; char* K_lds = lds + 2 * SHM_V;
    float* ws = (float*)(lds + 2 * SHM_V + 2 * SHM_K) + wid * 64; float* li_l = ws, * al_l = ws + 32;
    float m_reg = -1e30f, l_reg = 0; f32x16 o[4] = {};
    const int sr = tid >> 4, sc = (tid & 15) * 8, vst0 = v_st(sr, sc), vst1 = v_st(32 + sr, sc), kws = KSWZ(sr, sc * 2);
    const int vb0 = (int)(uintptr_t)V_lds + v_rd_base(lane);
    const TIn* Kh = cur.K; const TIn* Vh = cur.V;
#define RESC(a) do { if (__any((a) < 1.f)) { if (hi == 0) al_l[r32] = (a); asm volatile("s_waitcnt lgkmcnt(0)" ::: "memory");              \
                     for (int d_ = 0; d_ < 4; ++d_) for (int r = 0; r < 16; ++r) o[d_][r] *= al_l[crow(r, hi)]; } } while (0)
#define KBASE(t) ((j_lo + (t)) * KVBLK)
#define ACT(t) (KBASE(t) <= qlo + QBLK - 1 && KBASE(t) + KVBLK - 1 >= qlo - W + 1)
#define MASKT(P0_, P1_, t) do { const int kb_ = KBASE(t); if ((!SK || ACT(t)) && (kb_ + KVBLK - 1 > qlo || kb_ <= qlo + QBLK - 1 - W)) mask_tile(P0_, P1_, qm - kb_, (unsigned)W); } while (0)
    constexpr int NQL = F32 ? 16 : 8;
    constexpr bool SK = WSKIP && !F32;
#define SEAM_K0() do { VMWN(NQL); if constexpr (F32) { SWRITE_KF(0); SBAR(); SLOAD_F((const float*)nxt.V, kbn); } else { SWRITE_HK(0); } SBAR(); } while (0)
    f32x16 pA0, pA1, pB0, pB1; float mnA, mnB, alA, alB; bf16x8 pa0, pa1, pa2, pa3;
    if constexpr (F32) { VMW(); SWRITE_VF(0); SBAR(); } else { SWRITE_HV(0); SBAR(); }
    if (NT > 1) { if constexpr (F32) SLOAD_F((const float*)Kh, KBASE(1)); else SLOAD_H(Kh, Vh, KBASE(1)); }
    SBAR(); qkt<0, SK>(pA0, pA1, K_lds, r32, hi, S.qr, ACT(0));
    if constexpr (F32) { if (NT > 1) { VMW(); SWRITE_KF(1); SBAR(); SLOAD_F((const float*)Vh, KBASE(1)); } }
    MASKT(pA0, pA1, 0); partialSM(pA0, pA1, m_reg, mnA, alA);
    if (NT > 1) { VMW(); if constexpr (F32) { SWRITE_VF(1); SBAR(); if (NT > 2) SLOAD_F((const float*)Kh, KBASE(2)); } else SWRITE_H(1); }
    __syncthreads();
#define HALF_STEP(PX0, PX1, mnX, alX, PY0, PY1, alY, t, KB, VB, SB) do {                                                      \
        SBAR(); qkt<KB, SK>(PX0, PX1, K_lds, r32, hi, S.qr, ACT(t));                                             \
        finishSM(PY0, PY1, alY, l_reg, pa0, pa1, pa2, pa3); SBAR();                                                           \
        if ((t) + 1 < NT) { if constexpr (F32) { VMW(); SWRITE_KF(SB); SBAR(); SLOAD_F((const float*)Vh, KBASE((t) + 1)); }  \
                            else { SLOAD_H(Kh, Vh, KBASE((t) + 1)); } SBAR(); }                                               \
        pv_tile<VB, SK>(o, vb0, pa0, pa1, pa2, pa3, ACT((t) - 1)); MASKT(PX0, PX1, (t)); partialSM(PX0, PX1, m_reg, mnX, alX);                                        \
        __syncthreads();                                                                                                      \
        if ((t) + 1 < NT) { VMW(); if constexpr (F32) { SWRITE_VF(SB); SBAR(); if ((t) + 2 < NT) SLOAD_F((const float*)Kh, KBASE((t) + 2)); } \
                            else { SWRITE_H(SB); } }                                                                          \
        RESC(alX); __syncthreads(); } while (0)
    for (int t = 1; t + 1 < NT; t += 2) {
        HALF_STEP(pB0, pB1, mnB, alB, pA0, pA1, alA, t, 1, 0, 0);
        HALF_STEP(pA0, pA1, mnA, alA, pB0, pB1, alB, t + 1, 0, 1, 1);
    }
    const bool even = (NT & 1) == 0;
    if (even) { SBAR(); qkt<1, SK>(pB0, pB1, K_lds, r32, hi, S.qr, ACT(NT - 1)); SBAR(); }
#define QROW(e) (nxt.Q + (size_t)(wid * QBLK + r32) * QP + ((e) >> 1) * 16 + hi * 8 + ((e) & 1) * 4)
    if constexpr (F32) { SLOAD_F((const float*)nxt.K, kbn); SBAR();
#pragma unroll
        for (int e = 0; e < 8; ++e) S.tq[e] = *(const f32x4*)QROW(e); }
    else { SLOAD_H(nxt.K, nxt.V, kbn); SBAR();
#pragma unroll
        for (int d0 = 0; d0 < 8; ++d0) S.qr[d0] = load8<TIn>(nxt.Q + (size_t)(wid * QBLK + r32) * QP + d0 * 16 + hi * 8); }
    SBAR();
    finishSM(pA0, pA1, alA, l_reg, pa0, pa1, pa2, pa3); SBAR();
    if constexpr (F32) {
#pragma unroll
        for (int e = 8; e < 16; ++e) S.tq[e] = *(const f32x4*)QROW(e); SBAR(); }
#undef QROW
    pv_tile<0, SK>(o, vb0, pa0, pa1, pa2, pa3, ACT(even ? NT - 2 : NT - 1));
    if (even) { MASKT(pB0, pB1, NT - 1); partialSM(pB0, pB1, m_reg, mnB, alB); __syncthreads(); RESC(alB);
        finishSM(pB0, pB1, alB, l_reg, pa0, pa1, pa2, pa3); SBAR(); pv_tile<1, SK>(o, vb0, pa0, pa1, pa2, pa3, ACT(NT - 1)); }
    SBAR(); SEAM_K0();
    if (hi == 0) li_l[r32] = l_reg; asm volatile("s_waitcnt lgkmcnt(0)" ::: "memory");
    float rli[16];
#pragma unroll
    for (int r = 0; r < 16; ++r) rli[r] = __builtin_amdgcn_rcpf(li_l[crow(r, hi)]);
    TOut* Ow = cur.O + (size_t)(wid * QBLK) * OP;
#pragma unroll
    for (int r = 0; r < 16; ++r) { const int orow = crow(r, hi);
#pragma unroll
        for (int d0 = 0; d0 < 4; ++d0) { const float v = o[d0][r] * rli[r];
            if constexpr (same_t<TOut, float>::v) { Ow[(size_t)orow * OP + d0 * 32 + r32] = v; }
            else { const float vn = __shfl_xor(v, 1);
                   if ((r32 & 1) == 0) *(unsigned*)(Ow + (size_t)orow * OP + d0 * 32 + r32) = cvtpk(v, vn); } } }
    if constexpr (F32) {
#pragma unroll
        for (int d0 = 0; d0 < 8; ++d0) S.qr[d0] = pack8(S.tq[2 * d0], S.tq[2 * d0 + 1]); }
    __syncthreads();
#undef RESC
#undef KBASE
#undef ACT
#undef MASKT
#undef SEAM_K0
#undef HALF_STEP
}
#undef ROW
#undef VMW
#undef VMWN
#undef SLOAD_H
#undef SWRITE_HK
#undef SWRITE_HV
#undef SWRITE_H
#undef SLOAD_F
#undef SWRITE_KF
#undef SWRITE_VF


}
namespace dattn {
template <bool MASK> __device__ __forceinline__ void sb_half(f32x16& p, float& Px, float R, int dq, int hi) {
    float om[16];
#pragma unroll
    for (int r = 0; r < 16; ++r) {
        const int c = (r & 3) + 8 * (r >> 2);
        const float e = __builtin_amdgcn_exp2f(-fmaxf(p[r], -126.0f)); float b = __builtin_amdgcn_rcpf(1.0f + e), o = e * b;
        if (MASK) { const bool in = c < dq; b = in ? b : 0.f; o = in ? o : 1.0f; } om[r] = o; p[r] = b;
    }
    float E[4];
#pragma unroll
    for (int g = 3; g >= 0; --g) {
        const float s0 = (om[4 * g] * om[4 * g + 1]) * (om[4 * g + 2] * om[4 * g + 3]);
        auto rr = __builtin_amdgcn_permlane32_swap(__float_as_uint(s0), __float_as_uint(s0), false, false);
        const float ga = __uint_as_float(rr[0]), gb = __uint_as_float(rr[1]);
        E[g] = (hi ? Px : Px * gb) * R; Px *= ga * gb;
    }
#pragma unroll
    for (int g = 0; g < 4; ++g) {
        const float c3 = E[g], c2 = c3 * om[4 * g + 3], c1 = c2 * om[4 * g + 2], c0 = c1 * om[4 * g + 1];
        p[4 * g + 3] *= c3; p[4 * g + 2] *= c2; p[4 * g + 1] *= c1; p[4 * g] *= c0;
    }
}
template <int OPB> __device__ __forceinline__ void sb_unit(const bf16* Qh, const bf16* Kh, const bf16* Vh, bf16* Oh, int P0, float EXIT, char* lds, int tid_in) {
    int tid_ = tid_in; asm volatile("" : "+v"(tid_));
    const int tid = tid_, wid = __builtin_amdgcn_readfirstlane(tid >> 6), lane = tid & 63, r32 = lane & 31, hi = lane >> 5;
    char* V_lds = lds; char* K_lds = lds + 2 * SHM_V; unsigned* flags = (unsigned*)(lds + 2 * SHM_V + 2 * SHM_K);
    const int sr = tid >> 4, sc = (tid & 15) * 8, vst0 = v_st(sr, sc), vst1 = v_st(32 + sr, sc), kws = KSWZ(sr, sc * 2);
    const int vb0 = (int)(uintptr_t)V_lds + v_rd_base(lane);
    const int qlo = P0 + wid * QBLK, qpos = qlo + r32;
    bf16x8 qr[8];
#pragma unroll
    for (int d0 = 0; d0 < 8; ++d0) qr[d0] = load8<bf16>(Qh + (size_t)qpos * KVP + d0 * 16 + hi * 8);
    const int NT = (P0 + QB) / KVBLK;
    bf16x8 st_k0, st_k1, st_v0, st_v1;
#define SB_LOAD(t) do { const size_t r0_ = (size_t)((t) * KVBLK + sr) * KVP + sc, r1_ = r0_ + (size_t)32 * KVP; \
        st_v0 = load8<bf16>(Vh + r0_); st_v1 = load8<bf16>(Vh + r1_); st_k0 = load8<bf16>(Kh + r0_); st_k1 = load8<bf16>(Kh + r1_); } while (0)
    SB_LOAD(NT - 1);
    float R = 1.0f; f32x16 o[4] = {}; bool done = false;
    for (int t = NT - 1; t >= 0; --t) {
        asm volatile("s_waitcnt vmcnt(0)" ::: "memory");
        *(bf16x8*)(V_lds + vst0) = st_v0; *(bf16x8*)(V_lds + vst1) = st_v1; *(bf16x8*)(K_lds + kws) = st_k0; *(bf16x8*)(K_lds + kws + 32 * 256) = st_k1;
        __syncthreads();
        if (t > 0) SB_LOAD(t - 1);
        const int kb = t * KVBLK;
        if (!done && kb <= qlo + QBLK - 2) {
            f32x16 p0, p1; bf16x8 pa0, pa1, pa2, pa3;
            SBAR(); qkt<0, false>(p0, p1, K_lds, r32, hi, qr, true); SBAR();
            float Px = 1.0f;
            sb_half<true>(p1, Px, R, qpos - kb - 4 * hi - 32, hi); SBAR(); sb_half<true>(p0, Px, R, qpos - kb - 4 * hi, hi);
            R *= Px;
#define PK4(P, B_, OUT) do { unsigned a0 = cvtpk(P[B_+0], P[B_+1]), a1 = cvtpk(P[B_+2], P[B_+3]);                          \
        unsigned b0 = cvtpk(P[B_+4], P[B_+5]), b1 = cvtpk(P[B_+6], P[B_+7]);                                             \
        auto r0 = __builtin_amdgcn_permlane32_swap(a0, b0, false, false); auto r1 = __builtin_amdgcn_permlane32_swap(a1, b1, false, false); \
        u32x4 w = {r0[0], r1[0], r0[1], r1[1]}; OUT = *reinterpret_cast<bf16x8*>(&w); } while (0)
            PK4(p0, 0, pa0); PK4(p0, 8, pa1); PK4(p1, 0, pa2); PK4(p1, 8, pa3);
#undef PK4
            SBAR(); pv_tile<0, false>(o, vb0, pa0, pa1, pa2, pa3, true);
            done = __all(R < EXIT);
        }
        if (lane == 0) flags[wid] = done ? 1u : 0u;
        __syncthreads();
        const u32x4 f0 = *(const u32x4*)flags, f1 = *(const u32x4*)(flags + 4);
        if ((f0.x & f0.y & f0.z & f0.w & f1.x & f1.y & f1.z & f1.w) != 0u) break;
    }
#undef SB_LOAD
    bf16* Ow = Oh + (size_t)qlo * OPB;
#pragma unroll
    for (int r = 0; r < 16; ++r) { const int orow = crow(r, hi);
#pragma unroll
        for (int d0 = 0; d0 < 4; ++d0) { const float v = o[d0][r]; const float vn = __int_as_float(__builtin_amdgcn_ds_swizzle(__float_as_int(v), 0x041F));
            if ((r32 & 1) == 0) *(unsigned*)(Ow + (size_t)orow * OPB + d0 * 32 + r32) = cvtpk(v, vn); } }
    __syncthreads();
}
}
constexpr int NWAVES = 8;
constexpr int BATCH = 2, SEQ = 4096, DM = 2048, FF = 5632, DIN = 6144, DEPTH = 4, HD = 128;
constexpr int M = BATCH * SEQ;
constexpr float RMS_EPS = 1e-6f;
constexpr float QK_C2 = 0.08838834764831845f * 1.4426950408889634f;
constexpr float SB_EXIT = 7.52316385e-37f;
constexpr size_t MiB = 1u << 20;
constexpr size_t WS_CTL = 0, CTL_ZERO_BYTES = 1 * MiB;
constexpr size_t WS_ROPE = 1 * MiB;
constexpr size_t WS_SSQ = 3 * MiB;
constexpr size_t WS_X = 4 * MiB;
constexpr size_t WS_XB = 68 * MiB;
constexpr size_t WS_H = 100 * MiB;
constexpr size_t WS_QKV = 188 * MiB;
constexpr size_t WS_MIX = 284 * MiB;
constexpr size_t WS_OD = 316 * MiB;
constexpr size_t WS_W = 380 * MiB;
constexpr size_t W_GU = (size_t)2 * FF * DM * 2, W_D = (size_t)DM * FF * 2, W_IN = (size_t)DIN * DM * 2, W_OUT = (size_t)DM * DM * 2;
constexpr size_t WO_GU1 = 0, WO_D1 = W_GU, WO_IN = WO_D1 + W_D, WO_OUT = WO_IN + W_IN, WO_GU2 = WO_OUT + W_OUT, WO_D2 = WO_GU2 + W_GU, W_LAYER = WO_D2 + W_D;
constexpr size_t WS_END = WS_W + DEPTH * W_LAYER;
static_assert(W_LAYER == 164 * MiB, "weights per layer");
constexpr int CW_TMO = 0, CW_CODE = 1, CW_BAR = 4096;
constexpr int CW_DCNT = 65536;
static_assert((CW_DCNT + 64 * (DEPTH * 8 * 16)) * 4 <= (int)CTL_ZERO_BYTES, "counters inside the per-call memset");
constexpr int RING_OFF = 0, RING_BYTES = 135168;
constexpr int LDSCTL_OFF = RING_BYTES, MISC_OFF = LDSCTL_OFF + 320;
constexpr int LDS_BYTES = 147456;
static_assert(MISC_OFF + 128 <= LDS_BYTES && 8 * 16640 <= RING_BYTES, "LDS map");

#define GAS __attribute__((address_space(1)))
#define LAS __attribute__((address_space(3)))
typedef unsigned short bf16;
typedef unsigned v4u __attribute__((ext_vector_type(4)));
typedef float f32x4 __attribute__((ext_vector_type(4)));
typedef short bf16x8 __attribute__((ext_vector_type(8)));
typedef GAS unsigned gu32;
typedef GAS unsigned long long gu64;
#define RLX_AGENT __ATOMIC_RELAXED, __HIP_MEMORY_SCOPE_AGENT
#define LDS_WAIT() asm volatile("s_waitcnt lgkmcnt(0)" ::: "memory")
#define VM_WAIT() asm volatile("s_waitcnt vmcnt(0)" ::: "memory")
__device__ __forceinline__ unsigned long long rt() { return __builtin_amdgcn_s_memrealtime(); }
#define XB_TMO      128
#define XB_XCNT(j)  (256  + 64 * (j))
#define XB_XSUB(j)  (1280 + 64 * (j))
#define XB_XGEN(j)  (2304 + 64 * (j))
#define XB_TOP      3328
#define XB_TOPGEN   3392
#define XCD_BAR_WORDS 3456
#define XB_SPIN_CAP (1u << 18)

__device__ __forceinline__ unsigned xb_ld(unsigned* p)              { return __hip_atomic_load(p, __ATOMIC_RELAXED, __HIP_MEMORY_SCOPE_AGENT); }
__device__ __forceinline__ unsigned xb_add(unsigned* p, unsigned v) { return __hip_atomic_fetch_add(p, v, __ATOMIC_RELAXED, __HIP_MEMORY_SCOPE_AGENT); }
__device__ __forceinline__ unsigned xb_xcc_id() { return (unsigned)__builtin_amdgcn_s_getreg((3 << 11) | 20) & 0xFu; }
#define XB_SPIN(cond, bar) do { unsigned _sp = 0; while (cond) { __builtin_amdgcn_s_sleep(1); \
    if ((++_sp & 255u) == 0u) { if (xb_ld(&(bar)[XB_TMO])) break; if (_sp > XB_SPIN_CAP) { atomicAdd(&(bar)[XB_TMO], 1u); break; } } } } while (0)

struct XcdBarrier {
    unsigned* bar; unsigned x;
    volatile LAS unsigned* st;
};

__device__ __forceinline__ XcdBarrier xcd_barrier_post(unsigned* bar, volatile LAS unsigned* st) {
    XcdBarrier b; b.bar = bar; b.x = xb_xcc_id(); b.st = st;
    if (threadIdx.x == 0) (void)xb_add(&bar[XB_XCNT(b.x)], 1u);
    return b;
}
__device__ __forceinline__ void xcd_barrier_complete(unsigned* bar, unsigned x, unsigned& nloc, unsigned& nx) {
    const unsigned G = gridDim.x * gridDim.y * gridDim.z;
    unsigned sum, cnt, mine, sp = 0u;
    for (;;) {
        sum = 0u; cnt = 0u; mine = 0u;
#pragma unroll
        for (unsigned j = 0; j < 16; ++j) { const unsigned c = xb_ld(&bar[XB_XCNT(j)]); sum += c; cnt += (c > 0u) ? 1u : 0u; mine = (j == x) ? c : mine; }
        if (sum == G) break;
        __builtin_amdgcn_s_sleep(1);
        if ((++sp & 255u) == 0u) { if (xb_ld(&bar[XB_TMO])) break; if (sp > XB_SPIN_CAP) { atomicAdd(&bar[XB_TMO], 1u); break; } }
    }
    nloc = mine > 0u ? mine : 1u; nx = cnt > 0u ? cnt : 1u;
}

__device__ __forceinline__ void xcd_barrier(const XcdBarrier& b) {
    asm volatile("s_waitcnt vmcnt(0)" ::: "memory");
    __syncthreads();
    if (threadIdx.x == 0) {
        unsigned* bar = b.bar;
        __builtin_amdgcn_s_waitcnt(0);
        unsigned nloc = b.st[0], nx = b.st[1];
        if (nloc == 0u) { xcd_barrier_complete(bar, b.x, nloc, nx); b.st[0] = nloc; b.st[1] = nx; }
        const unsigned old = xb_add(&bar[XB_XSUB(b.x)], 1u);
        const unsigned gen = old / nloc;
        if (old + 1u == (gen + 1u) * nloc) {
            __builtin_amdgcn_fence(__ATOMIC_RELEASE, "agent");
            asm volatile("s_waitcnt vmcnt(0)" ::: "memory");
            const unsigned og = xb_add(&bar[XB_TOP], 1u);
            const unsigned tg = og / nx;
            if (og + 1u == (tg + 1u) * nx) xb_add(&bar[XB_TOPGEN], 1u);
            else XB_SPIN(xb_ld(&bar[XB_TOPGEN]) == tg, bar);
            __builtin_amdgcn_fence(__ATOMIC_ACQUIRE, "agent");
            xb_add(&bar[XB_XGEN(b.x)], 1u);
            asm volatile("s_waitcnt vmcnt(0)" ::: "memory");
        } else {
            XB_SPIN(xb_ld(&bar[XB_XGEN(b.x)]) == gen, bar);
            __builtin_amdgcn_fence(__ATOMIC_ACQUIRE, "agent");
            asm volatile("s_waitcnt vmcnt(0)" ::: "memory");
        }
    }
    __syncthreads();
}

__device__ __forceinline__ float wave_sum(float v) { return pg8::wave_sum_nolane(v); }
__device__ __forceinline__ unsigned pk2(float lo, float hi) { return pg8::cvt_pk_bf16(lo, hi); }
__device__ __forceinline__ int w_rowmap(int mode, int n) {
    if (mode == 0) return n;
    if (mode == 3) { const int l = n & 255, g = l >> 7, bj = (l >> 6) & 1, i = l & 63; return (n & ~255) + 128 * bj + 64 * g + i; }
    return ((n >> 7) << 8) + (n & 127) + (mode == 2 ? 128 : 0);
}
__device__ __forceinline__ void p0_item(const float* W, int K, int N, const float* gain, bf16* dst, int mode, LAS float* scr, int item, int lane) {
    const int nblk = N / 64, kb = item / nblk, nb = item % nblk, k0 = 64 * kb, n0 = 64 * nb;
    const int kk = lane >> 4, nn = 4 * (lane & 15);
    f32x4 v[16]; float g[16];
#pragma unroll
    for (int i = 0; i < 16; ++i) { const int k = 4 * i + kk; v[i] = __builtin_nontemporal_load((const GAS f32x4*)(W + (size_t)(k0 + k) * N + n0 + nn));     g[i] = gain ? gain[k0 + k] : 1.0f; }
#pragma unroll
    for (int i = 0; i < 16; ++i) { const int k = 4 * i + kk; LAS float* s = scr + k * 65 + nn; s[0] = v[i][0] * g[i]; s[1] = v[i][1] * g[i]; s[2] = v[i][2] * g[i]; s[3] = v[i][3] * g[i]; }
    LDS_WAIT(); asm volatile("" ::: "memory");
    const int c = lane & 7;
#pragma unroll
    for (int j = 0; j < 8; ++j) { const int n = (lane >> 3) + 8 * j; const LAS float* s = scr + (8 * c) * 65 + n;
        v4u o; o.x = pk2(s[0 * 65], s[1 * 65]); o.y = pk2(s[2 * 65], s[3 * 65]); o.z = pk2(s[4 * 65], s[5 * 65]); o.w = pk2(s[6 * 65], s[7 * 65]);
        __builtin_nontemporal_store(o, (GAS v4u*)(dst + (size_t)w_rowmap(mode, n0 + n) * K + k0 + 8 * c)); }
    LDS_WAIT(); asm volatile("" ::: "memory");
}
__device__ __forceinline__ void rope_entry(int pos, int i, float& c, float& s) {
    const double R1 = 0.86596432336006535, R2 = R1 * R1, R4 = R2 * R2, R8 = R4 * R4, R16 = R8 * R8, R32 = R16 * R16;
    double f = 1.0; if (i & 1) f *= R1; if (i & 2) f *= R2; if (i & 4) f *= R4; if (i & 8) f *= R8; if (i & 16) f *= R16; if (i & 32) f *= R32;
    const float ff = (float)f;
    const float angf = (float)pos * ff;
    const double ang = (double)angf;
    const double TWO_PI_HI = 6.283185307179586, TWO_PI_LO = 2.4492935982947064e-16, INV_2PI = 0.15915494309189535;
    const double n = __builtin_rint(ang * INV_2PI);
    double r = __builtin_fma(-n, TWO_PI_HI, ang); r = __builtin_fma(-n, TWO_PI_LO, r);
    const double r2 = r * r;
    double sc = 1.0, ss = 1.0;
#pragma unroll
    for (int k = 15; k >= 1; --k) { sc = 1.0 - sc * r2 / (double)((2 * k - 1) * (2 * k)); ss = 1.0 - ss * r2 / (double)((2 * k) * (2 * k + 1)); }
    c = (float)sc; s = (float)(ss * r);
}

struct Args { const float* in[18]; float* out; unsigned char* ws; float linit[4]; int ph_lo, ph_hi; };
enum { I_X = 0, I_NF1, I_G1, I_U1, I_D1, I_NMIX, I_WIN, I_LQ1, I_LK1, I_LQ2, I_LK2, I_SUBLN, I_WOUT, I_NF2, I_G2, I_U2, I_D2, I_NFIN };

struct Ctx { int tid, lane, wave, bx, G, gw, NGW; unsigned char* ws; gu32* ctl; float* ROPE; float* SSQ; unsigned char* XL; bf16* XB; bf16* H; bf16* QKV; bf16* MIX; float* OD; };
__device__ __forceinline__ Ctx make_ctx(unsigned char* ws_in, int wave_s) {
    Ctx c; unsigned z0; asm volatile("v_mov_b32 %0, 0" : "=v"(z0)); int t = wave_s * 64 + (int)__builtin_amdgcn_mbcnt_hi(~0u, __builtin_amdgcn_mbcnt_lo(~0u, z0));     int b = blockIdx.x; asm volatile("" : "+s"(b)); unsigned char* ws = ws_in; asm volatile("" : "+s"(ws));
    c.tid = t; c.lane = t & 63; c.wave = __builtin_amdgcn_readfirstlane(t >> 6); c.bx = b; c.G = gridDim.x;
    const int vcu = (c.G % 8 == 0) ? (b % 8) * (c.G / 8) + b / 8 : b; c.gw = vcu * NWAVES + c.wave; c.NGW = c.G * NWAVES;
    c.ws = ws; c.ctl = (gu32*)(ws + WS_CTL); c.ROPE = (float*)(ws + WS_ROPE); c.SSQ = (float*)(ws + WS_SSQ); c.XL = ws + WS_X; c.XB = (bf16*)(ws + WS_XB); c.H = (bf16*)(ws + WS_H);
    c.QKV = (bf16*)(ws + WS_QKV); c.MIX = (bf16*)(ws + WS_MIX); c.OD = (float*)(ws + WS_OD);
    return c;
}
__device__ __forceinline__ int opaque_s(int x) { asm volatile("" : "+s"(x)); return x; }
#define INP(i) (args.in[opaque_s(i)])
constexpr int CV_GU = (DM / 64) * (FF / 64), CV_DN = (FF / 64) * (DM / 64), CV_IN = (DM / 64) * (DIN / 64), CV_OUT = (DM / 64) * (DM / 64);
constexpr int CV_LAYER = 4 * CV_GU + 2 * CV_DN + CV_IN + CV_OUT;
constexpr int CV_PRO = 2 * CV_GU + CV_DN;
constexpr int CV_T0 = CV_PRO + CV_IN + CV_OUT + 2 * CV_GU;
#define CONVERT_RANGE(id_lo, id_hi, widx, nw, wsb, scr, lane) do { \
    for (int it_ = (id_lo) + (widx); it_ < (id_hi); it_ += (nw)) { \
        const int layer_ = it_ / CV_LAYER; int r_ = it_ % CV_LAYER; \
        unsigned char* wl_ = (wsb) + WS_W + (size_t)layer_ * W_LAYER; \
        const float* src_; const float* gain_ = nullptr; int K_ = DM, N_ = FF, mode_; size_t wo_; \
        if (r_ < CV_GU) { src_ = INP(I_G1) + (size_t)layer_ * DM * FF; gain_ = INP(I_NF1) + layer_ * DM; mode_ = 1; wo_ = WO_GU1; } \
        else if ((r_ -= CV_GU) < CV_GU) { src_ = INP(I_U1) + (size_t)layer_ * DM * FF; gain_ = INP(I_NF1) + layer_ * DM; mode_ = 2; wo_ = WO_GU1; } \
        else if ((r_ -= CV_GU) < CV_DN) { src_ = INP(I_D1) + (size_t)layer_ * DM * FF; mode_ = 0; wo_ = WO_D1; K_ = FF; N_ = DM; } \
        else if ((r_ -= CV_DN) < CV_IN) { src_ = INP(I_WIN) + (size_t)layer_ * DM * DIN; gain_ = INP(I_NMIX) + layer_ * DM; mode_ = 3; wo_ = WO_IN; N_ = DIN; } \
        else if ((r_ -= CV_IN) < CV_OUT) { src_ = INP(I_WOUT) + (size_t)layer_ * DM * DM; mode_ = 0; wo_ = WO_OUT; N_ = DM; } \
        else if ((r_ -= CV_OUT) < CV_GU) { src_ = INP(I_G2) + (size_t)layer_ * DM * FF; gain_ = INP(I_NF2) + layer_ * DM; mode_ = 1; wo_ = WO_GU2; } \
        else if ((r_ -= CV_GU) < CV_GU) { src_ = INP(I_U2) + (size_t)layer_ * DM * FF; gain_ = INP(I_NF2) + layer_ * DM; mode_ = 2; wo_ = WO_GU2; } \
        else { r_ -= CV_GU; src_ = INP(I_D2) + (size_t)layer_ * DM * FF; mode_ = 0; wo_ = WO_D2; K_ = FF; N_ = DM; } \
        p0_item(src_, K_, N_, gain_, (bf16*)(wl_ + wo_), mode_, scr, r_, lane); \
    } } while (0)

__global__ void __launch_bounds__(NWAVES * 64, 2) mk_fwd(Args args) {
    extern __shared__ __attribute__((aligned(16))) unsigned char lds[];
    LAS unsigned char* L = (LAS unsigned char*)lds;
    volatile LAS unsigned* MISC = (volatile LAS unsigned*)(L + MISC_OFF);
    for (int u = threadIdx.x; u < (LDS_BYTES - LDSCTL_OFF) / 4; u += NWAVES * 64) ((LAS unsigned*)(L + LDSCTL_OFF))[u] = 0u;
    __syncthreads();
    const int wave_s = __builtin_amdgcn_readfirstlane(threadIdx.x >> 6);
    XcdBarrier bar = xcd_barrier_post((unsigned*)(args.ws + WS_CTL) + CW_BAR, MISC + 8);
    const int lo = args.ph_lo, hi = args.ph_hi; int pc = 0;
#define PH_ON() (lo <= pc && pc < hi)
#define PH_END() do { if (lo <= pc && pc + 1 < hi) xcd_barrier(bar); ++pc; } while (0)

    if (PH_ON()) {
        const Ctx c = make_ctx(args.ws, wave_s); const int lane = c.lane, gw = c.gw, NGW = c.NGW;
        LAS float* scr = (LAS float*)(L + RING_OFF + c.wave * 16640);
        CONVERT_RANGE(0, CV_PRO, gw, NGW, c.ws, scr, lane);
        for (int e = c.bx * (NWAVES * 64) + c.tid; e < SEQ * 64; e += c.G * NWAVES * 64) { float cs, sn; rope_entry(e >> 6, e & 63, cs, sn); c.ROPE[e] = cs; c.ROPE[SEQ * 64 + e] = sn; }
        const float* xin = INP(I_X);
        for (int m = gw; m < M; m += NGW) {
            const GAS f32x4* xr = (const GAS f32x4*)(xin + (size_t)m * DM) + lane; GAS unsigned long long* o8 = (GAS unsigned long long*)(c.XB + (size_t)m * DM) + lane;
            GAS unsigned* l4 = (GAS unsigned*)(c.XL + (size_t)m * DM) + lane; float s = 0.f;
#pragma unroll
            for (int j = 0; j < 8; ++j) { const f32x4 v = xr[64 * j]; const unsigned w0 = pk2(v[0], v[1]), w1 = pk2(v[2], v[3]);
                const float d0 = pg8::lo_clamp(v[0] - __uint_as_float(w0 << 16)), d1 = pg8::lo_clamp(v[1] - __uint_as_float(w0 & 0xffff0000u)), d2 = pg8::lo_clamp(v[2] - __uint_as_float(w1 << 16)), d3 = pg8::lo_clamp(v[3] - __uint_as_float(w1 & 0xffff0000u));
                s += (v[0] * v[0] + v[1] * v[1]) + (v[2] * v[2] + v[3] * v[3]);
                o8[64 * j] = (unsigned long long)w0 | ((unsigned long long)w1 << 32);
                int wl = __builtin_amdgcn_cvt_pk_fp8_f32(d0, d1, 0, false); wl = __builtin_amdgcn_cvt_pk_fp8_f32(d2, d3, wl, true); l4[64 * j] = (unsigned)wl; }
            s = wave_sum(s);
            if (lane < 8) c.SSQ[(size_t)m * 8 + lane] = (lane == 0) ? s : 0.f;
        }
    }
    PH_END();

    for (int step = 0; step < 2 * DEPTH; ++step) {
        const int layer = step >> 1, half = step & 1;
        if (PH_ON()) {
            const Ctx c = make_ctx(args.ws, wave_s); unsigned char* wl = c.ws + WS_W + (size_t)layer * W_LAYER;
            pg8::Gemm g{c.XB, (const bf16*)(wl + (half ? WO_GU2 : WO_GU1)), M, 2 * FF, DM}; pg8::StaticOrder S; S.init(M, 2 * FF, c.G, c.bx);
            pg8::EpiSwiGLU E{c.H, c.SSQ};
            if (c.bx >= 128) {
                const int lo_ = layer * CV_LAYER + (half ? CV_T0 : CV_PRO); int hi_ = half ? (layer + 1) * CV_LAYER + CV_PRO : layer * CV_LAYER + CV_T0; if (hi_ > DEPTH * CV_LAYER) hi_ = DEPTH * CV_LAYER;
                LAS float* scr_ = (LAS float*)(L + RING_OFF + c.wave * 16640);
                CONVERT_RANGE(lo_, hi_, (c.bx - 128) * NWAVES + c.wave, 128 * NWAVES, c.ws, scr_, c.lane);
                __syncthreads();
            }
            pg8::gemm_phase<pg8::EpiSwiGLU, pg8::StaticOrder, true, true>(L + RING_OFF, g, S, E, c.tid);
        }
        PH_END();
        if (PH_ON()) {
            const Ctx c = make_ctx(args.ws, wave_s); unsigned char* wl = c.ws + WS_W + (size_t)layer * W_LAYER;
            pg8::Gemm g{c.H, (const bf16*)(wl + (half ? WO_D2 : WO_D1)), M, DM, FF}; pg8::StaticOrder S; S.init(M, DM, c.G, c.bx);
            pg8::EpiResid E{c.XB, c.XL, c.SSQ, 0.5f};
            pg8::gemm_phase<pg8::EpiResid, pg8::StaticOrder, false, true>(L + RING_OFF, g, S, E, c.tid);
        }
        PH_END();
        if (half == 0) {
            if (PH_ON()) {
                const Ctx c = make_ctx(args.ws, wave_s); unsigned char* wl = c.ws + WS_W + (size_t)layer * W_LAYER;
                pg8::Gemm g{c.XB, (const bf16*)(wl + WO_IN), M, DIN, DM}; pg8::StaticOrder S; S.init(M, DIN, c.G, c.bx);
                pg8::EpiQKV E{c.QKV, c.SSQ, c.ROPE, QK_C2};
                pg8::gemm_phase<pg8::EpiQKV, pg8::StaticOrder, true, true>(L + RING_OFF, g, S, E, c.tid);
            }
            PH_END();
            if (PH_ON()) {
                {
                    const Ctx c = make_ctx(args.ws, wave_s);
                    const int j = c.bx >> 3, bh = ((c.bx & 7) << 1) | (j >> 4), qb = j & 15, b = bh >> 3, h = bh & 7;
                    const __hip_bfloat16* Qh = (const __hip_bfloat16*)c.QKV + (size_t)(b * SEQ) * DIN + h * HD;
                    dattn::sb_unit<DM>(Qh, Qh + 1024, Qh + 2048, (__hip_bfloat16*)c.MIX + (size_t)(b * SEQ) * DM + h * HD, qb * dattn::QB, SB_EXIT, (char*)lds + RING_OFF, c.tid);
                }
                {
                    using namespace dattn;
                    const Ctx c = make_ctx(args.ws, wave_s);
                    const int bh = c.bx & 7, j = c.bx >> 3, br = j >> 4, vh = (j >> 3) & 1, x = j & 7, b = bh >> 2, h = bh & 3;
                    const __hip_bfloat16* Qb = (const __hip_bfloat16*)c.QKV + (size_t)(b * SEQ) * DIN + 3072 + h * 256 + br * 128;
                    const __hip_bfloat16* Kb = (const __hip_bfloat16*)c.QKV + (size_t)(b * SEQ) * DIN + 4096 + h * 256 + br * 128;
                    const __hip_bfloat16* Vb = (const __hip_bfloat16*)c.QKV + (size_t)(b * SEQ) * DIN + 5120 + h * 256 + vh * 128;
                    float* Ob = c.OD + (size_t)br * M * 1024 + (size_t)(b * SEQ) * 1024 + h * 256 + vh * 128;
                    const int qa = x, qb2 = 15 - x;
                    BlockRef<__hip_bfloat16, float> c0{Qb + (size_t)qa * QB * QP, Kb, Vb, Ob + (size_t)qa * QB * OP, qa * QB};
                    BlockRef<__hip_bfloat16, float> c1{Qb + (size_t)qb2 * QB * QP, Kb, Vb, Ob + (size_t)qb2 * QB * OP, qb2 * QB};
                    Seam<__hip_bfloat16> S;
                    __syncthreads();
                    causal_swa_prime<__hip_bfloat16, float>(c0, SEQ, (char*)lds + RING_OFF, S, c.tid);
                    causal_swa_block<__hip_bfloat16, float>(c0, c1, SEQ, SEQ, (char*)lds + RING_OFF, S, c.tid);
                    causal_swa_block<__hip_bfloat16, float>(c1, c1, SEQ, SEQ, (char*)lds + RING_OFF, S, c.tid);
                }
            }
            PH_END();
            if (PH_ON()) {
                const Ctx c = make_ctx(args.ws, wave_s); const int lane = c.lane;
                const float linit = args.linit[opaque_s(layer)];
                const float* lq1 = INP(I_LQ1) + layer * HD; const float* lk1 = INP(I_LK1) + layer * HD; const float* lq2 = INP(I_LQ2) + layer * HD; const float* lk2 = INP(I_LK2) + layer * HD;
                const float s1 = wave_sum(lq1[lane] * lk1[lane] + lq1[lane + 64] * lk1[lane + 64]), s2 = wave_sum(lq2[lane] * lk2[lane] + lq2[lane + 64] * lk2[lane + 64]);
                const float lam = expf(s1) - expf(s2) + linit;
                const f32x4 gsub = *(const GAS f32x4*)(INP(I_SUBLN) + layer * 256 + 4 * lane);
                const float* OD = c.OD; bf16* MIX = c.MIX;
                for (int idx = c.gw; idx < M * 4; idx += 4 * c.NGW) {
                    f32x4 o1[4], o2[4];
#pragma unroll
                    for (int q = 0; q < 4; ++q) { const int id = idx + q * c.NGW, row = id >> 2, h = id & 3;
                        o1[q] = *(const GAS f32x4*)(OD + (size_t)row * 1024 + h * 256 + 4 * lane); o2[q] = *(const GAS f32x4*)(OD + (size_t)M * 1024 + (size_t)row * 1024 + h * 256 + 4 * lane); }
#pragma unroll
                    for (int q = 0; q < 4; ++q) { const int id = idx + q * c.NGW, row = id >> 2, h = id & 3;
                        const f32x4 d = o1[q] - o2[q] * lam;
                        const float ss = wave_sum((d[0] * d[0] + d[1] * d[1]) + (d[2] * d[2] + d[3] * d[3]));
                        const float r = (1.0f / sqrtf(ss * (1.0f / 256.0f) + RMS_EPS)) * (1.0f - linit);
                        const f32x4 y = d * gsub * r;
                        *(GAS unsigned long long*)(MIX + (size_t)row * DM + 1024 + h * 256 + 4 * lane) = (unsigned long long)pk2(y[0], y[1]) | ((unsigned long long)pk2(y[2], y[3]) << 32); }
                }
            }
            PH_END();
            if (PH_ON()) {
                const Ctx c = make_ctx(args.ws, wave_s); unsigned char* wl = c.ws + WS_W + (size_t)layer * W_LAYER;
                pg8::Gemm g{c.MIX, (const bf16*)(wl + WO_OUT), M, DM, DM}; pg8::StaticOrder S; S.init(M, DM, c.G, c.bx);
                pg8::EpiResid E{c.XB, c.XL, c.SSQ, 1.0f};
                pg8::gemm_phase<pg8::EpiResid, pg8::StaticOrder, false, true>(L + RING_OFF, g, S, E, c.tid);
            }
            PH_END();
        }
    }
    if (PH_ON()) {
        const Ctx c = make_ctx(args.ws, wave_s); const int lane = c.lane;
        const bool bad = (__hip_atomic_load(c.ctl + CW_BAR + XB_TMO, RLX_AGENT) != 0u);
        const float* gf = INP(I_NFIN); float* out = args.out;
        for (int m = c.gw; m < M; m += c.NGW) {
            const GAS unsigned long long* xr = (const GAS unsigned long long*)(c.XB + (size_t)m * DM) + lane; const GAS unsigned* xl = (const GAS unsigned*)(c.XL + (size_t)m * DM) + lane; GAS f32x4* o = (GAS f32x4*)(out + (size_t)m * DM) + lane; f32x4 v[8]; float s = 0.f;
#pragma unroll
            for (int j = 0; j < 8; ++j) { const unsigned long long w = xr[64 * j]; const int wl = (int)xl[64 * j]; const unsigned w0 = (unsigned)w, w1 = (unsigned)(w >> 32);
                const pg8::f32x2v_ la = __builtin_amdgcn_cvt_pk_f32_fp8(wl, false), lb = __builtin_amdgcn_cvt_pk_f32_fp8(wl, true);
                v[j] = (f32x4){__uint_as_float(w0 << 16) + la.x * pg8::LO_INV, __uint_as_float(w0 & 0xffff0000u) + la.y * pg8::LO_INV,
                               __uint_as_float(w1 << 16) + lb.x * pg8::LO_INV, __uint_as_float(w1 & 0xffff0000u) + lb.y * pg8::LO_INV};
                s += (v[j][0] * v[j][0] + v[j][1] * v[j][1]) + (v[j][2] * v[j][2] + v[j][3] * v[j][3]); }
            float r = 1.0f / sqrtf(wave_sum(s) * (1.0f / DM) + RMS_EPS); if (bad) r = __builtin_nanf("");
#pragma unroll
            for (int j = 0; j < 8; ++j) o[64 * j] = v[j] * *((const GAS f32x4*)gf + lane + 64 * j) * r;
        }
    }
    PH_END();
#undef PH_ON
#undef PH_END
}
constexpr int N_PHASES = 1 + 2 * DEPTH * 2 + DEPTH * 4 + 1;

#ifndef MK_MULTI
#define MK_MULTI 0
#endif
extern "C" void kernel_launch(void* const* d_in, const int* in_sizes, int n_in, void* d_out, int out_size, void* d_ws, size_t ws_size, hipStream_t stream) {
    static int grid = 0;
    if (grid == 0) {
        if (n_in != 18 || in_sizes[0] != M * DM || out_size != M * DM || ws_size < WS_END) { fprintf(stderr, "kernel_launch: shape/workspace mismatch (n_in %d, in0 %d, out %d, ws %zu < %zu)\n", n_in, n_in > 0 ? in_sizes[0] : -1, out_size, ws_size, (size_t)WS_END); grid = -1; return; }
        if (hipFuncSetAttribute((const void*)mk_fwd, hipFuncAttributeMaxDynamicSharedMemorySize, LDS_BYTES) != hipSuccess) { fprintf(stderr, "kernel_launch: hipFuncSetAttribute failed\n"); grid = -1; return; }
        int per_cu = 0;
        if (hipOccupancyMaxActiveBlocksPerMultiprocessor(&per_cu, (const void*)mk_fwd, NWAVES * 64, LDS_BYTES) != hipSuccess || per_cu < 1) fprintf(stderr, "kernel_launch: occupancy query reports %d\n", per_cu);
        (void)hipGetLastError();
        grid = 256;
    }
    if (grid < 0) return;
    (void)hipMemsetAsync((char*)d_ws + WS_CTL, 0, CTL_ZERO_BYTES, stream);
    Args a{};
    for (int i = 0; i < 18; ++i) a.in[i] = (const float*)d_in[i];
    a.out = (float*)d_out; a.ws = (unsigned char*)d_ws;
    for (int l = 0; l < DEPTH; ++l) a.linit[l] = (float)(0.8 - 0.6 * exp(-0.3 * (double)l));
#if MK_MULTI
    for (int p = 0; p < N_PHASES; ++p) { a.ph_lo = p; a.ph_hi = p + 1; hipLaunchKernelGGL(mk_fwd, dim3(grid), dim3(NWAVES * 64), LDS_BYTES, stream, a); }
#else
    a.ph_lo = 0; a.ph_hi = N_PHASES;
    hipLaunchKernelGGL(mk_fwd, dim3(grid), dim3(NWAVES * 64), LDS_BYTES, stream, a);
#endif
    const hipError_t le = hipPeekAtLastError();
    if (le != hipSuccess) fprintf(stderr, "kernel_launch: launch failed: %s\n", hipGetErrorName(le));
}
```

```cpp
#include <hip/hip_bf16.h>
#include <cmath>
#include <hip/hip_runtime.h>
#include <cstdio>
#include <cstdint>
namespace pg8 {
#define PG8_LAS __attribute__((address_space(3)))
typedef unsigned short bf16_t;
typedef short bf16x8 __attribute__((ext_vector_type(8)));
typedef float f32x4 __attribute__((ext_vector_type(4)));
typedef unsigned u32x4 __attribute__((ext_vector_type(4)));
constexpr int BM = 256, BK = 64, HALF = 128, HTB = HALF * BK * 2  , STAGE_BYTES = 8 * HTB, NXCD = 8, WGM = 4;

__host__ __device__ __forceinline__ int lds_byte(int r, int c) { const int st = (r >> 4) * 2 + (c >> 5), rr = r & 15, cc = c & 31, ob = rr * 64 + cc * 2; return st * 1024 + (ob ^ (((ob >> 9) & 1) << 5)); }
__host__ __device__ __forceinline__ void stage_rc(int b, int& R, int& C) { const int st = b / 1024, sb = b % 1024, swz = sb ^ (((sb >> 9) & 1) << 5); R = (st >> 1) * 16 + swz / 64; C = (st & 1) * 32 + (swz % 64) / 2; }
__host__ __device__ __forceinline__ int perm32(int rho) { const int n = rho >> 4, i = rho & 15; return 8 * (i >> 2) + 4 * n + (i & 3); }

struct Unit { int pm, pn; };
struct Gemm { const bf16_t* A; const bf16_t* Bt; int M, N, K; };

struct StaticOrder {
    int nM, nN, nwg, G, c;
    __host__ __device__ void init(int M, int N, int G_, int c_) { nM = M / BM; nN = N / BM; nwg = nM * nN; G = G_; c = c_; }
    __host__ __device__ bool next(int i, Unit& u) const {
        const long L = (long)i * G + c; if (L >= nwg) return false;
        int wgid = (int)L; { const int q = nwg / NXCD, r = nwg % NXCD, xcd = wgid % NXCD, off = wgid / NXCD; wgid = (xcd < r ? xcd * (q + 1) : r * (q + 1) + (xcd - r) * q) + off; }
        const int nig = WGM * nN, gid = wgid / nig, fm = gid * WGM, gsz = (nM - fm) < WGM ? (nM - fm) : WGM;
        u.pm = fm + ((wgid % nig) % gsz); u.pn = (wgid % nig) / gsz; return true;
    }
    __device__ __forceinline__ void a_ready(const Unit&) const {}
    __device__ __forceinline__ void done(const Unit&) const {}
};

typedef float f32x2_t_ __attribute__((ext_vector_type(2))); typedef __bf16 bf16x2_t_ __attribute__((ext_vector_type(2)));
__device__ __forceinline__ unsigned cvt_pk_bf16(float lo, float hi) { f32x2_t_ v = {lo, hi}; bf16x2_t_ b = __builtin_convertvector(v, bf16x2_t_); return __builtin_bit_cast(unsigned, b); }
constexpr int DM_ = 2048, FF_ = 5632, DIN_ = 6144, SEQ_ = 4096;
constexpr float RMS_EPS_ = 1e-6f;
template <int PAT> __device__ __forceinline__ float swz_xor(float v) { return __int_as_float(__builtin_amdgcn_ds_swizzle(__float_as_int(v), PAT)); }
__device__ __forceinline__ float half_swap_sum(float v) { auto rr = __builtin_amdgcn_permlane32_swap(__float_as_uint(v), __float_as_uint(v), false, false); return __uint_as_float(rr[0]) + __uint_as_float(rr[1]); }
__device__ __forceinline__ float wave_sum_nolane(float v) { v += swz_xor<0x041F>(v); v += swz_xor<0x081F>(v); v += swz_xor<0x101F>(v); v += swz_xor<0x201F>(v); v += swz_xor<0x401F>(v); return half_swap_sum(v); }
__device__ __forceinline__ float row_rstd(const float* ssq, int row) {
    const f32x4 a = *(const f32x4*)(ssq + (size_t)row * 8), b = *(const f32x4*)(ssq + (size_t)row * 8 + 4);
    const float s = ((a[0] + a[1]) + (a[2] + a[3])) + ((b[0] + b[1]) + (b[2] + b[3]));
    return 1.0f / sqrtf(s * (1.0f / DM_) + RMS_EPS_);
}
struct EpiSwiGLU {
    static constexpr bool PERM = true, AFTER_DRAIN = false;
    bf16_t* H; const float* ssq;
    __device__ __forceinline__ void operator()(const f32x4 (&acc)[2][2][4][2], const Unit& u, int wr, int wc, int fr, int fq) const {
        const int row0 = u.pm * BM + wr * 64 + fr, col0 = u.pn * HALF + wc * 32 + 8 * fq;
        float rsv[8];
#pragma unroll
        for (int q = 0; q < 8; ++q) rsv[q] = row_rstd(ssq, row0 + (q >> 2) * HALF + (q & 3) * 16);
#pragma unroll
        for (int ai = 0; ai < 2; ++ai)
#pragma unroll
            for (int m = 0; m < 4; ++m) { const int row = row0 + ai * HALF + m * 16; const float rs = rsv[ai * 4 + m], rsn = rs * -1.4426950408889634f, rs2 = rs * rs;
                f32x4 hv[2];
#pragma unroll
                for (int n = 0; n < 2; ++n) { const f32x4 g = acc[ai][0][m][n], up = acc[ai][1][m][n]; const f32x4 a = g * rsn; f32x4 e;
                    e[0] = __builtin_amdgcn_exp2f(a[0]); e[1] = __builtin_amdgcn_exp2f(a[1]); e[2] = __builtin_amdgcn_exp2f(a[2]); e[3] = __builtin_amdgcn_exp2f(a[3]);
                    const f32x4 d = e + 1.0f; f32x4 r; r[0] = __builtin_amdgcn_rcpf(d[0]); r[1] = __builtin_amdgcn_rcpf(d[1]); r[2] = __builtin_amdgcn_rcpf(d[2]); r[3] = __builtin_amdgcn_rcpf(d[3]);
                    hv[n] = (g * up) * (r * rs2); }
                u32x4 w; w.x = cvt_pk_bf16(hv[0][0], hv[0][1]); w.y = cvt_pk_bf16(hv[0][2], hv[0][3]); w.z = cvt_pk_bf16(hv[1][0], hv[1][1]); w.w = cvt_pk_bf16(hv[1][2], hv[1][3]);
                *(u32x4*)(H + (size_t)row * FF_ + col0) = w; }
    }
};
struct EpiQKV {
    static constexpr bool PERM = true, AFTER_DRAIN = false;
    bf16_t* QKV; const float* ssq; const float* rope; float qscale;
    __device__ __forceinline__ void operator()(const f32x4 (&acc)[2][2][4][2], const Unit& u, int wr, int wc, int fr, int fq) const {
        const int sec = u.pn >> 2; const bool rp = (sec == 3) || (sec == 4); const float qs = (sec == 0) ? qscale : 1.0f;
        const int row0 = u.pm * BM + wr * 64 + fr, i0 = 32 * (wc & 1) + 8 * fq;
        float rsv[8];
#pragma unroll
        for (int q = 0; q < 8; ++q) rsv[q] = row_rstd(ssq, row0 + (q >> 2) * HALF + (q & 3) * 16) * qs;
        bf16_t* pbase = QKV + (size_t)row0 * DIN_ + u.pn * BM + (wc >> 1) * HALF + i0;
        if (!rp) {
#pragma unroll
            for (int ai = 0; ai < 2; ++ai)
#pragma unroll
                for (int m = 0; m < 4; ++m) { const float rs = rsv[ai * 4 + m];
#pragma unroll
                    for (int bj = 0; bj < 2; ++bj) { const f32x4 v0 = acc[ai][bj][m][0] * rs, v1 = acc[ai][bj][m][1] * rs;
                        u32x4 w; w.x = cvt_pk_bf16(v0[0], v0[1]); w.y = cvt_pk_bf16(v0[2], v0[3]); w.z = cvt_pk_bf16(v1[0], v1[1]); w.w = cvt_pk_bf16(v1[2], v1[3]);
                        *(u32x4*)(pbase + (size_t)(ai * HALF + m * 16) * DIN_ + bj * 64) = w; } }
        } else {
#pragma unroll
            for (int ai = 0; ai < 2; ++ai)
#pragma unroll
                for (int mp = 0; mp < 2; ++mp) {
                    f32x4 csv[2][2], snv[2][2];
#pragma unroll
                    for (int k = 0; k < 2; ++k) { const int pos = (row0 + ai * HALF + (2 * mp + k) * 16) & (SEQ_ - 1);
#pragma unroll
                        for (int n = 0; n < 2; ++n) { csv[k][n] = *(const f32x4*)(rope + (size_t)pos * 64 + i0 + 4 * n); snv[k][n] = *(const f32x4*)(rope + (size_t)SEQ_ * 64 + (size_t)pos * 64 + i0 + 4 * n); } }
                    asm volatile("" ::: "memory");
#pragma unroll
                    for (int k = 0; k < 2; ++k) { const int m = 2 * mp + k; const float rs = rsv[ai * 4 + m];
                        f32x4 o0[2], o1[2];
#pragma unroll
                        for (int n = 0; n < 2; ++n) { const f32x4 lo = acc[ai][0][m][n] * rs, hi = acc[ai][1][m][n] * rs; o0[n] = lo * csv[k][n] - hi * snv[k][n]; o1[n] = hi * csv[k][n] + lo * snv[k][n]; }
                        bf16_t* p = pbase + (size_t)(ai * HALF + m * 16) * DIN_;
                        u32x4 a, b; a.x = cvt_pk_bf16(o0[0][0], o0[0][1]); a.y = cvt_pk_bf16(o0[0][2], o0[0][3]); a.z = cvt_pk_bf16(o0[1][0], o0[1][1]); a.w = cvt_pk_bf16(o0[1][2], o0[1][3]);
                        b.x = cvt_pk_bf16(o1[0][0], o1[0][1]); b.y = cvt_pk_bf16(o1[0][2], o1[0][3]); b.z = cvt_pk_bf16(o1[1][0], o1[1][1]); b.w = cvt_pk_bf16(o1[1][2], o1[1][3]);
                        *(u32x4*)p = a; *(u32x4*)(p + 64) = b; }
                    asm volatile("" ::: "memory"); }
        }
    }
};
typedef float f32x2v_ __attribute__((ext_vector_type(2)));
constexpr float LO_SCALE = 512.0f, LO_INV = 1.0f / 512.0f, LO_MAX = 224.0f;
__device__ __forceinline__ float lo_clamp(float d) { return __builtin_fminf(__builtin_fmaxf(d * LO_SCALE, -LO_MAX), LO_MAX); }
struct EpiResid {
    static constexpr bool PERM = true, AFTER_DRAIN = true;
    bf16_t* XB; unsigned char* XL; float* ssq; float alpha;
    __device__ __forceinline__ void fused(f32x4 (&acc)[2][2][4][2], const Unit& u, int wr, int wc, int fr, int fq, PG8_LAS unsigned char* lds, int wid, int lane) const {
        typedef unsigned u32x2 __attribute__((ext_vector_type(2)));
        PG8_LAS float* P = (PG8_LAS float*)lds;
        const int col0 = u.pn * BM + wc * 32 + 8 * fq;
#pragma unroll
        for (int ai = 0; ai < 2; ++ai) {
            u32x4 ph[4][2]; u32x2 pl[4][2];
#pragma unroll
            for (int m = 0; m < 4; ++m) { const size_t off = (size_t)(u.pm * BM + ai * HALF + wr * 64 + m * 16 + fr) * DM_ + col0;
#pragma unroll
                for (int bj = 0; bj < 2; ++bj) { ph[m][bj] = *(const u32x4*)(XB + off + bj * HALF); pl[m][bj] = *(const u32x2*)(XL + off + bj * HALF); } }
            asm volatile("" ::: "memory");
#pragma unroll
            for (int m = 0; m < 4; ++m) { const int r = ai * HALF + wr * 64 + m * 16 + fr; const size_t off = (size_t)(u.pm * BM + r) * DM_ + col0; float s = 0.f;
#pragma unroll
                for (int bj = 0; bj < 2; ++bj) { const u32x4 a = ph[m][bj]; const u32x2 b = pl[m][bj]; u32x4 wh; int wl0 = 0, wl1 = 0;
#pragma unroll
                    for (int q = 0; q < 4; ++q) {
                        const f32x2v_ l = (q & 1) ? __builtin_amdgcn_cvt_pk_f32_fp8((int)(q < 2 ? b.x : b.y), true) : __builtin_amdgcn_cvt_pk_f32_fp8((int)(q < 2 ? b.x : b.y), false);
                        const float x0 = __uint_as_float(a[q] << 16) + l.x * LO_INV, x1 = __uint_as_float(a[q] & 0xffff0000u) + l.y * LO_INV;
                        const float v0 = x0 + acc[ai][bj][m][q >> 1][(q & 1) * 2] * alpha, v1 = x1 + acc[ai][bj][m][q >> 1][(q & 1) * 2 + 1] * alpha;
                        const unsigned h = cvt_pk_bf16(v0, v1); wh[q] = h;
                        const float d0 = lo_clamp(v0 - __uint_as_float(h << 16)), d1 = lo_clamp(v1 - __uint_as_float(h & 0xffff0000u));
                        if (q == 0) wl0 = __builtin_amdgcn_cvt_pk_fp8_f32(d0, d1, wl0, false); else if (q == 1) wl0 = __builtin_amdgcn_cvt_pk_fp8_f32(d0, d1, wl0, true);
                        else if (q == 2) wl1 = __builtin_amdgcn_cvt_pk_fp8_f32(d0, d1, wl1, false); else wl1 = __builtin_amdgcn_cvt_pk_fp8_f32(d0, d1, wl1, true);
                        s += v0 * v0 + v1 * v1; }
                    *(u32x4*)(XB + off + bj * HALF) = wh; u32x2 wl; wl.x = (unsigned)wl0; wl.y = (unsigned)wl1; *(u32x2*)(XL + off + bj * HALF) = wl; }
                s += swz_xor<0x401F>(s); s = half_swap_sum(s);
                if (fq == 0) P[r * 4 + wc] = s; }
            asm volatile("" ::: "memory"); }
        asm volatile("s_waitcnt lgkmcnt(0)" ::: "memory"); __builtin_amdgcn_s_barrier(); asm volatile("" ::: "memory");
        const int t = wid * 64 + lane;
        if (t < 256) { const f32x4 p = *(const PG8_LAS f32x4*)(P + t * 4); ssq[(size_t)(u.pm * BM + t) * 8 + u.pn] = (p[0] + p[1]) + (p[2] + p[3]); }
        asm volatile("s_waitcnt lgkmcnt(0)" ::: "memory"); __builtin_amdgcn_s_barrier(); asm volatile("" ::: "memory");
    }
};

template <class Epi, class Sched, bool ALIGN_EPI = false, bool SP2 = false>
__device__ __forceinline__ void gemm_phase(PG8_LAS unsigned char* lds, const Gemm g, const Sched& S, const Epi& E, int tid_in) {
    int tid_ = tid_in; asm volatile("" : "+v"(tid_));
    const int tid = tid_, wid = __builtin_amdgcn_readfirstlane(tid >> 6), lane = tid & 63, wr = wid >> 2, wc = wid & 3, fr = lane & 15, fq = lane >> 4;
    const int K = g.K, nt = K / BK;
    unsigned voffA[2], voffB[2];
#pragma unroll
    for (int i = 0; i < 2; ++i) { int R, C; stage_rc(tid * 16 + i * 8192, R, C); const int Rb = Epi::PERM ? ((R & ~31) + perm32(R & 31)) : R;
        voffA[i] = (unsigned)(R * K + C) * 2u; voffB[i] = (unsigned)(Rb * K + C) * 2u; }
    const size_t kstep = (size_t)(BK * 2);
    const size_t hstep = (size_t)HALF * K * 2;
    const size_t tstep = 2 * hstep;
    const unsigned ldsw = (unsigned)wid * 1024u;
    const int aoff = lds_byte(wr * 64 + fr, fq * 8), boff = lds_byte(wc * 32 + fr, fq * 8);
#define PG8_SA(b, h) (((b) * 2 + (h)) * HTB)
#define PG8_SB(b, h) ((4 + (b) * 2 + (h)) * HTB)
#define PG8_STAGE(bufoff, gbase, voff) do { _Pragma("unroll") for (int _i = 0; _i < 2; ++_i) \
        __builtin_amdgcn_global_load_lds((const unsigned*)((const char*)(gbase) + (voff)[_i]), (PG8_LAS unsigned*)(lds + (bufoff) + ldsw + _i * 8192), 16, 0, 0); } while (0)
#define PG8_LDA(dst, b, h) do { _Pragma("unroll") for (int m = 0; m < 4; ++m) _Pragma("unroll") for (int k = 0; k < 2; ++k) dst[m][k] = *(const PG8_LAS bf16x8*)(lds + PG8_SA(b, h) + aoff + m * 2048 + k * 1024); } while (0)
#define PG8_LDB(dst, b, h) do { _Pragma("unroll") for (int n = 0; n < 2; ++n) _Pragma("unroll") for (int k = 0; k < 2; ++k) dst[n][k] = *(const PG8_LAS bf16x8*)(lds + PG8_SB(b, h) + boff + n * 2048 + k * 1024); } while (0)
#define PG8_MMA(ai, bj, At, Bt) do { __builtin_amdgcn_s_setprio(1); _Pragma("unroll") for (int m = 0; m < 4; ++m) _Pragma("unroll") for (int n = 0; n < 2; ++n) _Pragma("unroll") for (int k = 0; k < 2; ++k) \
        acc[ai][bj][m][n] = __builtin_amdgcn_mfma_f32_16x16x32_bf16(Bt[n][k], At[m][k], acc[ai][bj][m][n], 0, 0, 0); __builtin_amdgcn_s_setprio(0); } while (0)
#define PG8_WAIT_V(n) asm volatile("s_waitcnt vmcnt(" #n ")" ::: "memory")
#define PG8_WAIT_L(n) asm volatile("s_waitcnt lgkmcnt(" #n ")" ::: "memory")
#define PG8_BAR __builtin_amdgcn_s_barrier()
#define PG8_SCHED __builtin_amdgcn_sched_barrier(0)
    Unit cur, nxt; int ui = 0;
    if (!S.next(0, cur)) return;
    f32x4 acc[2][2][4][2];
#pragma unroll
    for (int a = 0; a < 2; ++a)
#pragma unroll
        for (int b = 0; b < 2; ++b)
#pragma unroll
            for (int m = 0; m < 4; ++m)
#pragma unroll
                for (int n = 0; n < 2; ++n) acc[a][b][m][n] = (f32x4){0.f, 0.f, 0.f, 0.f};
    bf16x8 At[4][2], B0[2][2], B1[2][2];
    const char* cA = (const char*)g.A + (size_t)cur.pm * tstep; const char* cB = (const char*)g.Bt + (size_t)cur.pn * tstep;
    S.a_ready(cur);
    if constexpr (SP2) {
        PG8_STAGE(PG8_SB(0, 0), cB, voffB); PG8_STAGE(PG8_SB(0, 1), cB + hstep, voffB); PG8_STAGE(PG8_SA(0, 0), cA, voffA); PG8_STAGE(PG8_SA(0, 1), cA + hstep, voffA);
        if (wr == 1) PG8_BAR;
        PG8_WAIT_V(2); PG8_BAR;
        PG8_STAGE(PG8_SB(1, 0), cB + kstep, voffB); PG8_STAGE(PG8_SA(1, 0), cA + kstep, voffA); PG8_STAGE(PG8_SB(1, 1), cB + hstep + kstep, voffB);
        PG8_WAIT_V(6); PG8_BAR;
    } else {
        PG8_STAGE(PG8_SB(0, 0), cB, voffB); PG8_STAGE(PG8_SA(0, 0), cA, voffA); PG8_STAGE(PG8_SB(0, 1), cB + hstep, voffB); PG8_STAGE(PG8_SA(0, 1), cA + hstep, voffA);
        if (wr == 1) PG8_BAR;
        PG8_WAIT_V(4); PG8_BAR;
        PG8_STAGE(PG8_SB(1, 0), cB + kstep, voffB); PG8_STAGE(PG8_SA(1, 0), cA + kstep, voffA); PG8_STAGE(PG8_SB(1, 1), cB + hstep + kstep, voffB);
        PG8_WAIT_V(6); PG8_BAR;
    }
    for (;;) {
        const bool has_next = S.next(ui + 1, nxt);
        const char* nA = has_next ? (const char*)g.A + (size_t)nxt.pm * tstep : cA; const char* nB = has_next ? (const char*)g.Bt + (size_t)nxt.pn * tstep : cB;
        for (int t = 0; t < nt; t += 2) {
            const bool last = (t == nt - 2);
            const char* a1 = cA + (size_t)(t + 1) * kstep;
            const char* a2 = last ? nA : cA + (size_t)(t + 2) * kstep; const char* b2 = last ? nB : cB + (size_t)(t + 2) * kstep;
            const char* a3 = a2 + kstep; const char* b3 = b2 + kstep;
            if (last && has_next) S.a_ready(nxt);
            if constexpr (SP2) {
            PG8_LDB(B0, 0, 0); PG8_LDB(B1, 0, 1); PG8_SCHED; PG8_LDA(At, 0, 0); PG8_STAGE(PG8_SA(1, 1), a1 + hstep, voffA);
            PG8_WAIT_V(8); PG8_WAIT_L(0); PG8_BAR; PG8_MMA(0, 0, At, B0); PG8_MMA(0, 1, At, B1); PG8_BAR; PG8_SCHED;
            PG8_LDA(At, 0, 1); PG8_STAGE(PG8_SB(0, 0), b2, voffB); PG8_STAGE(PG8_SB(0, 1), b2 + hstep, voffB); PG8_STAGE(PG8_SA(0, 0), a2, voffA);
            PG8_WAIT_V(8); PG8_WAIT_L(0); PG8_BAR; PG8_MMA(1, 0, At, B0); PG8_MMA(1, 1, At, B1); PG8_BAR; PG8_SCHED;
            PG8_LDB(B0, 1, 0); PG8_LDB(B1, 1, 1); PG8_SCHED; PG8_LDA(At, 1, 0); PG8_STAGE(PG8_SA(0, 1), a2 + hstep, voffA);
            PG8_WAIT_V(8); PG8_WAIT_L(0); PG8_BAR; PG8_MMA(0, 0, At, B0); PG8_MMA(0, 1, At, B1); PG8_BAR; PG8_SCHED;
            PG8_LDA(At, 1, 1); PG8_STAGE(PG8_SB(1, 0), b3, voffB); PG8_STAGE(PG8_SB(1, 1), b3 + hstep, voffB); PG8_STAGE(PG8_SA(1, 0), a3, voffA);
            PG8_WAIT_V(8); PG8_WAIT_L(0); PG8_BAR; PG8_MMA(1, 0, At, B0); PG8_MMA(1, 1, At, B1); PG8_BAR; PG8_SCHED;
            } else {
            PG8_LDB(B0, 0, 0); PG8_SCHED; PG8_LDA(At, 0, 0); PG8_STAGE(PG8_SA(1, 1), a1 + hstep, voffA);
            PG8_WAIT_L(8); PG8_BAR; PG8_WAIT_L(0); PG8_MMA(0, 0, At, B0); PG8_BAR; PG8_SCHED;
            PG8_LDB(B1, 0, 1); PG8_STAGE(PG8_SB(0, 0), b2, voffB);
            PG8_BAR; PG8_WAIT_L(0); PG8_MMA(0, 1, At, B1); PG8_BAR;
            PG8_LDA(At, 0, 1); PG8_STAGE(PG8_SA(0, 0), a2, voffA);
            PG8_BAR; PG8_WAIT_L(0); PG8_MMA(1, 0, At, B0); PG8_BAR; PG8_SCHED;
            PG8_STAGE(PG8_SB(0, 1), b2 + hstep, voffB);
            PG8_WAIT_V(6); PG8_BAR; PG8_MMA(1, 1, At, B1); PG8_BAR;
            PG8_LDB(B0, 1, 0); PG8_SCHED; PG8_LDA(At, 1, 0); PG8_STAGE(PG8_SA(0, 1), a2 + hstep, voffA);
            PG8_WAIT_L(8); PG8_BAR; PG8_WAIT_L(0); PG8_MMA(0, 0, At, B0); PG8_BAR; PG8_SCHED;
            PG8_LDB(B1, 1, 1); PG8_STAGE(PG8_SB(1, 0), b3, voffB);
            PG8_BAR; PG8_WAIT_L(0); PG8_MMA(0, 1, At, B1); PG8_BAR;
            PG8_LDA(At, 1, 1); PG8_STAGE(PG8_SA(1, 0), a3, voffA);
            PG8_BAR; PG8_WAIT_L(0); PG8_MMA(1, 0, At, B0); PG8_BAR; PG8_SCHED;
            PG8_STAGE(PG8_SB(1, 1), b3 + hstep, voffB);
            PG8_WAIT_V(6); PG8_BAR; PG8_MMA(1, 1, At, B1); PG8_BAR;
            }
        }
        if constexpr (ALIGN_EPI) { if (wr == 0) PG8_BAR; }
        if constexpr (!Epi::AFTER_DRAIN) { E(acc, cur, wr, wc, fr, fq); S.done(cur); }
        if (!has_next) break;
#pragma unroll
        for (int a = 0; a < 2; ++a)
#pragma unroll
            for (int b = 0; b < 2; ++b)
#pragma unroll
                for (int m = 0; m < 4; ++m)
#pragma unroll
                    for (int n = 0; n < 2; ++n) acc[a][b][m][n] = (f32x4){0.f, 0.f, 0.f, 0.f};
        cur = nxt; cA = nA; cB = nB; ++ui;
        if constexpr (ALIGN_EPI) { if (wr == 1) PG8_BAR; }
    }
    PG8_WAIT_V(0);
    if constexpr (!ALIGN_EPI) { if (wr == 0) PG8_BAR; }
    PG8_BAR;
    if constexpr (Epi::AFTER_DRAIN) { E.fused(acc, cur, wr, wc, fr, fq, lds, wid, lane); S.done(cur); }
#undef PG8_SA
#undef PG8_SB
#undef PG8_STAGE
#undef PG8_LDA
#undef PG8_LDB
#undef PG8_MMA
#undef PG8_WAIT_V
#undef PG8_WAIT_L
#undef PG8_BAR
#undef PG8_SCHED
}
}
namespace dattn {
constexpr int D = 128;
constexpr int QP = 6144, KVP = 6144, OP = 1024;
constexpr float THR = 8.f;
constexpr bool WSKIP = false;
constexpr float SCALE = 0.08838834764831845f;
constexpr int NW = 8, QBLK = 32, KVBLK = 64, QB = NW * QBLK;
constexpr int SHM_V = KVBLK * D * 2, SHM_K = KVBLK * D * 2;
constexpr int LDS_BYTES = 2 * SHM_V + 2 * SHM_K + NW * 64 * 4;
using bf16 = __hip_bfloat16;
typedef short bf16x8 __attribute__((ext_vector_type(8)));
typedef short s16x4 __attribute__((ext_vector_type(4)));
typedef float f32x16 __attribute__((ext_vector_type(16)));
typedef float f32x4 __attribute__((ext_vector_type(4)));
typedef unsigned u32x4 __attribute__((ext_vector_type(4)));
template <class A, class Bt> struct same_t { static constexpr bool v = false; };
template <class A> struct same_t<A, A> { static constexpr bool v = true; };

#define KSWZ(row, colB) ((row) * 256 + ((colB) ^ (((row) & 7) << 4)))
#define SBAR() __builtin_amdgcn_sched_barrier(0)
__device__ __forceinline__ int v_st(int k, int c) { const int kk = (k & ~0xC) | ((k & 4) << 1) | ((k & 8) >> 1); return ((kk >> 3) * 4 + (c >> 5)) * 512 + ((kk & 7) * 32 + (c & 31)) * 2; }
__device__ __forceinline__ int v_rd_base(int lane) { return ((lane & 3) << 3) | (((lane >> 2) & 3) << 6) | (((lane >> 4) & 1) << 5) | (((lane >> 5) & 1) << 8); }
constexpr int v_rd_off(int d0, int ks, int half) { return d0 * 512 + ks * 4096 + half * 2048; }
__device__ __forceinline__ int crow(int r, int hi) { return (r & 3) + 8 * (r >> 2) + 4 * hi; }
__device__ __forceinline__ unsigned cvtpk(float lo, float hi) {
    unsigned r; asm volatile("v_cvt_pk_bf16_f32 %0, %1, %2" : "=v"(r) : "v"(lo), "v"(hi)); return r;
}
__device__ __forceinline__ bf16x8 pack8(f32x4 a, f32x4 b) {
    u32x4 w = {cvtpk(a[0], a[1]), cvtpk(a[2], a[3]), cvtpk(b[0], b[1]), cvtpk(b[2], b[3])};
    return *reinterpret_cast<bf16x8*>(&w);
}
template <class T> __device__ __forceinline__ bf16x8 load8(const T* p) {
    if constexpr (same_t<T, float>::v) { return pack8(*(const f32x4*)p, *(const f32x4*)(p + 4)); }
    else { return *reinterpret_cast<const bf16x8*>(p); }
}
__device__ __forceinline__ void mask_tile(f32x16& p0, f32x16& p1, int dq, unsigned W) {
    const float NEG = -__builtin_inff();
#pragma unroll
    for (int r = 0; r < 16; ++r) {
        const int c = (r & 3) + 8 * (r >> 2);
        if ((unsigned)(dq - c) >= W) p0[r] = NEG;
        if ((unsigned)(dq - c - 32) >= W) p1[r] = NEG;
    }
}
__device__ __forceinline__ void partialSM(f32x16& p0, f32x16& p1, float& m_reg, float& mn, float& alpha) {
    float pmax = p0[0]; for (int r = 1; r < 16; ++r) pmax = fmaxf(pmax, p0[r]); for (int r = 0; r < 16; ++r) pmax = fmaxf(pmax, p1[r]);
    { auto rr = __builtin_amdgcn_permlane32_swap(__float_as_uint(pmax), __float_as_uint(pmax), false, false);
      pmax = fmaxf(__uint_as_float(rr[0]), __uint_as_float(rr[1])); }
    constexpr float C2 = 1.4426950408889634f * SCALE;
    if (__builtin_expect(__all((pmax - m_reg) * SCALE <= THR), 1)) { mn = m_reg; alpha = 1.f; }
    else { mn = fmaxf(m_reg, pmax); alpha = __builtin_amdgcn_exp2f((m_reg - mn) * C2); m_reg = mn; }
    const float mnL = -mn * C2;
    for (int r = 0; r < 16; ++r) p0[r] = fmaf(p0[r], C2, mnL); for (int r = 0; r < 16; ++r) p1[r] = fmaf(p1[r], C2, mnL);
    for (int r = 0; r < 16; ++r) p0[r] = __builtin_amdgcn_exp2f(p0[r]);
}
__device__ __forceinline__ void finishSM(f32x16& p0, f32x16& p1, float alpha, float& l_reg, bf16x8& pa0, bf16x8& pa1, bf16x8& pa2, bf16x8& pa3) {
    for (int r = 0; r < 16; ++r) p1[r] = __builtin_amdgcn_exp2f(p1[r]);
    float ps = 0; for (int r = 0; r < 16; ++r) ps += p0[r]; for (int r = 0; r < 16; ++r) ps += p1[r];
    { auto rr = __builtin_amdgcn_permlane32_swap(__float_as_uint(ps), __float_as_uint(ps), false, false);
      ps = __uint_as_float(rr[0]) + __uint_as_float(rr[1]); }
    l_reg = l_reg * alpha + ps;
#define PK4(P, B_, OUT) do { unsigned a0 = cvtpk(P[B_+0], P[B_+1]), a1 = cvtpk(P[B_+2], P[B_+3]);                          \
        unsigned b0 = cvtpk(P[B_+4], P[B_+5]), b1 = cvtpk(P[B_+6], P[B_+7]);                                             \
        auto r0 = __builtin_amdgcn_permlane32_swap(a0, b0, false, false); auto r1 = __builtin_amdgcn_permlane32_swap(a1, b1, false, false); \
        u32x4 w = {r0[0], r1[0], r0[1], r1[1]}; OUT = *reinterpret_cast<bf16x8*>(&w); } while (0)
    PK4(p0, 0, pa0); PK4(p0, 8, pa1); PK4(p1, 0, pa2); PK4(p1, 8, pa3);
#undef PK4
}
template <int KB, bool SK>
__device__ __forceinline__ void qkt(f32x16& p0, f32x16& p1, const char* K_lds, int r32, int hi, const bf16x8* qr, bool act) {
    if (SK && !act) { const float NEG = -__builtin_inff();
#pragma unroll
        for (int r = 0; r < 16; ++r) { p0[r] = NEG; p1[r] = NEG; } return; }
    p0 = f32x16{}; p1 = f32x16{};
    const char* kb[4];
#pragma unroll
    for (int dd = 0; dd < 4; ++dd) kb[dd] = K_lds + KB * SHM_K + KSWZ(r32, (dd * 16 + hi * 8) * 2);
#pragma unroll
    for (int d0 = 0; d0 < 8; ++d0) { const char* a = kb[d0 & 3] + (d0 >> 2) * 128;
        bf16x8 b0 = *reinterpret_cast<const bf16x8*>(a);
        bf16x8 b1 = *reinterpret_cast<const bf16x8*>(a + 32 * 256);
        p0 = __builtin_amdgcn_mfma_f32_32x32x16_bf16(b0, qr[d0], p0, 0, 0, 0);
        p1 = __builtin_amdgcn_mfma_f32_32x32x16_bf16(b1, qr[d0], p1, 0, 0, 0); }
}
template <int VB, bool SK>
__device__ __forceinline__ void pv_tile(f32x16* o, int vb0, bf16x8 pa0, bf16x8 pa1, bf16x8 pa2, bf16x8 pa3, bool act) {
    if (SK && !act) return;
#define TRRD(dst, off) asm volatile("ds_read_b64_tr_b16 %0, %1 offset:%2" : "=&v"(dst) : "v"(vb0), "i"(off) : "memory")
#define PV_D0(d0) do { s16x4 l0, l1, l2, l3, h0, h1, h2, h3; constexpr int b_ = VB * SHM_V + v_rd_off(d0, 0, 0);     \
        TRRD(l0, b_); TRRD(h0, b_ + 2048); TRRD(l1, b_ + 4096); TRRD(h1, b_ + 6144); TRRD(l2, b_ + 8192); TRRD(h2, b_ + 10240); TRRD(l3, b_ + 12288); TRRD(h3, b_ + 14336); \
        asm volatile("s_waitcnt lgkmcnt(0)" ::: "memory"); SBAR();                 \
        o[d0] = __builtin_amdgcn_mfma_f32_32x32x16_bf16(pa0, (bf16x8){l0[0], l0[1], l0[2], l0[3], h0[0], h0[1], h0[2], h0[3]}, o[d0], 0, 0, 0);   \
        o[d0] = __builtin_amdgcn_mfma_f32_32x32x16_bf16(pa1, (bf16x8){l1[0], l1[1], l1[2], l1[3], h1[0], h1[1], h1[2], h1[3]}, o[d0], 0, 0, 0);   \
        o[d0] = __builtin_amdgcn_mfma_f32_32x32x16_bf16(pa2, (bf16x8){l2[0], l2[1], l2[2], l2[3], h2[0], h2[1], h2[2], h2[3]}, o[d0], 0, 0, 0);   \
        o[d0] = __builtin_amdgcn_mfma_f32_32x32x16_bf16(pa3, (bf16x8){l3[0], l3[1], l3[2], l3[3], h3[0], h3[1], h3[2], h3[3]}, o[d0], 0, 0, 0); } while (0)
    PV_D0(0); PV_D0(1); PV_D0(2); PV_D0(3);
#undef PV_D0
#undef TRRD
}

template <class TIn, class TOut> struct BlockRef { const TIn* Q; const TIn* K; const TIn* V; TOut* O; int P0; };
template <class TIn> struct Seam {
    bf16x8 qr[8];
    bf16x8 st_v0, st_v1, st_k0, st_k1; f32x4 sf0, sf1, sf2, sf3;
    f32x4 tq[16];
};
__device__ __forceinline__ int swa_jlo(int P0, int W) { const int lowk = P0 - W + 1; return lowk > 0 ? lowk / KVBLK : 0; }
#define ROW(p, k0, rr) ((p) + (size_t)((k0) + (rr)) * KVP + sc)
#define VMW() asm volatile("s_waitcnt vmcnt(0)" ::: "memory")
#define VMWN(n) asm volatile("s_waitcnt vmcnt(%0)" :: "i"(n) : "memory")
#define SLOAD_H(Kp, Vp, k0) do { S.st_v0 = load8<TIn>(ROW(Vp, k0, sr)); S.st_v1 = load8<TIn>(ROW(Vp, k0, 32 + sr));              \
                         S.st_k0 = load8<TIn>(ROW(Kp, k0, sr)); S.st_k1 = load8<TIn>(ROW(Kp, k0, 32 + sr)); } while (0)
#define SWRITE_HK(bf) do { *(bf16x8*)(K_lds + (bf) * SHM_K + kws) = S.st_k0; *(bf16x8*)(K_lds + (bf) * SHM_K + kws + 32 * 256) = S.st_k1; } while (0)
#define SWRITE_HV(bf) do { *(bf16x8*)(V_lds + (bf) * SHM_V + vst0) = S.st_v0; *(bf16x8*)(V_lds + (bf) * SHM_V + vst1) = S.st_v1; } while (0)
#define SWRITE_H(bf) do { SWRITE_HV(bf); SWRITE_HK(bf); } while (0)
#define SLOAD_F(p, k0) do { S.sf0 = *(const f32x4*)ROW(p, k0, sr); S.sf1 = *(const f32x4*)(ROW(p, k0, sr) + 4);                \
                            S.sf2 = *(const f32x4*)ROW(p, k0, 32 + sr); S.sf3 = *(const f32x4*)(ROW(p, k0, 32 + sr) + 4); } while (0)
#define SWRITE_KF(bf) do { *(bf16x8*)(K_lds + (bf) * SHM_K + kws) = pack8(S.sf0, S.sf1); *(bf16x8*)(K_lds + (bf) * SHM_K + kws + 32 * 256) = pack8(S.sf2, S.sf3); } while (0)
#define SWRITE_VF(bf) do { *(bf16x8*)(V_lds + (bf) * SHM_V + vst0) = pack8(S.sf0, S.sf1); *(bf16x8*)(V_lds + (bf) * SHM_V + vst1) = pack8(S.sf2, S.sf3); } while (0)
template <class TIn, class TOut>
__device__ __forceinline__ void causal_swa_prime(const BlockRef<TIn, TOut>& cur, int W, char* lds, Seam<TIn>& S, int tid_in) {
    constexpr bool F32 = same_t<TIn, float>::v;
    int tid_ = tid_in; asm volatile("" : "+v"(tid_));
    const int tid = tid_, wid = __builtin_amdgcn_readfirstlane(tid >> 6), lane = tid & 63, r32 = lane & 31, hi = lane >> 5;
    const int sr = tid >> 4, sc = (tid & 15) * 8, kws = KSWZ(sr, sc * 2); char* K_lds = lds + 2 * SHM_V;
    const int kb0 = swa_jlo(cur.P0, W) * KVBLK;
    for (int d0 = 0; d0 < 8; ++d0) S.qr[d0] = load8<TIn>(cur.Q + (size_t)(wid * QBLK + r32) * QP + d0 * 16 + hi * 8);
    if constexpr (F32) { SLOAD_F((const float*)cur.K, kb0); VMW(); SWRITE_KF(0); SBAR(); SLOAD_F((const float*)cur.V, kb0); }
    else { SLOAD_H(cur.K, cur.V, kb0); VMW(); SWRITE_HK(0); }
    __syncthreads();
}
template <class TIn, class TOut>
__device__ __forceinline__ void causal_swa_block(const BlockRef<TIn, TOut>& cur, const BlockRef<TIn, TOut>& nxt, int skv, int W, char* lds, Seam<TIn>& S, int tid_in) {
    constexpr bool F32 = same_t<TIn, float>::v;
    int tid_ = tid_in; asm volatile("" : "+v"(tid_));
    const int tid = tid_, wid = __builtin_amdgcn_readfirstlane(tid >> 6), lane = tid & 63, r32 = lane & 31, hi = lane >> 5;
    const int j_lo = swa_jlo(cur.P0, W);
    int j_hi = (cur.P0 + QB - 1) / KVBLK + 1; if (j_hi > skv / KVBLK) j_hi = skv / KVBLK;
    const int NT = j_hi - j_lo;
    const int kbn = swa_jlo(nxt.P0, W) * KVBLK;
    const int qlo = cur.P0 + wid * QBLK, qm = qlo + r32 - 4 * hi;
    char* V_lds = lds; char* K_lds = lds + 2 * SHM_V;
    float* ws = (float*)(lds + 2 * SHM_V + 2 * SHM_K) + wid * 64; float* li_l = ws, * al_l = ws + 32;
    float m_reg = -1e30f, l_reg = 0; f32x16 o[4] = {};
    const int sr = tid >> 4, sc = (tid & 15) * 8, vst0 = v_st(sr, sc), vst1 = v_st(32 + sr, sc), kws = KSWZ(sr, sc * 2);
    const int vb0 = (int)(uintptr_t)V_lds + v_rd_base(lane);
    const TIn* Kh = cur.K; const TIn* Vh = cur.V;
#define RESC(a) do { if (__any((a) < 1.f)) { if (hi == 0) al_l[r32] = (a); asm volatile("s_waitcnt lgkmcnt(0)" ::: "memory");              \
                     for (int d_ = 0; d_ < 4; ++d_) for (int r = 0; r < 16; ++r) o[d_][r] *= al_l[crow(r, hi)]; } } while (0)
#define KBASE(t) ((j_lo + (t)) * KVBLK)
#define ACT(t) (KBASE(t) <= qlo + QBLK - 1 && KBASE(t) + KVBLK - 1 >= qlo - W + 1)
#define MASKT(P0_, P1_, t) do { const int kb_ = KBASE(t); if ((!SK || ACT(t)) && (kb_ + KVBLK - 1 > qlo || kb_ <= qlo + QBLK - 1 - W)) mask_tile(P0_, P1_, qm - kb_, (unsigned)W); } while (0)
    constexpr int NQL = F32 ? 16 : 8;
    constexpr bool SK = WSKIP && !F32;
#define SEAM_K0() do { VMWN(NQL); if constexpr (F32) { SWRITE_KF(0); SBAR(); SLOAD_F((const float*)nxt.V, kbn); } else { SWRITE_HK(0); } SBAR(); } while (0)
    f32x16 pA0, pA1, pB0, pB1; float mnA, mnB, alA, alB; bf16x8 pa0, pa1, pa2, pa3;
    if constexpr (F32) { VMW(); SWRITE_VF(0); SBAR(); } else { SWRITE_HV(0); SBAR(); }
    if (NT > 1) { if constexpr (F32) SLOAD_F((const float*)Kh, KBASE(1)); else SLOAD_H(Kh, Vh, KBASE(1)); }
    SBAR(); qkt<0, SK>(pA0, pA1, K_lds, r32, hi, S.qr, ACT(0));
    if constexpr (F32) { if (NT > 1) { VMW(); SWRITE_KF(1); SBAR(); SLOAD_F((const float*)Vh, KBASE(1)); } }
    MASKT(pA0, pA1, 0); partialSM(pA0, pA1, m_reg, mnA, alA);
    if (NT > 1) { VMW(); if constexpr (F32) { SWRITE_VF(1); SBAR(); if (NT > 2) SLOAD_F((const float*)Kh, KBASE(2)); } else SWRITE_H(1); }
    __syncthreads();
#define HALF_STEP(PX0, PX1, mnX, alX, PY0, PY1, alY, t, KB, VB, SB) do {                                                      \
        SBAR(); qkt<KB, SK>(PX0, PX1, K_lds, r32, hi, S.qr, ACT(t));                                             \
        finishSM(PY0, PY1, alY, l_reg, pa0, pa1, pa2, pa3); SBAR();                                                           \
        if ((t) + 1 < NT) { if constexpr (F32) { VMW(); SWRITE_KF(SB); SBAR(); SLOAD_F((const float*)Vh, KBASE((t) + 1)); }  \
                            else { SLOAD_H(Kh, Vh, KBASE((t) + 1)); } SBAR(); }                                               \
        pv_tile<VB, SK>(o, vb0, pa0, pa1, pa2, pa3, ACT((t) - 1)); MASKT(PX0, PX1, (t)); partialSM(PX0, PX1, m_reg, mnX, alX);                                        \
        __syncthreads();                                                                                                      \
        if ((t) + 1 < NT) { VMW(); if constexpr (F32) { SWRITE_VF(SB); SBAR(); if ((t) + 2 < NT) SLOAD_F((const float*)Kh, KBASE((t) + 2)); } \
                            else { SWRITE_H(SB); } }                                                                          \
        RESC(alX); __syncthreads(); } while (0)
    for (int t = 1; t + 1 < NT; t += 2) {
        HALF_STEP(pB0, pB1, mnB, alB, pA0, pA1, alA, t, 1, 0, 0);
        HALF_STEP(pA0, pA1, mnA, alA, pB0, pB1, alB, t + 1, 0, 1, 1);
    }
    const bool even = (NT & 1) == 0;
    if (even) { SBAR(); qkt<1, SK>(pB0, pB1, K_lds, r32, hi, S.qr, ACT(NT - 1)); SBAR(); }
#define QROW(e) (nxt.Q + (size_t)(wid * QBLK + r32) * QP + ((e) >> 1) * 16 + hi * 8 + ((e) & 1) * 4)
    if constexpr (F32) { SLOAD_F((const float*)nxt.K, kbn); SBAR();
#pragma unroll
        for (int e = 0; e < 8; ++e) S.tq[e] = *(const f32x4*)QROW(e); }
    else { SLOAD_H(nxt.K, nxt.V, kbn); SBAR();
#pragma unroll
        for (int d0 = 0; d0 < 8; ++d0) S.qr[d0] = load8<TIn>(nxt.Q + (size_t)(wid * QBLK + r32) * QP + d0 * 16 + hi * 8); }
    SBAR();
    finishSM(pA0, pA1, alA, l_reg, pa0, pa1, pa2, pa3); SBAR();
    if constexpr (F32) {
#pragma unroll
        for (int e = 8; e < 16; ++e) S.tq[e] = *(const f32x4*)QROW(e); SBAR(); }
#undef QROW
    pv_tile<0, SK>(o, vb0, pa0, pa1, pa2, pa3, ACT(even ? NT - 2 : NT - 1));
    if (even) { MASKT(pB0, pB1, NT - 1); partialSM(pB0, pB1, m_reg, mnB, alB); __syncthreads(); RESC(alB);
        finishSM(pB0, pB1, alB, l_reg, pa0, pa1, pa2, pa3); SBAR(); pv_tile<1, SK>(o, vb0, pa0, pa1, pa2, pa3, ACT(NT - 1)); }
    SBAR(); SEAM_K0();
    if (hi == 0) li_l[r32] = l_reg; asm volatile("s_waitcnt lgkmcnt(0)" ::: "memory");
    float rli[16];
#pragma unroll
    for (int r = 0; r < 16; ++r) rli[r] = __builtin_amdgcn_rcpf(li_l[crow(r, hi)]);
    TOut* Ow = cur.O + (size_t)(wid * QBLK) * OP;
#pragma unroll
    for (int r = 0; r < 16; ++r) { const int orow = crow(r, hi);
#pragma unroll
        for (int d0 = 0; d0 < 4; ++d0) { const float v = o[d0][r] * rli[r];
            if constexpr (same_t<TOut, float>::v) { Ow[(size_t)orow * OP + d0 * 32 + r32] = v; }
            else { const float vn = __shfl_xor(v, 1);
                   if ((r32 & 1) == 0) *(unsigned*)(Ow + (size_t)orow * OP + d0 * 32 + r32) = cvtpk(v, vn); } } }
    if constexpr (F32) {
#pragma unroll
        for (int d0 = 0; d0 < 8; ++d0) S.qr[d0] = pack8(S.tq[2 * d0], S.tq[2 * d0 + 1]); }
    __syncthreads();
#undef RESC
#undef KBASE
#undef ACT
#undef MASKT
#undef SEAM_K0
#undef HALF_STEP
}
#undef ROW
#undef VMW
#undef VMWN
#undef SLOAD_H
#undef SWRITE_HK
#undef SWRITE_HV
#undef SWRITE_H
#undef SLOAD_F
#undef SWRITE_KF
#undef SWRITE_VF


}
namespace dattn {
template <bool MASK> __device__ __forceinline__ void sb_half(f32x16& p, float& Px, float R, int dq, int hi) {
    float om[16];
#pragma unroll
    for (int r = 0; r < 16; ++r) {
        const int c = (r & 3) + 8 * (r >> 2);
        const float e = __builtin_amdgcn_exp2f(-fmaxf(p[r], -126.0f)); float b = __builtin_amdgcn_rcpf(1.0f + e), o = e * b;
        if (MASK) { const bool in = c < dq; b = in ? b : 0.f; o = in ? o : 1.0f; } om[r] = o; p[r] = b;
    }
    float E[4];
#pragma unroll
    for (int g = 3; g >= 0; --g) {
        const float s0 = (om[4 * g] * om[4 * g + 1]) * (om[4 * g + 2] * om[4 * g + 3]);
        auto rr = __builtin_amdgcn_permlane32_swap(__float_as_uint(s0), __float_as_uint(s0), false, false);
        const float ga = __uint_as_float(rr[0]), gb = __uint_as_float(rr[1]);
        E[g] = (hi ? Px : Px * gb) * R; Px *= ga * gb;
    }
#pragma unroll
    for (int g = 0; g < 4; ++g) {
        const float c3 = E[g], c2 = c3 * om[4 * g + 3], c1 = c2 * om[4 * g + 2], c0 = c1 * om[4 * g + 1];
        p[4 * g + 3] *= c3; p[4 * g + 2] *= c2; p[4 * g + 1] *= c1; p[4 * g] *= c0;
    }
}
template <int OPB> __device__ __forceinline__ void sb_unit(const bf16* Qh, const bf16* Kh, const bf16* Vh, bf16* Oh, int P0, float EXIT, char* lds, int tid_in) {
    int tid_ = tid_in; asm volatile("" : "+v"(tid_));
    const int tid = tid_, wid = __builtin_amdgcn_readfirstlane(tid >> 6), lane = tid & 63, r32 = lane & 31, hi = lane >> 5;
    char* V_lds = lds; char* K_lds = lds + 2 * SHM_V; unsigned* flags = (unsigned*)(lds + 2 * SHM_V + 2 * SHM_K);
    const int sr = tid >> 4, sc = (tid & 15) * 8, vst0 = v_st(sr, sc), vst1 = v_st(32 + sr, sc), kws = KSWZ(sr, sc * 2);
    const int vb0 = (int)(uintptr_t)V_lds + v_rd_base(lane);
    const int qlo = P0 + wid * QBLK, qpos = qlo + r32;
    bf16x8 qr[8];
#pragma unroll
    for (int d0 = 0; d0 < 8; ++d0) qr[d0] = load8<bf16>(Qh + (size_t)qpos * KVP + d0 * 16 + hi * 8);
    const int NT = (P0 + QB) / KVBLK;
    bf16x8 st_k0, st_k1, st_v0, st_v1;
#define SB_LOAD(t) do { const size_t r0_ = (size_t)((t) * KVBLK + sr) * KVP + sc, r1_ = r0_ + (size_t)32 * KVP; \
        st_v0 = load8<bf16>(Vh + r0_); st_v1 = load8<bf16>(Vh + r1_); st_k0 = load8<bf16>(Kh + r0_); st_k1 = load8<bf16>(Kh + r1_); } while (0)
    SB_LOAD(NT - 1);
    float R = 1.0f; f32x16 o[4] = {}; bool done = false;
    for (int t = NT - 1; t >= 0; --t) {
        asm volatile("s_waitcnt vmcnt(0)" ::: "memory");
        *(bf16x8*)(V_lds + vst0) = st_v0; *(bf16x8*)(V_lds + vst1) = st_v1; *(bf16x8*)(K_lds + kws) = st_k0; *(bf16x8*)(K_lds + kws + 32 * 256) = st_k1;
        __syncthreads();
        if (t > 0) SB_LOAD(t - 1);
        const int kb = t * KVBLK;
        if (!done && kb <= qlo + QBLK - 2) {
            f32x16 p0, p1; bf16x8 pa0, pa1, pa2, pa3;
            SBAR(); qkt<0, false>(p0, p1, K_lds, r32, hi, qr, true); SBAR();
            float Px = 1.0f;
            sb_half<true>(p1, Px, R, qpos - kb - 4 * hi - 32, hi); SBAR(); sb_half<true>(p0, Px, R, qpos - kb - 4 * hi, hi);
            R *= Px;
#define PK4(P, B_, OUT) do { unsigned a0 = cvtpk(P[B_+0], P[B_+1]), a1 = cvtpk(P[B_+2], P[B_+3]);                          \
        unsigned b0 = cvtpk(P[B_+4], P[B_+5]), b1 = cvtpk(P[B_+6], P[B_+7]);                                             \
        auto r0 = __builtin_amdgcn_permlane32_swap(a0, b0, false, false); auto r1 = __builtin_amdgcn_permlane32_swap(a1, b1, false, false); \
        u32x4 w = {r0[0], r1[0], r0[1], r1[1]}; OUT = *reinterpret_cast<bf16x8*>(&w); } while (0)
            PK4(p0, 0, pa0); PK4(p0, 8, pa1); PK4(p1, 0, pa2); PK4(p1, 8, pa3);
#undef PK4
            SBAR(); pv_tile<0, false>(o, vb0, pa0, pa1, pa2, pa3, true);
            done = __all(R < EXIT);
        }
        if (lane == 0) flags[wid] = done ? 1u : 0u;
        __syncthreads();
        const u32x4 f0 = *(const u32x4*)flags, f1 = *(const u32x4*)(flags + 4);
        if ((f0.x & f0.y & f0.z & f0.w & f1.x & f1.y & f1.z & f1.w) != 0u) break;
    }
#undef SB_LOAD
    bf16* Ow = Oh + (size_t)qlo * OPB;
#pragma unroll
    for (int r = 0; r < 16; ++r) { const int orow = crow(r, hi);
#pragma unroll
        for (int d0 = 0; d0 < 4; ++d0) { const float v = o[d0][r]; const float vn = __int_as_float(__builtin_amdgcn_ds_swizzle(__float_as_int(v), 0x041F));
            if ((r32 & 1) == 0) *(unsigned*)(Ow + (size_t)orow * OPB + d0 * 32 + r32) = cvtpk(v, vn); } }
    __syncthreads();
}
}
constexpr int NWAVES = 8;
constexpr int BATCH = 2, SEQ = 4096, DM = 2048, FF = 5632, DIN = 6144, DEPTH = 4, HD = 128;
constexpr int M = BATCH * SEQ;
constexpr float RMS_EPS = 1e-6f;
constexpr float QK_C2 = 0.08838834764831845f * 1.4426950408889634f;
constexpr float SB_EXIT = 7.52316385e-37f;
constexpr size_t MiB = 1u << 20;
constexpr size_t WS_CTL = 0, CTL_ZERO_BYTES = 1 * MiB;
constexpr size_t WS_ROPE = 1 * MiB;
constexpr size_t WS_SSQ = 3 * MiB;
constexpr size_t WS_X = 4 * MiB;
constexpr size_t WS_XB = 68 * MiB;
constexpr size_t WS_H = 100 * MiB;
constexpr size_t WS_QKV = 188 * MiB;
constexpr size_t WS_MIX = 284 * MiB;
constexpr size_t WS_OD = 316 * MiB;
constexpr size_t WS_W = 380 * MiB;
constexpr size_t W_GU = (size_t)2 * FF * DM * 2, W_D = (size_t)DM * FF * 2, W_IN = (size_t)DIN * DM * 2, W_OUT = (size_t)DM * DM * 2;
constexpr size_t WO_GU1 = 0, WO_D1 = W_GU, WO_IN = WO_D1 + W_D, WO_OUT = WO_IN + W_IN, WO_GU2 = WO_OUT + W_OUT, WO_D2 = WO_GU2 + W_GU, W_LAYER = WO_D2 + W_D;
constexpr size_t WS_END = WS_W + DEPTH * W_LAYER;
static_assert(W_LAYER == 164 * MiB, "weights per layer");
constexpr int CW_TMO = 0, CW_CODE = 1, CW_BAR = 4096;
constexpr int CW_DCNT = 65536;
static_assert((CW_DCNT + 64 * (DEPTH * 8 * 16)) * 4 <= (int)CTL_ZERO_BYTES, "counters inside the per-call memset");
constexpr int RING_OFF = 0, RING_BYTES = 135168;
constexpr int LDSCTL_OFF = RING_BYTES, MISC_OFF = LDSCTL_OFF + 320;
constexpr int LDS_BYTES = 147456;
static_assert(MISC_OFF + 128 <= LDS_BYTES && 8 * 16640 <= RING_BYTES, "LDS map");

#define GAS __attribute__((address_space(1)))
#define LAS __attribute__((address_space(3)))
typedef unsigned short bf16;
typedef unsigned v4u __attribute__((ext_vector_type(4)));
typedef float f32x4 __attribute__((ext_vector_type(4)));
typedef short bf16x8 __attribute__((ext_vector_type(8)));
typedef GAS unsigned gu32;
typedef GAS unsigned long long gu64;
#define RLX_AGENT __ATOMIC_RELAXED, __HIP_MEMORY_SCOPE_AGENT
#define LDS_WAIT() asm volatile("s_waitcnt lgkmcnt(0)" ::: "memory")
#define VM_WAIT() asm volatile("s_waitcnt vmcnt(0)" ::: "memory")
__device__ __forceinline__ unsigned long long rt() { return __builtin_amdgcn_s_memrealtime(); }
#define XB_TMO      128
#define XB_XCNT(j)  (256  + 64 * (j))
#define XB_XSUB(j)  (1280 + 64 * (j))
#define XB_XGEN(j)  (2304 + 64 * (j))
#define XB_TOP      3328
#define XB_TOPGEN   3392
#define XCD_BAR_WORDS 3456
#define XB_SPIN_CAP (1u << 18)

__device__ __forceinline__ unsigned xb_ld(unsigned* p)              { return __hip_atomic_load(p, __ATOMIC_RELAXED, __HIP_MEMORY_SCOPE_AGENT); }
__device__ __forceinline__ unsigned xb_add(unsigned* p, unsigned v) { return __hip_atomic_fetch_add(p, v, __ATOMIC_RELAXED, __HIP_MEMORY_SCOPE_AGENT); }
__device__ __forceinline__ unsigned xb_xcc_id() { return (unsigned)__builtin_amdgcn_s_getreg((3 << 11) | 20) & 0xFu; }
#define XB_SPIN(cond, bar) do { unsigned _sp = 0; while (cond) { __builtin_amdgcn_s_sleep(1); \
    if ((++_sp & 255u) == 0u) { if (xb_ld(&(bar)[XB_TMO])) break; if (_sp > XB_SPIN_CAP) { atomicAdd(&(bar)[XB_TMO], 1u); break; } } } } while (0)

struct XcdBarrier {
    unsigned* bar; unsigned x;
    volatile LAS unsigned* st;
};

__device__ __forceinline__ XcdBarrier xcd_barrier_post(unsigned* bar, volatile LAS unsigned* st) {
    XcdBarrier b; b.bar = bar; b.x = xb_xcc_id(); b.st = st;
    if (threadIdx.x == 0) (void)xb_add(&bar[XB_XCNT(b.x)], 1u);
    return b;
}
__device__ __forceinline__ void xcd_barrier_complete(unsigned* bar, unsigned x, unsigned& nloc, unsigned& nx) {
    const unsigned G = gridDim.x * gridDim.y * gridDim.z;
    unsigned sum, cnt, mine, sp = 0u;
    for (;;) {
        sum = 0u; cnt = 0u; mine = 0u;
#pragma unroll
        for (unsigned j = 0; j < 16; ++j) { const unsigned c = xb_ld(&bar[XB_XCNT(j)]); sum += c; cnt += (c > 0u) ? 1u : 0u; mine = (j == x) ? c : mine; }
        if (sum == G) break;
        __builtin_amdgcn_s_sleep(1);
        if ((++sp & 255u) == 0u) { if (xb_ld(&bar[XB_TMO])) break; if (sp > XB_SPIN_CAP) { atomicAdd(&bar[XB_TMO], 1u); break; } }
    }
    nloc = mine > 0u ? mine : 1u; nx = cnt > 0u ? cnt : 1u;
}

__device__ __forceinline__ void xcd_barrier(const XcdBarrier& b) {
    asm volatile("s_waitcnt vmcnt(0)" ::: "memory");
    __syncthreads();
    if (threadIdx.x == 0) {
        unsigned* bar = b.bar;
        __builtin_amdgcn_s_waitcnt(0);
        unsigned nloc = b.st[0], nx = b.st[1];
        if (nloc == 0u) { xcd_barrier_complete(bar, b.x, nloc, nx); b.st[0] = nloc; b.st[1] = nx; }
        const unsigned old = xb_add(&bar[XB_XSUB(b.x)], 1u);
        const unsigned gen = old / nloc;
        if (old + 1u == (gen + 1u) * nloc) {
            __builtin_amdgcn_fence(__ATOMIC_RELEASE, "agent");
            asm volatile("s_waitcnt vmcnt(0)" ::: "memory");
            const unsigned og = xb_add(&bar[XB_TOP], 1u);
            const unsigned tg = og / nx;
            if (og + 1u == (tg + 1u) * nx) xb_add(&bar[XB_TOPGEN], 1u);
            else XB_SPIN(xb_ld(&bar[XB_TOPGEN]) == tg, bar);
            __builtin_amdgcn_fence(__ATOMIC_ACQUIRE, "agent");
            xb_add(&bar[XB_XGEN(b.x)], 1u);
            asm volatile("s_waitcnt vmcnt(0)" ::: "memory");
        } else {
            XB_SPIN(xb_ld(&bar[XB_XGEN(b.x)]) == gen, bar);
            __builtin_amdgcn_fence(__ATOMIC_ACQUIRE, "agent");
            asm volatile("s_waitcnt vmcnt(0)" ::: "memory");
        }
    }
    __syncthreads();
}

__device__ __forceinline__ float wave_sum(float v) { return pg8::wave_sum_nolane(v); }
__device__ __forceinline__ unsigned pk2(float lo, float hi) { return pg8::cvt_pk_bf16(lo, hi); }
__device__ __forceinline__ int w_rowmap(int mode, int n) {
    if (mode == 0) return n;
    if (mode == 3) { const int l = n & 255, g = l >> 7, bj = (l >> 6) & 1, i = l & 63; return (n & ~255) + 128 * bj + 64 * g + i; }
    return ((n >> 7) << 8) + (n & 127) + (mode == 2 ? 128 : 0);
}
__device__ __forceinline__ void p0_item(const float* W, int K, int N, const float* gain, bf16* dst, int mode, LAS float* scr, int item, int lane) {
    const int nblk = N / 64, kb = item / nblk, nb = item % nblk, k0 = 64 * kb, n0 = 64 * nb;
    const int kk = lane >> 4, nn = 4 * (lane & 15);
    f32x4 v[16]; float g[16];
#pragma unroll
    for (int i = 0; i < 16; ++i) { const int k = 4 * i + kk; v[i] = __builtin_nontemporal_load((const GAS f32x4*)(W + (size_t)(k0 + k) * N + n0 + nn));     g[i] = gain ? gain[k0 + k] : 1.0f; }
#pragma unroll
    for (int i = 0; i < 16; ++i) { const int k = 4 * i + kk; LAS float* s = scr + k * 65 + nn; s[0] = v[i][0] * g[i]; s[1] = v[i][1] * g[i]; s[2] = v[i][2] * g[i]; s[3] = v[i][3] * g[i]; }
    LDS_WAIT(); asm volatile("" ::: "memory");
    const int c = lane & 7;
#pragma unroll
    for (int j = 0; j < 8; ++j) { const int n = (lane >> 3) + 8 * j; const LAS float* s = scr + (8 * c) * 65 + n;
        v4u o; o.x = pk2(s[0 * 65], s[1 * 65]); o.y = pk2(s[2 * 65], s[3 * 65]); o.z = pk2(s[4 * 65], s[5 * 65]); o.w = pk2(s[6 * 65], s[7 * 65]);
        __builtin_nontemporal_store(o, (GAS v4u*)(dst + (size_t)w_rowmap(mode, n0 + n) * K + k0 + 8 * c)); }
    LDS_WAIT(); asm volatile("" ::: "memory");
}
__device__ __forceinline__ void rope_entry(int pos, int i, float& c, float& s) {
    const double R1 = 0.86596432336006535, R2 = R1 * R1, R4 = R2 * R2, R8 = R4 * R4, R16 = R8 * R8, R32 = R16 * R16;
    double f = 1.0; if (i & 1) f *= R1; if (i & 2) f *= R2; if (i & 4) f *= R4; if (i & 8) f *= R8; if (i & 16) f *= R16; if (i & 32) f *= R32;
    const float ff = (float)f;
    const float angf = (float)pos * ff;
    const double ang = (double)angf;
    const double TWO_PI_HI = 6.283185307179586, TWO_PI_LO = 2.4492935982947064e-16, INV_2PI = 0.15915494309189535;
    const double n = __builtin_rint(ang * INV_2PI);
    double r = __builtin_fma(-n, TWO_PI_HI, ang); r = __builtin_fma(-n, TWO_PI_LO, r);
    const double r2 = r * r;
    double sc = 1.0, ss = 1.0;
#pragma unroll
    for (int k = 15; k >= 1; --k) { sc = 1.0 - sc * r2 / (double)((2 * k - 1) * (2 * k)); ss = 1.0 - ss * r2 / (double)((2 * k) * (2 * k + 1)); }
    c = (float)sc; s = (float)(ss * r);
}

struct Args { const float* in[18]; float* out; unsigned char* ws; float linit[4]; int ph_lo, ph_hi; };
enum { I_X = 0, I_NF1, I_G1, I_U1, I_D1, I_NMIX, I_WIN, I_LQ1, I_LK1, I_LQ2, I_LK2, I_SUBLN, I_WOUT, I_NF2, I_G2, I_U2, I_D2, I_NFIN };

struct Ctx { int tid, lane, wave, bx, G, gw, NGW; unsigned char* ws; gu32* ctl; float* ROPE; float* SSQ; unsigned char* XL; bf16* XB; bf16* H; bf16* QKV; bf16* MIX; float* OD; };
__device__ __forceinline__ Ctx make_ctx(unsigned char* ws_in, int wave_s) {
    Ctx c; unsigned z0; asm volatile("v_mov_b32 %0, 0" : "=v"(z0)); int t = wave_s * 64 + (int)__builtin_amdgcn_mbcnt_hi(~0u, __builtin_amdgcn_mbcnt_lo(~0u, z0));     int b = blockIdx.x; asm volatile("" : "+s"(b)); unsigned char* ws = ws_in; asm volatile("" : "+s"(ws));
    c.tid = t; c.lane = t & 63; c.wave = __builtin_amdgcn_readfirstlane(t >> 6); c.bx = b; c.G = gridDim.x;
    const int vcu = (c.G % 8 == 0) ? (b % 8) * (c.G / 8) + b / 8 : b; c.gw = vcu * NWAVES + c.wave; c.NGW = c.G * NWAVES;
    c.ws = ws; c.ctl = (gu32*)(ws + WS_CTL); c.ROPE = (float*)(ws + WS_ROPE); c.SSQ = (float*)(ws + WS_SSQ); c.XL = ws + WS_X; c.XB = (bf16*)(ws + WS_XB); c.H = (bf16*)(ws + WS_H);
    c.QKV = (bf16*)(ws + WS_QKV); c.MIX = (bf16*)(ws + WS_MIX); c.OD = (float*)(ws + WS_OD);
    return c;
}
__device__ __forceinline__ int opaque_s(int x) { asm volatile("" : "+s"(x)); return x; }
#define INP(i) (args.in[opaque_s(i)])
constexpr int CV_GU = (DM / 64) * (FF / 64), CV_DN = (FF / 64) * (DM / 64), CV_IN = (DM / 64) * (DIN / 64), CV_OUT = (DM / 64) * (DM / 64);
constexpr int CV_LAYER = 4 * CV_GU + 2 * CV_DN + CV_IN + CV_OUT;
constexpr int CV_PRO = 2 * CV_GU + CV_DN;
constexpr int CV_T0 = CV_PRO + CV_IN + CV_OUT + 2 * CV_GU;
#define CONVERT_RANGE(id_lo, id_hi, widx, nw, wsb, scr, lane) do { \
    for (int it_ = (id_lo) + (widx); it_ < (id_hi); it_ += (nw)) { \
        const int layer_ = it_ / CV_LAYER; int r_ = it_ % CV_LAYER; \
        unsigned char* wl_ = (wsb) + WS_W + (size_t)layer_ * W_LAYER; \
        const float* src_; const float* gain_ = nullptr; int K_ = DM, N_ = FF, mode_; size_t wo_; \
        if (r_ < CV_GU) { src_ = INP(I_G1) + (size_t)layer_ * DM * FF; gain_ = INP(I_NF1) + layer_ * DM; mode_ = 1; wo_ = WO_GU1; } \
        else if ((r_ -= CV_GU) < CV_GU) { src_ = INP(I_U1) + (size_t)layer_ * DM * FF; gain_ = INP(I_NF1) + layer_ * DM; mode_ = 2; wo_ = WO_GU1; } \
        else if ((r_ -= CV_GU) < CV_DN) { src_ = INP(I_D1) + (size_t)layer_ * DM * FF; mode_ = 0; wo_ = WO_D1; K_ = FF; N_ = DM; } \
        else if ((r_ -= CV_DN) < CV_IN) { src_ = INP(I_WIN) + (size_t)layer_ * DM * DIN; gain_ = INP(I_NMIX) + layer_ * DM; mode_ = 3; wo_ = WO_IN; N_ = DIN; } \
        else if ((r_ -= CV_IN) < CV_OUT) { src_ = INP(I_WOUT) + (size_t)layer_ * DM * DM; mode_ = 0; wo_ = WO_OUT; N_ = DM; } \
        else if ((r_ -= CV_OUT) < CV_GU) { src_ = INP(I_G2) + (size_t)layer_ * DM * FF; gain_ = INP(I_NF2) + layer_ * DM; mode_ = 1; wo_ = WO_GU2; } \
        else if ((r_ -= CV_GU) < CV_GU) { src_ = INP(I_U2) + (size_t)layer_ * DM * FF; gain_ = INP(I_NF2) + layer_ * DM; mode_ = 2; wo_ = WO_GU2; } \
        else { r_ -= CV_GU; src_ = INP(I_D2) + (size_t)layer_ * DM * FF; mode_ = 0; wo_ = WO_D2; K_ = FF; N_ = DM; } \
        p0_item(src_, K_, N_, gain_, (bf16*)(wl_ + wo_), mode_, scr, r_, lane); \
    } } while (0)

__global__ void __launch_bounds__(NWAVES * 64, 2) mk_fwd(Args args) {
    extern __shared__ __attribute__((aligned(16))) unsigned char lds[];
    LAS unsigned char* L = (LAS unsigned char*)lds;
    volatile LAS unsigned* MISC = (volatile LAS unsigned*)(L + MISC_OFF);
    for (int u = threadIdx.x; u < (LDS_BYTES - LDSCTL_OFF) / 4; u += NWAVES * 64) ((LAS unsigned*)(L + LDSCTL_OFF))[u] = 0u;
    __syncthreads();
    const int wave_s = __builtin_amdgcn_readfirstlane(threadIdx.x >> 6);
    XcdBarrier bar = xcd_barrier_post((unsigned*)(args.ws + WS_CTL) + CW_BAR, MISC + 8);
    const int lo = args.ph_lo, hi = args.ph_hi; int pc = 0;
#define PH_ON() (lo <= pc && pc < hi)
#define PH_END() do { if (lo <= pc && pc + 1 < hi) xcd_barrier(bar); ++pc; } while (0)

    if (PH_ON()) {
        const Ctx c = make_ctx(args.ws, wave_s); const int lane = c.lane, gw = c.gw, NGW = c.NGW;
        LAS float* scr = (LAS float*)(L + RING_OFF + c.wave * 16640);
        CONVERT_RANGE(0, CV_PRO, gw, NGW, c.ws, scr, lane);
        for (int e = c.bx * (NWAVES * 64) + c.tid; e < SEQ * 64; e += c.G * NWAVES * 64) { float cs, sn; rope_entry(e >> 6, e & 63, cs, sn); c.ROPE[e] = cs; c.ROPE[SEQ * 64 + e] = sn; }
        const float* xin = INP(I_X);
        for (int m = gw; m < M; m += NGW) {
            const GAS f32x4* xr = (const GAS f32x4*)(xin + (size_t)m * DM) + lane; GAS unsigned long long* o8 = (GAS unsigned long long*)(c.XB + (size_t)m * DM) + lane;
            GAS unsigned* l4 = (GAS unsigned*)(c.XL + (size_t)m * DM) + lane; float s = 0.f;
#pragma unroll
            for (int j = 0; j < 8; ++j) { const f32x4 v = xr[64 * j]; const unsigned w0 = pk2(v[0], v[1]), w1 = pk2(v[2], v[3]);
                const float d0 = pg8::lo_clamp(v[0] - __uint_as_float(w0 << 16)), d1 = pg8::lo_clamp(v[1] - __uint_as_float(w0 & 0xffff0000u)), d2 = pg8::lo_clamp(v[2] - __uint_as_float(w1 << 16)), d3 = pg8::lo_clamp(v[3] - __uint_as_float(w1 & 0xffff0000u));
                s += (v[0] * v[0] + v[1] * v[1]) + (v[2] * v[2] + v[3] * v[3]);
                o8[64 * j] = (unsigned long long)w0 | ((unsigned long long)w1 << 32);
                int wl = __builtin_amdgcn_cvt_pk_fp8_f32(d0, d1, 0, false); wl = __builtin_amdgcn_cvt_pk_fp8_f32(d2, d3, wl, true); l4[64 * j] = (unsigned)wl; }
            s = wave_sum(s);
            if (lane < 8) c.SSQ[(size_t)m * 8 + lane] = (lane == 0) ? s : 0.f;
        }
    }
    PH_END();

    for (int step = 0; step < 2 * DEPTH; ++step) {
        const int layer = step >> 1, half = step & 1;
        if (PH_ON()) {
            const Ctx c = make_ctx(args.ws, wave_s); unsigned char* wl = c.ws + WS_W + (size_t)layer * W_LAYER;
            pg8::Gemm g{c.XB, (const bf16*)(wl + (half ? WO_GU2 : WO_GU1)), M, 2 * FF, DM}; pg8::StaticOrder S; S.init(M, 2 * FF, c.G, c.bx);
            pg8::EpiSwiGLU E{c.H, c.SSQ};
            if (c.bx >= 128) {
                const int lo_ = layer * CV_LAYER + (half ? CV_T0 : CV_PRO); int hi_ = half ? (layer + 1) * CV_LAYER + CV_PRO : layer * CV_LAYER + CV_T0; if (hi_ > DEPTH * CV_LAYER) hi_ = DEPTH * CV_LAYER;
                LAS float* scr_ = (LAS float*)(L + RING_OFF + c.wave * 16640);
                CONVERT_RANGE(lo_, hi_, (c.bx - 128) * NWAVES + c.wave, 128 * NWAVES, c.ws, scr_, c.lane);
                __syncthreads();
            }
            pg8::gemm_phase<pg8::EpiSwiGLU, pg8::StaticOrder, true, true>(L + RING_OFF, g, S, E, c.tid);
        }
        PH_END();
        if (PH_ON()) {
            const Ctx c = make_ctx(args.ws, wave_s); unsigned char* wl = c.ws + WS_W + (size_t)layer * W_LAYER;
            pg8::Gemm g{c.H, (const bf16*)(wl + (half ? WO_D2 : WO_D1)), M, DM, FF}; pg8::StaticOrder S; S.init(M, DM, c.G, c.bx);
            pg8::EpiResid E{c.XB, c.XL, c.SSQ, 0.5f};
            pg8::gemm_phase<pg8::EpiResid, pg8::StaticOrder, false, true>(L + RING_OFF, g, S, E, c.tid);
        }
        PH_END();
        if (half == 0) {
            if (PH_ON()) {
                const Ctx c = make_ctx(args.ws, wave_s); unsigned char* wl = c.ws + WS_W + (size_t)layer * W_LAYER;
                pg8::Gemm g{c.XB, (const bf16*)(wl + WO_IN), M, DIN, DM}; pg8::StaticOrder S; S.init(M, DIN, c.G, c.bx);
                pg8::EpiQKV E{c.QKV, c.SSQ, c.ROPE, QK_C2};
                pg8::gemm_phase<pg8::EpiQKV, pg8::StaticOrder, true, true>(L + RING_OFF, g, S, E, c.tid);
            }
            PH_END();
            if (PH_ON()) {
                {
                    using namespace dattn;
                    const Ctx c = make_ctx(args.ws, wave_s);
                    const int bh = c.bx & 7, j = c.bx >> 3, br = j >> 4, vh = (j >> 3) & 1, x = j & 7, b = bh >> 2, h = bh & 3;
                    const __hip_bfloat16* Qb = (const __hip_bfloat16*)c.QKV + (size_t)(b * SEQ) * DIN + 3072 + h * 256 + br * 128;
                    const __hip_bfloat16* Kb = (const __hip_bfloat16*)c.QKV + (size_t)(b * SEQ) * DIN + 4096 + h * 256 + br * 128;
                    const __hip_bfloat16* Vb = (const __hip_bfloat16*)c.QKV + (size_t)(b * SEQ) * DIN + 5120 + h * 256 + vh * 128;
                    float* Ob = c.OD + (size_t)br * M * 1024 + (size_t)(b * SEQ) * 1024 + h * 256 + vh * 128;
                    const int qa = x, qb2 = 15 - x;
                    BlockRef<__hip_bfloat16, float> c0{Qb + (size_t)qa * QB * QP, Kb, Vb, Ob + (size_t)qa * QB * OP, qa * QB};
                    BlockRef<__hip_bfloat16, float> c1{Qb + (size_t)qb2 * QB * QP, Kb, Vb, Ob + (size_t)qb2 * QB * OP, qb2 * QB};
                    Seam<__hip_bfloat16> S;
                    __syncthreads();
                    causal_swa_prime<__hip_bfloat16, float>(c0, SEQ, (char*)lds + RING_OFF, S, c.tid);
                    causal_swa_block<__hip_bfloat16, float>(c0, c1, SEQ, SEQ, (char*)lds + RING_OFF, S, c.tid);
                    causal_swa_block<__hip_bfloat16, float>(c1, c1, SEQ, SEQ, (char*)lds + RING_OFF, S, c.tid);
                }
                {
                    const Ctx c = make_ctx(args.ws, wave_s);
                    const int j = c.bx >> 3, bh = ((c.bx & 7) << 1) | (j >> 4), qb = j & 15, b = bh >> 3, h = bh & 7;
                    const __hip_bfloat16* Qh = (const __hip_bfloat16*)c.QKV + (size_t)(b * SEQ) * DIN + h * HD;
                    dattn::sb_unit<DM>(Qh, Qh + 1024, Qh + 2048, (__hip_bfloat16*)c.MIX + (size_t)(b * SEQ) * DM + h * HD, qb * dattn::QB, SB_EXIT, (char*)lds + RING_OFF, c.tid);
                }
            }
            PH_END();
            if (PH_ON()) {
                const Ctx c = make_ctx(args.ws, wave_s); const int lane = c.lane;
                const float linit = args.linit[opaque_s(layer)];
                const float* lq1 = INP(I_LQ1) + layer * HD; const float* lk1 = INP(I_LK1) + layer * HD; const float* lq2 = INP(I_LQ2) + layer * HD; const float* lk2 = INP(I_LK2) + layer * HD;
                const float s1 = wave_sum(lq1[lane] * lk1[lane] + lq1[lane + 64] * lk1[lane + 64]), s2 = wave_sum(lq2[lane] * lk2[lane] + lq2[lane + 64] * lk2[lane + 64]);
                const float lam = expf(s1) - expf(s2) + linit;
                const f32x4 gsub = *(const GAS f32x4*)(INP(I_SUBLN) + layer * 256 + 4 * lane);
                const float* OD = c.OD; bf16* MIX = c.MIX;
                for (int idx = c.gw; idx < M * 4; idx += 4 * c.NGW) {
                    f32x4 o1[4], o2[4];
#pragma unroll
                    for (int q = 0; q < 4; ++q) { const int id = idx + q * c.NGW, row = id >> 2, h = id & 3;
                        o1[q] = *(const GAS f32x4*)(OD + (size_t)row * 1024 + h * 256 + 4 * lane); o2[q] = *(const GAS f32x4*)(OD + (size_t)M * 1024 + (size_t)row * 1024 + h * 256 + 4 * lane); }
#pragma unroll
                    for (int q = 0; q < 4; ++q) { const int id = idx + q * c.NGW, row = id >> 2, h = id & 3;
                        const f32x4 d = o1[q] - o2[q] * lam;
                        const float ss = wave_sum((d[0] * d[0] + d[1] * d[1]) + (d[2] * d[2] + d[3] * d[3]));
                        const float r = (1.0f / sqrtf(ss * (1.0f / 256.0f) + RMS_EPS)) * (1.0f - linit);
                        const f32x4 y = d * gsub * r;
                        *(GAS unsigned long long*)(MIX + (size_t)row * DM + 1024 + h * 256 + 4 * lane) = (unsigned long long)pk2(y[0], y[1]) | ((unsigned long long)pk2(y[2], y[3]) << 32); }
                }
            }
            PH_END();
            if (PH_ON()) {
                const Ctx c = make_ctx(args.ws, wave_s); unsigned char* wl = c.ws + WS_W + (size_t)layer * W_LAYER;
                pg8::Gemm g{c.MIX, (const bf16*)(wl + WO_OUT), M, DM, DM}; pg8::StaticOrder S; S.init(M, DM, c.G, c.bx);
                pg8::EpiResid E{c.XB, c.XL, c.SSQ, 1.0f};
                pg8::gemm_phase<pg8::EpiResid, pg8::StaticOrder, false, true>(L + RING_OFF, g, S, E, c.tid);
            }
            PH_END();
        }
    }
    if (PH_ON()) {
        const Ctx c = make_ctx(args.ws, wave_s); const int lane = c.lane;
        const bool bad = (__hip_atomic_load(c.ctl + CW_BAR + XB_TMO, RLX_AGENT) != 0u);
        const float* gf = INP(I_NFIN); float* out = args.out;
        for (int m = c.gw; m < M; m += c.NGW) {
            const GAS unsigned long long* xr = (const GAS unsigned long long*)(c.XB + (size_t)m * DM) + lane; const GAS unsigned* xl = (const GAS unsigned*)(c.XL + (size_t)m * DM) + lane; GAS f32x4* o = (GAS f32x4*)(out + (size_t)m * DM) + lane; f32x4 v[8]; float s = 0.f;
#pragma unroll
            for (int j = 0; j < 8; ++j) { const unsigned long long w = xr[64 * j]; const int wl = (int)xl[64 * j]; const unsigned w0 = (unsigned)w, w1 = (unsigned)(w >> 32);
                const pg8::f32x2v_ la = __builtin_amdgcn_cvt_pk_f32_fp8(wl, false), lb = __builtin_amdgcn_cvt_pk_f32_fp8(wl, true);
                v[j] = (f32x4){__uint_as_float(w0 << 16) + la.x * pg8::LO_INV, __uint_as_float(w0 & 0xffff0000u) + la.y * pg8::LO_INV,
                               __uint_as_float(w1 << 16) + lb.x * pg8::LO_INV, __uint_as_float(w1 & 0xffff0000u) + lb.y * pg8::LO_INV};
                s += (v[j][0] * v[j][0] + v[j][1] * v[j][1]) + (v[j][2] * v[j][2] + v[j][3] * v[j][3]); }
            float r = 1.0f / sqrtf(wave_sum(s) * (1.0f / DM) + RMS_EPS); if (bad) r = __builtin_nanf("");
#pragma unroll
            for (int j = 0; j < 8; ++j) o[64 * j] = v[j] * *((const GAS f32x4*)gf + lane + 64 * j) * r;
        }
    }
    PH_END();
#undef PH_ON
#undef PH_END
}
constexpr int N_PHASES = 1 + 2 * DEPTH * 2 + DEPTH * 4 + 1;

#ifndef MK_MULTI
#define MK_MULTI 0
#endif
extern "C" void kernel_launch(void* const* d_in, const int* in_sizes, int n_in, void* d_out, int out_size, void* d_ws, size_t ws_size, hipStream_t stream) {
    static int grid = 0;
    if (grid == 0) {
        if (n_in != 18 || in_sizes[0] != M * DM || out_size != M * DM || ws_size < WS_END) { fprintf(stderr, "kernel_launch: shape/workspace mismatch (n_in %d, in0 %d, out %d, ws %zu < %zu)\n", n_in, n_in > 0 ? in_sizes[0] : -1, out_size, ws_size, (size_t)WS_END); grid = -1; return; }
        if (hipFuncSetAttribute((const void*)mk_fwd, hipFuncAttributeMaxDynamicSharedMemorySize, LDS_BYTES) != hipSuccess) { fprintf(stderr, "kernel_launch: hipFuncSetAttribute failed\n"); grid = -1; return; }
        int per_cu = 0;
        if (hipOccupancyMaxActiveBlocksPerMultiprocessor(&per_cu, (const void*)mk_fwd, NWAVES * 64, LDS_BYTES) != hipSuccess || per_cu < 1) fprintf(stderr, "kernel_launch: occupancy query reports %d\n", per_cu);
        (void)hipGetLastError();
        grid = 256;
    }
    if (grid < 0) return;
    (void)hipMemsetAsync((char*)d_ws + WS_CTL, 0, CTL_ZERO_BYTES, stream);
    Args a{};
    for (int i = 0; i < 18; ++i) a.in[i] = (const float*)d_in[i];
    a.out = (float*)d_out; a.ws = (unsigned char*)d_ws;
    for (int l = 0; l < DEPTH; ++l) a.linit[l] = (float)(0.8 - 0.6 * exp(-0.3 * (double)l));
#if MK_MULTI
    for (int p = 0; p < N_PHASES; ++p) { a.ph_lo = p; a.ph_hi = p + 1; hipLaunchKernelGGL(mk_fwd, dim3(grid), dim3(NWAVES * 64), LDS_BYTES, stream, a); }
#else
    a.ph_lo = 0; a.ph_hi = N_PHASES;
    hipLaunchKernelGGL(mk_fwd, dim3(grid), dim3(NWAVES * 64), LDS_BYTES, stream, a);
#endif
    const hipError_t le = hipPeekAtLastError();
    if (le != hipSuccess) fprintf(stderr, "kernel_launch: launch failed: %s\n", hipGetErrorName(le));
}
```

```cpp
#include <hip/hip_bf16.h>
#include <cmath>
#include <hip/hip_runtime.h>
#include <cstdio>
#include <cstdint>
namespace pg8 {
#define PG8_LAS __attribute__((address_space(3)))
typedef unsigned short bf16_t;
typedef short bf16x8 __attribute__((ext_vector_type(8)));
typedef float f32x4 __attribute__((ext_vector_type(4)));
typedef unsigned u32x4 __attribute__((ext_vector_type(4)));
constexpr int BM = 256, BK = 64, HALF = 128, HTB = HALF * BK * 2  , STAGE_BYTES = 8 * HTB, NXCD = 8, WGM = 4;

__host__ __device__ __forceinline__ int lds_byte(int r, int c) { const int st = (r >> 4) * 2 + (c >> 5), rr = r & 15, cc = c & 31, ob = rr * 64 + cc * 2; return st * 1024 + (ob ^ (((ob >> 9) & 1) << 5)); }
__host__ __device__ __forceinline__ void stage_rc(int b, int& R, int& C) { const int st = b / 1024, sb = b % 1024, swz = sb ^ (((sb >> 9) & 1) << 5); R = (st >> 1) * 16 + swz / 64; C = (st & 1) * 32 + (swz % 64) / 2; }
__host__ __device__ __forceinline__ int perm32(int rho) { const int n = rho >> 4, i = rho & 15; return 8 * (i >> 2) + 4 * n + (i & 3); }

struct Unit { int pm, pn; };
struct Gemm { const bf16_t* A; const bf16_t* Bt; int M, N, K; };

struct StaticOrder {
    int nM, nN, nwg, G, c;
    __host__ __device__ void init(int M, int N, int G_, int c_) { nM = M / BM; nN = N / BM; nwg = nM * nN; G = G_; c = c_; }
    __host__ __device__ bool next(int i, Unit& u) const {
        const long L = (long)i * G + c; if (L >= nwg) return false;
        int wgid = (int)L; { const int q = nwg / NXCD, r = nwg % NXCD, xcd = wgid % NXCD, off = wgid / NXCD; wgid = (xcd < r ? xcd * (q + 1) : r * (q + 1) + (xcd - r) * q) + off; }
        const int nig = WGM * nN, gid = wgid / nig, fm = gid * WGM, gsz = (nM - fm) < WGM ? (nM - fm) : WGM;
        u.pm = fm + ((wgid % nig) % gsz); u.pn = (wgid % nig) / gsz; return true;
    }
    __device__ __forceinline__ void a_ready(const Unit&) const {}
    __device__ __forceinline__ void done(const Unit&) const {}
};

typedef float f32x2_t_ __attribute__((ext_vector_type(2))); typedef __bf16 bf16x2_t_ __attribute__((ext_vector_type(2)));
__device__ __forceinline__ unsigned cvt_pk_bf16(float lo, float hi) { f32x2_t_ v = {lo, hi}; bf16x2_t_ b = __builtin_convertvector(v, bf16x2_t_); return __builtin_bit_cast(unsigned, b); }
constexpr int DM_ = 2048, FF_ = 5632, DIN_ = 6144, SEQ_ = 4096;
constexpr float RMS_EPS_ = 1e-6f;
template <int PAT> __device__ __forceinline__ float swz_xor(float v) { return __int_as_float(__builtin_amdgcn_ds_swizzle(__float_as_int(v), PAT)); }
__device__ __forceinline__ float half_swap_sum(float v) { auto rr = __builtin_amdgcn_permlane32_swap(__float_as_uint(v), __float_as_uint(v), false, false); return __uint_as_float(rr[0]) + __uint_as_float(rr[1]); }
__device__ __forceinline__ float wave_sum_nolane(float v) { v += swz_xor<0x041F>(v); v += swz_xor<0x081F>(v); v += swz_xor<0x101F>(v); v += swz_xor<0x201F>(v); v += swz_xor<0x401F>(v); return half_swap_sum(v); }
__device__ __forceinline__ float row_rstd(const float* ssq, int row) {
    const f32x4 a = *(const f32x4*)(ssq + (size_t)row * 8), b = *(const f32x4*)(ssq + (size_t)row * 8 + 4);
    const float s = ((a[0] + a[1]) + (a[2] + a[3])) + ((b[0] + b[1]) + (b[2] + b[3]));
    return __builtin_amdgcn_rsqf(s * (1.0f / DM_) + RMS_EPS_);
}
struct EpiSwiGLU {
    static constexpr bool PERM = true, AFTER_DRAIN = false;
    bf16_t* H; const float* ssq;
    __device__ __forceinline__ void operator()(const f32x4 (&acc)[2][2][4][2], const Unit& u, int wr, int wc, int fr, int fq) const {
        const int row0 = u.pm * BM + wr * 64 + fr, col0 = u.pn * HALF + wc * 32 + 8 * fq;
        float rsv[8];
#pragma unroll
        for (int q = 0; q < 8; ++q) rsv[q] = row_rstd(ssq, row0 + (q >> 2) * HALF + (q & 3) * 16);
#pragma unroll
        for (int ai = 0; ai < 2; ++ai)
#pragma unroll
            for (int m = 0; m < 4; ++m) { const int row = row0 + ai * HALF + m * 16; const float rs = rsv[ai * 4 + m], rsn = rs * -1.4426950408889634f, rs2 = rs * rs;
                f32x4 hv[2];
#pragma unroll
                for (int n = 0; n < 2; ++n) { const f32x4 g = acc[ai][0][m][n], up = acc[ai][1][m][n]; const f32x4 a = g * rsn; f32x4 e;
                    e[0] = __builtin_amdgcn_exp2f(a[0]); e[1] = __builtin_amdgcn_exp2f(a[1]); e[2] = __builtin_amdgcn_exp2f(a[2]); e[3] = __builtin_amdgcn_exp2f(a[3]);
                    const f32x4 d = e + 1.0f; f32x4 r; r[0] = __builtin_amdgcn_rcpf(d[0]); r[1] = __builtin_amdgcn_rcpf(d[1]); r[2] = __builtin_amdgcn_rcpf(d[2]); r[3] = __builtin_amdgcn_rcpf(d[3]);
                    hv[n] = (g * up) * (r * rs2); }
                u32x4 w; w.x = cvt_pk_bf16(hv[0][0], hv[0][1]); w.y = cvt_pk_bf16(hv[0][2], hv[0][3]); w.z = cvt_pk_bf16(hv[1][0], hv[1][1]); w.w = cvt_pk_bf16(hv[1][2], hv[1][3]);
                *(u32x4*)(H + (size_t)row * FF_ + col0) = w; }
    }
};
struct EpiQKV {
    static constexpr bool PERM = true, AFTER_DRAIN = false;
    bf16_t* QKV; const float* ssq; const float* rope; float qscale;
    __device__ __forceinline__ void operator()(const f32x4 (&acc)[2][2][4][2], const Unit& u, int wr, int wc, int fr, int fq) const {
        const int sec = u.pn >> 2; const bool rp = (sec == 3) || (sec == 4); const float qs = (sec == 0) ? qscale : 1.0f;
        const int row0 = u.pm * BM + wr * 64 + fr, i0 = 32 * (wc & 1) + 8 * fq;
        float rsv[8];
#pragma unroll
        for (int q = 0; q < 8; ++q) rsv[q] = row_rstd(ssq, row0 + (q >> 2) * HALF + (q & 3) * 16) * qs;
        bf16_t* pbase = QKV + (size_t)row0 * DIN_ + u.pn * BM + (wc >> 1) * HALF + i0;
        if (!rp) {
#pragma unroll
            for (int ai = 0; ai < 2; ++ai)
#pragma unroll
                for (int m = 0; m < 4; ++m) { const float rs = rsv[ai * 4 + m];
#pragma unroll
                    for (int bj = 0; bj < 2; ++bj) { const f32x4 v0 = acc[ai][bj][m][0] * rs, v1 = acc[ai][bj][m][1] * rs;
                        u32x4 w; w.x = cvt_pk_bf16(v0[0], v0[1]); w.y = cvt_pk_bf16(v0[2], v0[3]); w.z = cvt_pk_bf16(v1[0], v1[1]); w.w = cvt_pk_bf16(v1[2], v1[3]);
                        *(u32x4*)(pbase + (size_t)(ai * HALF + m * 16) * DIN_ + bj * 64) = w; } }
        } else {
#pragma unroll
            for (int ai = 0; ai < 2; ++ai)
#pragma unroll
                for (int mp = 0; mp < 2; ++mp) {
                    f32x4 csv[2][2], snv[2][2];
#pragma unroll
                    for (int k = 0; k < 2; ++k) { const int pos = (row0 + ai * HALF + (2 * mp + k) * 16) & (SEQ_ - 1);
#pragma unroll
                        for (int n = 0; n < 2; ++n) { csv[k][n] = *(const f32x4*)(rope + (size_t)pos * 64 + i0 + 4 * n); snv[k][n] = *(const f32x4*)(rope + (size_t)SEQ_ * 64 + (size_t)pos * 64 + i0 + 4 * n); } }
                    asm volatile("" ::: "memory");
#pragma unroll
                    for (int k = 0; k < 2; ++k) { const int m = 2 * mp + k; const float rs = rsv[ai * 4 + m];
                        f32x4 o0[2], o1[2];
#pragma unroll
                        for (int n = 0; n < 2; ++n) { const f32x4 lo = acc[ai][0][m][n] * rs, hi = acc[ai][1][m][n] * rs; o0[n] = lo * csv[k][n] - hi * snv[k][n]; o1[n] = hi * csv[k][n] + lo * snv[k][n]; }
                        bf16_t* p = pbase + (size_t)(ai * HALF + m * 16) * DIN_;
                        u32x4 a, b; a.x = cvt_pk_bf16(o0[0][0], o0[0][1]); a.y = cvt_pk_bf16(o0[0][2], o0[0][3]); a.z = cvt_pk_bf16(o0[1][0], o0[1][1]); a.w = cvt_pk_bf16(o0[1][2], o0[1][3]);
                        b.x = cvt_pk_bf16(o1[0][0], o1[0][1]); b.y = cvt_pk_bf16(o1[0][2], o1[0][3]); b.z = cvt_pk_bf16(o1[1][0], o1[1][1]); b.w = cvt_pk_bf16(o1[1][2], o1[1][3]);
                        *(u32x4*)p = a; *(u32x4*)(p + 64) = b; }
                    asm volatile("" ::: "memory"); }
        }
    }
};
typedef float f32x2v_ __attribute__((ext_vector_type(2)));
constexpr float LO_SCALE = 512.0f, LO_INV = 1.0f / 512.0f, LO_MAX = 224.0f;
__device__ __forceinline__ float lo_clamp(float d) { return __builtin_fminf(__builtin_fmaxf(d * LO_SCALE, -LO_MAX), LO_MAX); }
struct EpiResid {
    static constexpr bool PERM = true, AFTER_DRAIN = true;
    bf16_t* XB; unsigned char* XL; float* ssq; float alpha;
    __device__ __forceinline__ void fused(f32x4 (&acc)[2][2][4][2], const Unit& u, int wr, int wc, int fr, int fq, PG8_LAS unsigned char* lds, int wid, int lane) const {
        typedef unsigned u32x2 __attribute__((ext_vector_type(2)));
        PG8_LAS float* P = (PG8_LAS float*)lds;
        const int col0 = u.pn * BM + wc * 32 + 8 * fq;
#pragma unroll
        for (int ai = 0; ai < 2; ++ai) {
            u32x4 ph[4][2]; u32x2 pl[4][2];
#pragma unroll
            for (int m = 0; m < 4; ++m) { const size_t off = (size_t)(u.pm * BM + ai * HALF + wr * 64 + m * 16 + fr) * DM_ + col0;
#pragma unroll
                for (int bj = 0; bj < 2; ++bj) { ph[m][bj] = *(const u32x4*)(XB + off + bj * HALF); pl[m][bj] = *(const u32x2*)(XL + off + bj * HALF); } }
            asm volatile("" ::: "memory");
#pragma unroll
            for (int m = 0; m < 4; ++m) { const int r = ai * HALF + wr * 64 + m * 16 + fr; const size_t off = (size_t)(u.pm * BM + r) * DM_ + col0; float s = 0.f;
#pragma unroll
                for (int bj = 0; bj < 2; ++bj) { const u32x4 a = ph[m][bj]; const u32x2 b = pl[m][bj]; u32x4 wh; int wl0 = 0, wl1 = 0;
#pragma unroll
                    for (int q = 0; q < 4; ++q) {
                        const f32x2v_ l = (q & 1) ? __builtin_amdgcn_cvt_pk_f32_fp8((int)(q < 2 ? b.x : b.y), true) : __builtin_amdgcn_cvt_pk_f32_fp8((int)(q < 2 ? b.x : b.y), false);
                        const float x0 = __uint_as_float(a[q] << 16) + l.x * LO_INV, x1 = __uint_as_float(a[q] & 0xffff0000u) + l.y * LO_INV;
                        const float v0 = x0 + acc[ai][bj][m][q >> 1][(q & 1) * 2] * alpha, v1 = x1 + acc[ai][bj][m][q >> 1][(q & 1) * 2 + 1] * alpha;
                        const unsigned h = cvt_pk_bf16(v0, v1); wh[q] = h;
                        const float d0 = lo_clamp(v0 - __uint_as_float(h << 16)), d1 = lo_clamp(v1 - __uint_as_float(h & 0xffff0000u));
                        if (q == 0) wl0 = __builtin_amdgcn_cvt_pk_fp8_f32(d0, d1, wl0, false); else if (q == 1) wl0 = __builtin_amdgcn_cvt_pk_fp8_f32(d0, d1, wl0, true);
                        else if (q == 2) wl1 = __builtin_amdgcn_cvt_pk_fp8_f32(d0, d1, wl1, false); else wl1 = __builtin_amdgcn_cvt_pk_fp8_f32(d0, d1, wl1, true);
                        s += v0 * v0 + v1 * v1; }
                    *(u32x4*)(XB + off + bj * HALF) = wh; u32x2 wl; wl.x = (unsigned)wl0; wl.y = (unsigned)wl1; *(u32x2*)(XL + off + bj * HALF) = wl; }
                s += swz_xor<0x401F>(s); s = half_swap_sum(s);
                if (fq == 0) P[r * 4 + wc] = s; }
            asm volatile("" ::: "memory"); }
        asm volatile("s_waitcnt lgkmcnt(0)" ::: "memory"); __builtin_amdgcn_s_barrier(); asm volatile("" ::: "memory");
        const int t = wid * 64 + lane;
        if (t < 256) { const f32x4 p = *(const PG8_LAS f32x4*)(P + t * 4); ssq[(size_t)(u.pm * BM + t) * 8 + u.pn] = (p[0] + p[1]) + (p[2] + p[3]); }
        asm volatile("s_waitcnt lgkmcnt(0)" ::: "memory"); __builtin_amdgcn_s_barrier(); asm volatile("" ::: "memory");
    }
};

template <class Epi, class Sched, bool ALIGN_EPI = false, bool SP2 = false>
__device__ __forceinline__ void gemm_phase(PG8_LAS unsigned char* lds, const Gemm g, const Sched& S, const Epi& E, int tid_in) {
    int tid_ = tid_in; asm volatile("" : "+v"(tid_));
    const int tid = tid_, wid = __builtin_amdgcn_readfirstlane(tid >> 6), lane = tid & 63, wr = wid >> 2, wc = wid & 3, fr = lane & 15, fq = lane >> 4;
    const int K = g.K, nt = K / BK;
    unsigned voffA[2], voffB[2];
#pragma unroll
    for (int i = 0; i < 2; ++i) { int R, C; stage_rc(tid * 16 + i * 8192, R, C); const int Rb = Epi::PERM ? ((R & ~31) + perm32(R & 31)) : R;
        voffA[i] = (unsigned)(R * K + C) * 2u; voffB[i] = (unsigned)(Rb * K + C) * 2u; }
    const size_t kstep = (size_t)(BK * 2);
    const size_t hstep = (size_t)HALF * K * 2;
    const size_t tstep = 2 * hstep;
    const unsigned ldsw = (unsigned)wid * 1024u;
    const int aoff = lds_byte(wr * 64 + fr, fq * 8), boff = lds_byte(wc * 32 + fr, fq * 8);
#define PG8_SA(b, h) (((b) * 2 + (h)) * HTB)
#define PG8_SB(b, h) ((4 + (b) * 2 + (h)) * HTB)
#define PG8_STAGE(bufoff, gbase, voff) do { _Pragma("unroll") for (int _i = 0; _i < 2; ++_i) \
        __builtin_amdgcn_global_load_lds((const unsigned*)((const char*)(gbase) + (voff)[_i]), (PG8_LAS unsigned*)(lds + (bufoff) + ldsw + _i * 8192), 16, 0, 0); } while (0)
#define PG8_LDA(dst, b, h) do { _Pragma("unroll") for (int m = 0; m < 4; ++m) _Pragma("unroll") for (int k = 0; k < 2; ++k) dst[m][k] = *(const PG8_LAS bf16x8*)(lds + PG8_SA(b, h) + aoff + m * 2048 + k * 1024); } while (0)
#define PG8_LDB(dst, b, h) do { _Pragma("unroll") for (int n = 0; n < 2; ++n) _Pragma("unroll") for (int k = 0; k < 2; ++k) dst[n][k] = *(const PG8_LAS bf16x8*)(lds + PG8_SB(b, h) + boff + n * 2048 + k * 1024); } while (0)
#define PG8_MMA(ai, bj, At, Bt) do { __builtin_amdgcn_s_setprio(1); _Pragma("unroll") for (int m = 0; m < 4; ++m) _Pragma("unroll") for (int n = 0; n < 2; ++n) _Pragma("unroll") for (int k = 0; k < 2; ++k) \
        acc[ai][bj][m][n] = __builtin_amdgcn_mfma_f32_16x16x32_bf16(Bt[n][k], At[m][k], acc[ai][bj][m][n], 0, 0, 0); __builtin_amdgcn_s_setprio(0); } while (0)
#define PG8_WAIT_V(n) asm volatile("s_waitcnt vmcnt(" #n ")" ::: "memory")
#define PG8_WAIT_L(n) asm volatile("s_waitcnt lgkmcnt(" #n ")" ::: "memory")
#define PG8_BAR __builtin_amdgcn_s_barrier()
#define PG8_SCHED __builtin_amdgcn_sched_barrier(0)
    Unit cur, nxt; int ui = 0;
    if (!S.next(0, cur)) return;
    f32x4 acc[2][2][4][2];
#pragma unroll
    for (int a = 0; a < 2; ++a)
#pragma unroll
        for (int b = 0; b < 2; ++b)
#pragma unroll
            for (int m = 0; m < 4; ++m)
#pragma unroll
                for (int n = 0; n < 2; ++n) acc[a][b][m][n] = (f32x4){0.f, 0.f, 0.f, 0.f};
    bf16x8 At[4][2], B0[2][2], B1[2][2];
    const char* cA = (const char*)g.A + (size_t)cur.pm * tstep; const char* cB = (const char*)g.Bt + (size_t)cur.pn * tstep;
    S.a_ready(cur);
    if constexpr (SP2) {
        PG8_STAGE(PG8_SB(0, 0), cB, voffB); PG8_STAGE(PG8_SB(0, 1), cB + hstep, voffB); PG8_STAGE(PG8_SA(0, 0), cA, voffA); PG8_STAGE(PG8_SA(0, 1), cA + hstep, voffA);
        if (wr == 1) PG8_BAR;
        PG8_WAIT_V(2); PG8_BAR;
        PG8_STAGE(PG8_SB(1, 0), cB + kstep, voffB); PG8_STAGE(PG8_SA(1, 0), cA + kstep, voffA); PG8_STAGE(PG8_SB(1, 1), cB + hstep + kstep, voffB);
        PG8_WAIT_V(6); PG8_BAR;
    } else {
        PG8_STAGE(PG8_SB(0, 0), cB, voffB); PG8_STAGE(PG8_SA(0, 0), cA, voffA); PG8_STAGE(PG8_SB(0, 1), cB + hstep, voffB); PG8_STAGE(PG8_SA(0, 1), cA + hstep, voffA);
        if (wr == 1) PG8_BAR;
        PG8_WAIT_V(4); PG8_BAR;
        PG8_STAGE(PG8_SB(1, 0), cB + kstep, voffB); PG8_STAGE(PG8_SA(1, 0), cA + kstep, voffA); PG8_STAGE(PG8_SB(1, 1), cB + hstep + kstep, voffB);
        PG8_WAIT_V(6); PG8_BAR;
    }
    for (;;) {
        const bool has_next = S.next(ui + 1, nxt);
        const char* nA = has_next ? (const char*)g.A + (size_t)nxt.pm * tstep : cA; const char* nB = has_next ? (const char*)g.Bt + (size_t)nxt.pn * tstep : cB;
        for (int t = 0; t < nt; t += 2) {
            const bool last = (t == nt - 2);
            const char* a1 = cA + (size_t)(t + 1) * kstep;
            const char* a2 = last ? nA : cA + (size_t)(t + 2) * kstep; const char* b2 = last ? nB : cB + (size_t)(t + 2) * kstep;
            const char* a3 = a2 + kstep; const char* b3 = b2 + kstep;
            if (last && has_next) S.a_ready(nxt);
            if constexpr (SP2) {
            PG8_LDB(B0, 0, 0); PG8_LDB(B1, 0, 1); PG8_SCHED; PG8_LDA(At, 0, 0); PG8_STAGE(PG8_SA(1, 1), a1 + hstep, voffA);
            PG8_WAIT_V(8); PG8_WAIT_L(0); PG8_BAR; PG8_MMA(0, 0, At, B0); PG8_MMA(0, 1, At, B1); PG8_BAR; PG8_SCHED;
            PG8_LDA(At, 0, 1); PG8_STAGE(PG8_SB(0, 0), b2, voffB); PG8_STAGE(PG8_SB(0, 1), b2 + hstep, voffB); PG8_STAGE(PG8_SA(0, 0), a2, voffA);
            PG8_WAIT_V(8); PG8_WAIT_L(0); PG8_BAR; PG8_MMA(1, 0, At, B0); PG8_MMA(1, 1, At, B1); PG8_BAR; PG8_SCHED;
            PG8_LDB(B0, 1, 0); PG8_LDB(B1, 1, 1); PG8_SCHED; PG8_LDA(At, 1, 0); PG8_STAGE(PG8_SA(0, 1), a2 + hstep, voffA);
            PG8_WAIT_V(8); PG8_WAIT_L(0); PG8_BAR; PG8_MMA(0, 0, At, B0); PG8_MMA(0, 1, At, B1); PG8_BAR; PG8_SCHED;
            PG8_LDA(At, 1, 1); PG8_STAGE(PG8_SB(1, 0), b3, voffB); PG8_STAGE(PG8_SB(1, 1), b3 + hstep, voffB); PG8_STAGE(PG8_SA(1, 0), a3, voffA);
            PG8_WAIT_V(8); PG8_WAIT_L(0); PG8_BAR; PG8_MMA(1, 0, At, B0); PG8_MMA(1, 1, At, B1); PG8_BAR; PG8_SCHED;
            } else {
            PG8_LDB(B0, 0, 0); PG8_SCHED; PG8_LDA(At, 0, 0); PG8_STAGE(PG8_SA(1, 1), a1 + hstep, voffA);
            PG8_WAIT_L(8); PG8_BAR; PG8_WAIT_L(0); PG8_MMA(0, 0, At, B0); PG8_BAR; PG8_SCHED;
            PG8_LDB(B1, 0, 1); PG8_STAGE(PG8_SB(0, 0), b2, voffB);
            PG8_BAR; PG8_WAIT_L(0); PG8_MMA(0, 1, At, B1); PG8_BAR;
            PG8_LDA(At, 0, 1); PG8_STAGE(PG8_SA(0, 0), a2, voffA);
            PG8_BAR; PG8_WAIT_L(0); PG8_MMA(1, 0, At, B0); PG8_BAR; PG8_SCHED;
            PG8_STAGE(PG8_SB(0, 1), b2 + hstep, voffB);
            PG8_WAIT_V(6); PG8_BAR; PG8_MMA(1, 1, At, B1); PG8_BAR;
            PG8_LDB(B0, 1, 0); PG8_SCHED; PG8_LDA(At, 1, 0); PG8_STAGE(PG8_SA(0, 1), a2 + hstep, voffA);
            PG8_WAIT_L(8); PG8_BAR; PG8_WAIT_L(0); PG8_MMA(0, 0, At, B0); PG8_BAR; PG8_SCHED;
            PG8_LDB(B1, 1, 1); PG8_STAGE(PG8_SB(1, 0), b3, voffB);
            PG8_BAR; PG8_WAIT_L(0); PG8_MMA(0, 1, At, B1); PG8_BAR;
            PG8_LDA(At, 1, 1); PG8_STAGE(PG8_SA(1, 0), a3, voffA);
            PG8_BAR; PG8_WAIT_L(0); PG8_MMA(1, 0, At, B0); PG8_BAR; PG8_SCHED;
            PG8_STAGE(PG8_SB(1, 1), b3 + hstep, voffB);
            PG8_WAIT_V(6); PG8_BAR; PG8_MMA(1, 1, At, B1); PG8_BAR;
            }
        }
        if constexpr (ALIGN_EPI) { if (wr == 0) PG8_BAR; }
        if constexpr (!Epi::AFTER_DRAIN) { E(acc, cur, wr, wc, fr, fq); S.done(cur); }
        if (!has_next) break;
#pragma unroll
        for (int a = 0; a < 2; ++a)
#pragma unroll
            for (int b = 0; b < 2; ++b)
#pragma unroll
                for (int m = 0; m < 4; ++m)
#pragma unroll
                    for (int n = 0; n < 2; ++n) acc[a][b][m][n] = (f32x4){0.f, 0.f, 0.f, 0.f};
        cur = nxt; cA = nA; cB = nB; ++ui;
        if constexpr (ALIGN_EPI) { if (wr == 1) PG8_BAR; }
    }
    PG8_WAIT_V(0);
    if constexpr (!ALIGN_EPI) { if (wr == 0) PG8_BAR; }
    PG8_BAR;
    if constexpr (Epi::AFTER_DRAIN) { E.fused(acc, cur, wr, wc, fr, fq, lds, wid, lane); S.done(cur); }
#undef PG8_SA
#undef PG8_SB
#undef PG8_STAGE
#undef PG8_LDA
#undef PG8_LDB
#undef PG8_MMA
#undef PG8_WAIT_V
#undef PG8_WAIT_L
#undef PG8_BAR
#undef PG8_SCHED
}
}
namespace dattn {
constexpr int D = 128;
constexpr int QP = 6144, KVP = 6144, OP = 1024;
constexpr float THR = 8.f;
constexpr bool WSKIP = false;
constexpr float SCALE = 0.08838834764831845f;
constexpr int NW = 8, QBLK = 32, KVBLK = 64, QB = NW * QBLK;
constexpr int SHM_V = KVBLK * D * 2, SHM_K = KVBLK * D * 2;
constexpr int LDS_BYTES = 2 * SHM_V + 2 * SHM_K + NW * 64 * 4;
using bf16 = __hip_bfloat16;
typedef short bf16x8 __attribute__((ext_vector_type(8)));
typedef short s16x4 __attribute__((ext_vector_type(4)));
typedef float f32x16 __attribute__((ext_vector_type(16)));
typedef float f32x4 __attribute__((ext_vector_type(4)));
typedef unsigned u32x4 __attribute__((ext_vector_type(4)));
template <class A, class Bt> struct same_t { static constexpr bool v = false; };
template <class A> struct same_t<A, A> { static constexpr bool v = true; };

#define KSWZ(row, colB) ((row) * 256 + ((colB) ^ (((row) & 7) << 4)))
#define SBAR() __builtin_amdgcn_sched_barrier(0)
__device__ __forceinline__ int v_st(int k, int c) { const int kk = (k & ~0xC) | ((k & 4) << 1) | ((k & 8) >> 1); return ((kk >> 3) * 4 + (c >> 5)) * 512 + ((kk & 7) * 32 + (c & 31)) * 2; }
__device__ __forceinline__ int v_rd_base(int lane) { return ((lane & 3) << 3) | (((lane >> 2) & 3) << 6) | (((lane >> 4) & 1) << 5) | (((lane >> 5) & 1) << 8); }
constexpr int v_rd_off(int d0, int ks, int half) { return d0 * 512 + ks * 4096 + half * 2048; }
__device__ __forceinline__ int crow(int r, int hi) { return (r & 3) + 8 * (r >> 2) + 4 * hi; }
__device__ __forceinline__ unsigned cvtpk(float lo, float hi) {
    unsigned r; asm volatile("v_cvt_pk_bf16_f32 %0, %1, %2" : "=v"(r) : "v"(lo), "v"(hi)); return r;
}
__device__ __forceinline__ bf16x8 pack8(f32x4 a, f32x4 b) {
    u32x4 w = {cvtpk(a[0], a[1]), cvtpk(a[2], a[3]), cvtpk(b[0], b[1]), cvtpk(b[2], b[3])};
    return *reinterpret_cast<bf16x8*>(&w);
}
template <class T> __device__ __forceinline__ bf16x8 load8(const T* p) {
    if constexpr (same_t<T, float>::v) { return pack8(*(const f32x4*)p, *(const f32x4*)(p + 4)); }
    else { return *reinterpret_cast<const bf16x8*>(p); }
}
__device__ __forceinline__ void mask_tile(f32x16& p0, f32x16& p1, int dq, unsigned W) {
    const float NEG = -__builtin_inff();
#pragma unroll
    for (int r = 0; r < 16; ++r) {
        const int c = (r & 3) + 8 * (r >> 2);
        if ((unsigned)(dq - c) >= W) p0[r] = NEG;
        if ((unsigned)(dq - c - 32) >= W) p1[r] = NEG;
    }
}
__device__ __forceinline__ void partialSM(f32x16& p0, f32x16& p1, float& m_reg, float& mn, float& alpha) {
    float pmax = p0[0]; for (int r = 1; r < 16; ++r) pmax = fmaxf(pmax, p0[r]); for (int r = 0; r < 16; ++r) pmax = fmaxf(pmax, p1[r]);
    { auto rr = __builtin_amdgcn_permlane32_swap(__float_as_uint(pmax), __float_as_uint(pmax), false, false);
      pmax = fmaxf(__uint_as_float(rr[0]), __uint_as_float(rr[1])); }
    constexpr float C2 = 1.4426950408889634f * SCALE;
    if (__builtin_expect(__all((pmax - m_reg) * SCALE <= THR), 1)) { mn = m_reg; alpha = 1.f; }
    else { mn = fmaxf(m_reg, pmax); alpha = __builtin_amdgcn_exp2f((m_reg - mn) * C2); m_reg = mn; }
    const float mnL = -mn * C2;
    for (int r = 0; r < 16; ++r) p0[r] = fmaf(p0[r], C2, mnL); for (int r = 0; r < 16; ++r) p1[r] = fmaf(p1[r], C2, mnL);
    for (int r = 0; r < 16; ++r) p0[r] = __builtin_amdgcn_exp2f(p0[r]);
}
__device__ __forceinline__ void finishSM(f32x16& p0, f32x16& p1, float alpha, float& l_reg, bf16x8& pa0, bf16x8& pa1, bf16x8& pa2, bf16x8& pa3) {
    for (int r = 0; r < 16; ++r) p1[r] = __builtin_amdgcn_exp2f(p1[r]);
    float ps = 0; for (int r = 0; r < 16; ++r) ps += p0[r]; for (int r = 0; r < 16; ++r) ps += p1[r];
    { auto rr = __builtin_amdgcn_permlane32_swap(__float_as_uint(ps), __float_as_uint(ps), false, false);
      ps = __uint_as_float(rr[0]) + __uint_as_float(rr[1]); }
    l_reg = l_reg * alpha + ps;
#define PK4(P, B_, OUT) do { unsigned a0 = cvtpk(P[B_+0], P[B_+1]), a1 = cvtpk(P[B_+2], P[B_+3]);                          \
        unsigned b0 = cvtpk(P[B_+4], P[B_+5]), b1 = cvtpk(P[B_+6], P[B_+7]);                                             \
        auto r0 = __builtin_amdgcn_permlane32_swap(a0, b0, false, false); auto r1 = __builtin_amdgcn_permlane32_swap(a1, b1, false, false); \
        u32x4 w = {r0[0], r1[0], r0[1], r1[1]}; OUT = *reinterpret_cast<bf16x8*>(&w); } while (0)
    PK4(p0, 0, pa0); PK4(p0, 8, pa1); PK4(p1, 0, pa2); PK4(p1, 8, pa3);
#undef PK4
}
template <int KB, bool SK>
__device__ __forceinline__ void qkt(f32x16& p0, f32x16& p1, const char* K_lds, int r32, int hi, const bf16x8* qr, bool act) {
    if (SK && !act) { const float NEG = -__builtin_inff();
#pragma unroll
        for (int r = 0; r < 16; ++r) { p0[r] = NEG; p1[r] = NEG; } return; }
    p0 = f32x16{}; p1 = f32x16{};
    const char* kb[4];
#pragma unroll
    for (int dd = 0; dd < 4; ++dd) kb[dd] = K_lds + KB * SHM_K + KSWZ(r32, (dd * 16 + hi * 8) * 2);
#pragma unroll
    for (int d0 = 0; d0 < 8; ++d0) { const char* a = kb[d0 & 3] + (d0 >> 2) * 128;
        bf16x8 b0 = *reinterpret_cast<const bf16x8*>(a);
        bf16x8 b1 = *reinterpret_cast<const bf16x8*>(a + 32 * 256);
        p0 = __builtin_amdgcn_mfma_f32_32x32x16_bf16(b0, qr[d0], p0, 0, 0, 0);
        p1 = __builtin_amdgcn_mfma_f32_32x32x16_bf16(b1, qr[d0], p1, 0, 0, 0); }
}
template <int VB, bool SK>
__device__ __forceinline__ void pv_tile(f32x16* o, int vb0, bf16x8 pa0, bf16x8 pa1, bf16x8 pa2, bf16x8 pa3, bool act) {
    if (SK && !act) return;
#define TRRD(dst, off) asm volatile("ds_read_b64_tr_b16 %0, %1 offset:%2" : "=&v"(dst) : "v"(vb0), "i"(off) : "memory")
#define PV_D0(d0) do { s16x4 l0, l1, l2, l3, h0, h1, h2, h3; constexpr int b_ = VB * SHM_V + v_rd_off(d0, 0, 0);     \
        TRRD(l0, b_); TRRD(h0, b_ + 2048); TRRD(l1, b_ + 4096); TRRD(h1, b_ + 6144); TRRD(l2, b_ + 8192); TRRD(h2, b_ + 10240); TRRD(l3, b_ + 12288); TRRD(h3, b_ + 14336); \
        asm volatile("s_waitcnt lgkmcnt(0)" ::: "memory"); SBAR();                 \
        o[d0] = __builtin_amdgcn_mfma_f32_32x32x16_bf16(pa0, (bf16x8){l0[0], l0[1], l0[2], l0[3], h0[0], h0[1], h0[2], h0[3]}, o[d0], 0, 0, 0);   \
        o[d0] = __builtin_amdgcn_mfma_f32_32x32x16_bf16(pa1, (bf16x8){l1[0], l1[1], l1[2], l1[3], h1[0], h1[1], h1[2], h1[3]}, o[d0], 0, 0, 0);   \
        o[d0] = __builtin_amdgcn_mfma_f32_32x32x16_bf16(pa2, (bf16x8){l2[0], l2[1], l2[2], l2[3], h2[0], h2[1], h2[2], h2[3]}, o[d0], 0, 0, 0);   \
        o[d0] = __builtin_amdgcn_mfma_f32_32x32x16_bf16(pa3, (bf16x8){l3[0], l3[1], l3[2], l3[3], h3[0], h3[1], h3[2], h3[3]}, o[d0], 0, 0, 0); } while (0)
    PV_D0(0); PV_D0(1); PV_D0(2); PV_D0(3);
#undef PV_D0
#undef TRRD
}

template <class TIn, class TOut> struct BlockRef { const TIn* Q; const TIn* K; const TIn* V; TOut* O; int P0; };
template <class TIn> struct Seam {
    bf16x8 qr[8];
    bf16x8 st_v0, st_v1, st_k0, st_k1; f32x4 sf0, sf1, sf2, sf3;
    f32x4 tq[16];
};
__device__ __forceinline__ int swa_jlo(int P0, int W) { const int lowk = P0 - W + 1; return lowk > 0 ? lowk / KVBLK : 0; }
#define ROW(p, k0, rr) ((p) + (size_t)((k0) + (rr)) * KVP + sc)
#define VMW() asm volatile("s_waitcnt vmcnt(0)" ::: "memory")
#define VMWN(n) asm volatile("s_waitcnt vmcnt(%0)" :: "i"(n) : "memory")
#define SLOAD_H(Kp, Vp, k0) do { S.st_v0 = load8<TIn>(ROW(Vp, k0, sr)); S.st_v1 = load8<TIn>(ROW(Vp, k0, 32 + sr));              \
                         S.st_k0 = load8<TIn>(ROW(Kp, k0, sr)); S.st_k1 = load8<TIn>(ROW(Kp, k0, 32 + sr)); } while (0)
#define SWRITE_HK(bf) do { *(bf16x8*)(K_lds + (bf) * SHM_K + kws) = S.st_k0; *(bf16x8*)(K_lds + (bf) * SHM_K + kws + 32 * 256) = S.st_k1; } while (0)
#define SWRITE_HV(bf) do { *(bf16x8*)(V_lds + (bf) * SHM_V + vst0) = S.st_v0; *(bf16x8*)(V_lds + (bf) * SHM_V + vst1) = S.st_v1; } while (0)
#define SWRITE_H(bf) do { SWRITE_HV(bf); SWRITE_HK(bf); } while (0)
#define SLOAD_F(p, k0) do { S.sf0 = *(const f32x4*)ROW(p, k0, sr); S.sf1 = *(const f32x4*)(ROW(p, k0, sr) + 4);                \
                            S.sf2 = *(const f32x4*)ROW(p, k0, 32 + sr); S.sf3 = *(const f32x4*)(ROW(p, k0, 32 + sr) + 4); } while (0)
#define SWRITE_KF(bf) do { *(bf16x8*)(K_lds + (bf) * SHM_K + kws) = pack8(S.sf0, S.sf1); *(bf16x8*)(K_lds + (bf) * SHM_K + kws + 32 * 256) = pack8(S.sf2, S.sf3); } while (0)
#define SWRITE_VF(bf) do { *(bf16x8*)(V_lds + (bf) * SHM_V + vst0) = pack8(S.sf0, S.sf1); *(bf16x8*)(V_lds + (bf) * SHM_V + vst1) = pack8(S.sf2, S.sf3); } while (0)
template <class TIn, class TOut>
__device__ __forceinline__ void causal_swa_prime(const BlockRef<TIn, TOut>& cur, int W, char* lds, Seam<TIn>& S, int tid_in) {
    constexpr bool F32 = same_t<TIn, float>::v;
    int tid_ = tid_in; asm volatile("" : "+v"(tid_));
    const int tid = tid_, wid = __builtin_amdgcn_readfirstlane(tid >> 6), lane = tid & 63, r32 = lane & 31, hi = lane >> 5;
    const int sr = tid >> 4, sc = (tid & 15) * 8, kws = KSWZ(sr, sc * 2); char* K_lds = lds + 2 * SHM_V;
    const int kb0 = swa_jlo(cur.P0, W) * KVBLK;
    for (int d0 = 0; d0 < 8; ++d0) S.qr[d0] = load8<TIn>(cur.Q + (size_t)(wid * QBLK + r32) * QP + d0 * 16 + hi * 8);
    if constexpr (F32) { SLOAD_F((const float*)cur.K, kb0); VMW(); SWRITE_KF(0); SBAR(); SLOAD_F((const float*)cur.V, kb0); }
    else { SLOAD_H(cur.K, cur.V, kb0); VMW(); SWRITE_HK(0); }
    __syncthreads();
}
template <class TIn, class TOut>
__device__ __forceinline__ void causal_swa_block(const BlockRef<TIn, TOut>& cur, const BlockRef<TIn, TOut>& nxt, int skv, int W, char* lds, Seam<TIn>& S, int tid_in) {
    constexpr bool F32 = same_t<TIn, float>::v;
    int tid_ = tid_in; asm volatile("" : "+v"(tid_));
    const int tid = tid_, wid = __builtin_amdgcn_readfirstlane(tid >> 6), lane = tid & 63, r32 = lane & 31, hi = lane >> 5;
    const int j_lo = swa_jlo(cur.P0, W);
    int j_hi = (cur.P0 + QB - 1) / KVBLK + 1; if (j_hi > skv / KVBLK) j_hi = skv / KVBLK;
    const int NT = j_hi - j_lo;
    const int kbn = swa_jlo(nxt.P0, W) * KVBLK;
    const int qlo = cur.P0 + wid * QBLK, qm = qlo + r32 - 4 * hi;
    char* V_lds = lds; char* K_lds = lds + 2 * SHM_V;
    float* ws = (float*)(lds + 2 * SHM_V + 2 * SHM_K) + wid * 64; float* li_l = ws, * al_l = ws + 32;
    float m_reg = -1e30f, l_reg = 0; f32x16 o[4] = {};
    const int sr = tid >> 4, sc = (tid & 15) * 8, vst0 = v_st(sr, sc), vst1 = v_st(32 + sr, sc), kws = KSWZ(sr, sc * 2);
    const int vb0 = (int)(uintptr_t)V_lds + v_rd_base(lane);
    const TIn* Kh = cur.K; const TIn* Vh = cur.V;
#define RESC(a) do { if (__any((a) < 1.f)) { if (hi == 0) al_l[r32] = (a); asm volatile("s_waitcnt lgkmcnt(0)" ::: "memory");              \
                     for (int d_ = 0; d_ < 4; ++d_) for (int r = 0; r < 16; ++r) o[d_][r] *= al_l[crow(r, hi)]; } } while (0)
#define KBASE(t) ((j_lo + (t)) * KVBLK)
#define ACT(t) (KBASE(t) <= qlo + QBLK - 1 && KBASE(t) + KVBLK - 1 >= qlo - W + 1)
#define MASKT(P0_, P1_, t) do { const int kb_ = KBASE(t); if ((!SK || ACT(t)) && (kb_ + KVBLK - 1 > qlo || kb_ <= qlo + QBLK - 1 - W)) mask_tile(P0_, P1_, qm - kb_, (unsigned)W); } while (0)
    constexpr int NQL = F32 ? 16 : 8;
    constexpr bool SK = WSKIP && !F32;
#define SEAM_K0() do { VMWN(NQL); if constexpr (F32) { SWRITE_KF(0); SBAR(); SLOAD_F((const float*)nxt.V, kbn); } else { SWRITE_HK(0); } SBAR(); } while (0)
    f32x16 pA0, pA1, pB0, pB1; float mnA, mnB, alA, alB; bf16x8 pa0, pa1, pa2, pa3;
    if constexpr (F32) { VMW(); SWRITE_VF(0); SBAR(); } else { SWRITE_HV(0); SBAR(); }
    if (NT > 1) { if constexpr (F32) SLOAD_F((const float*)Kh, KBASE(1)); else SLOAD_H(Kh, Vh, KBASE(1)); }
    SBAR(); qkt<0, SK>(pA0, pA1, K_lds, r32, hi, S.qr, ACT(0));
    if constexpr (F32) { if (NT > 1) { VMW(); SWRITE_KF(1); SBAR(); SLOAD_F((const float*)Vh, KBASE(1)); } }
    MASKT(pA0, pA1, 0); partialSM(pA0, pA1, m_reg, mnA, alA);
    if (NT > 1) { VMW(); if constexpr (F32) { SWRITE_VF(1); SBAR(); if (NT > 2) SLOAD_F((const float*)Kh, KBASE(2)); } else SWRITE_H(1); }
    __syncthreads();
#define HALF_STEP(PX0, PX1, mnX, alX, PY0, PY1, alY, t, KB, VB, SB) do {                                                      \
        SBAR(); qkt<KB, SK>(PX0, PX1, K_lds, r32, hi, S.qr, ACT(t));                                             \
        finishSM(PY0, PY1, alY, l_reg, pa0, pa1, pa2, pa3); SBAR();                                                           \
        if ((t) + 1 < NT) { if constexpr (F32) { VMW(); SWRITE_KF(SB); SBAR(); SLOAD_F((const float*)Vh, KBASE((t) + 1)); }  \
                            else { SLOAD_H(Kh, Vh, KBASE((t) + 1)); } SBAR(); }                                               \
        pv_tile<VB, SK>(o, vb0, pa0, pa1, pa2, pa3, ACT((t) - 1)); MASKT(PX0, PX1, (t)); partialSM(PX0, PX1, m_reg, mnX, alX);                                        \
        __syncthreads();                                                                                                      \
        if ((t) + 1 < NT) { VMW(); if constexpr (F32) { SWRITE_VF(SB); SBAR(); if ((t) + 2 < NT) SLOAD_F((const float*)Kh, KBASE((t) + 2)); } \
                            else { SWRITE_H(SB); } }                                                                          \
        RESC(alX); __syncthreads(); } while (0)
    for (int t = 1; t + 1 < NT; t += 2) {
        HALF_STEP(pB0, pB1, mnB, alB, pA0, pA1, alA, t, 1, 0, 0);
        HALF_STEP(pA0, pA1, mnA, alA, pB0, pB1, alB, t + 1, 0, 1, 1);
    }
    const bool even = (NT & 1) == 0;
    if (even) { SBAR(); qkt<1, SK>(pB0, pB1, K_lds, r32, hi, S.qr, ACT(NT - 1)); SBAR(); }
#define QROW(e) (nxt.Q + (size_t)(wid * QBLK + r32) * QP + ((e) >> 1) * 16 + hi * 8 + ((e) & 1) * 4)
    if constexpr (F32) { SLOAD_F((const float*)nxt.K, kbn); SBAR();
#pragma unroll
        for (int e = 0; e < 8; ++e) S.tq[e] = *(const f32x4*)QROW(e); }
    else { SLOAD_H(nxt.K, nxt.V, kbn); SBAR();
#pragma unroll
        for (int d0 = 0; d0 < 8; ++d0) S.qr[d0] = load8<TIn>(nxt.Q + (size_t)(wid * QBLK + r32) * QP + d0 * 16 + hi * 8); }
    SBAR();
    finishSM(pA0, pA1, alA, l_reg, pa0, pa1, pa2, pa3); SBAR();
    if constexpr (F32) {
#pragma unroll
        for (int e = 8; e < 16; ++e) S.tq[e] = *(const f32x4*)QROW(e); SBAR(); }
#undef QROW
    pv_tile<0, SK>(o, vb0, pa0, pa1, pa2, pa3, ACT(even ? NT - 2 : NT - 1));
    if (even) { MASKT(pB0, pB1, NT - 1); partialSM(pB0, pB1, m_reg, mnB, alB); __syncthreads(); RESC(alB);
        finishSM(pB0, pB1, alB, l_reg, pa0, pa1, pa2, pa3); SBAR(); pv_tile<1, SK>(o, vb0, pa0, pa1, pa2, pa3, ACT(NT - 1)); }
    SBAR(); SEAM_K0();
    if (hi == 0) li_l[r32] = l_reg; asm volatile("s_waitcnt lgkmcnt(0)" ::: "memory");
    float rli[16];
#pragma unroll
    for (int r = 0; r < 16; ++r) rli[r] = __builtin_amdgcn_rcpf(li_l[crow(r, hi)]);
    TOut* Ow = cur.O + (size_t)(wid * QBLK) * OP;
#pragma unroll
    for (int r = 0; r < 16; ++r) { const int orow = crow(r, hi);
#pragma unroll
        for (int d0 = 0; d0 < 4; ++d0) { const float v = o[d0][r] * rli[r];
            if constexpr (same_t<TOut, float>::v) { Ow[(size_t)orow * OP + d0 * 32 + r32] = v; }
            else { const float vn = __shfl_xor(v, 1);
                   if ((r32 & 1) == 0) *(unsigned*)(Ow + (size_t)orow * OP + d0 * 32 + r32) = cvtpk(v, vn); } } }
    if constexpr (F32) {
#pragma unroll
        for (int d0 = 0; d0 < 8; ++d0) S.qr[d0] = pack8(S.tq[2 * d0], S.tq[2 * d0 + 1]); }
    __syncthreads();
#undef RESC
#undef KBASE
#undef ACT
#undef MASKT
#undef SEAM_K0
#undef HALF_STEP
}
#undef ROW
#undef VMW
#undef VMWN
#undef SLOAD_H
#undef SWRITE_HK
#undef SWRITE_HV
#undef SWRITE_H
#undef SLOAD_F
#undef SWRITE_KF
#undef SWRITE_VF


}
namespace dattn {
template <bool MASK> __device__ __forceinline__ void sb_half(f32x16& p, float& Px, float R, int dq, int hi) {
    float om[16];
#pragma unroll
    for (int r = 0; r < 16; ++r) {
        const int c = (r & 3) + 8 * (r >> 2);
        const float e = __builtin_amdgcn_exp2f(-fmaxf(p[r], -126.0f)); float b = __builtin_amdgcn_rcpf(1.0f + e), o = e * b;
        if (MASK) { const bool in = c < dq; b = in ? b : 0.f; o = in ? o : 1.0f; } om[r] = o; p[r] = b;
    }
    float E[4];
#pragma unroll
    for (int g = 3; g >= 0; --g) {
        const float s0 = (om[4 * g] * om[4 * g + 1]) * (om[4 * g + 2] * om[4 * g + 3]);
        auto rr = __builtin_amdgcn_permlane32_swap(__float_as_uint(s0), __float_as_uint(s0), false, false);
        const float ga = __uint_as_float(rr[0]), gb = __uint_as_float(rr[1]);
        E[g] = (hi ? Px : Px * gb) * R; Px *= ga * gb;
    }
#pragma unroll
    for (int g = 0; g < 4; ++g) {
        const float c3 = E[g], c2 = c3 * om[4 * g + 3], c1 = c2 * om[4 * g + 2], c0 = c1 * om[4 * g + 1];
        p[4 * g + 3] *= c3; p[4 * g + 2] *= c2; p[4 * g + 1] *= c1; p[4 * g] *= c0;
    }
}
template <int OPB> __device__ __forceinline__ void sb_unit(const bf16* Qh, const bf16* Kh, const bf16* Vh, bf16* Oh, int P0, float EXIT, char* lds, int tid_in) {
    int tid_ = tid_in; asm volatile("" : "+v"(tid_));
    const int tid = tid_, wid = __builtin_amdgcn_readfirstlane(tid >> 6), lane = tid & 63, r32 = lane & 31, hi = lane >> 5;
    char* V_lds = lds; char* K_lds = lds + 2 * SHM_V; unsigned* flags = (unsigned*)(lds + 2 * SHM_V + 2 * SHM_K);
    const int sr = tid >> 4, sc = (tid & 15) * 8, vst0 = v_st(sr, sc), vst1 = v_st(32 + sr, sc), kws = KSWZ(sr, sc * 2);
    const int vb0 = (int)(uintptr_t)V_lds + v_rd_base(lane);
    const int qlo = P0 + wid * QBLK, qpos = qlo + r32;
    bf16x8 qr[8];
#pragma unroll
    for (int d0 = 0; d0 < 8; ++d0) qr[d0] = load8<bf16>(Qh + (size_t)qpos * KVP + d0 * 16 + hi * 8);
    const int NT = (P0 + QB) / KVBLK;
    bf16x8 st_k0, st_k1, st_v0, st_v1;
#define SB_LOAD(t) do { const size_t r0_ = (size_t)((t) * KVBLK + sr) * KVP + sc, r1_ = r0_ + (size_t)32 * KVP; \
        st_v0 = load8<bf16>(Vh + r0_); st_v1 = load8<bf16>(Vh + r1_); st_k0 = load8<bf16>(Kh + r0_); st_k1 = load8<bf16>(Kh + r1_); } while (0)
    SB_LOAD(NT - 1);
    float R = 1.0f; f32x16 o[4] = {}; bool done = false;
    for (int t = NT - 1; t >= 0; --t) {
        asm volatile("s_waitcnt vmcnt(0)" ::: "memory");
        *(bf16x8*)(V_lds + vst0) = st_v0; *(bf16x8*)(V_lds + vst1) = st_v1; *(bf16x8*)(K_lds + kws) = st_k0; *(bf16x8*)(K_lds + kws + 32 * 256) = st_k1;
        __syncthreads();
        if (t > 0) SB_LOAD(t - 1);
        const int kb = t * KVBLK;
        if (!done && kb <= qlo + QBLK - 2) {
            f32x16 p0, p1; bf16x8 pa0, pa1, pa2, pa3;
            SBAR(); qkt<0, false>(p0, p1, K_lds, r32, hi, qr, true); SBAR();
            float Px = 1.0f;
            sb_half<true>(p1, Px, R, qpos - kb - 4 * hi - 32, hi); SBAR(); sb_half<true>(p0, Px, R, qpos - kb - 4 * hi, hi);
            R *= Px;
#define PK4(P, B_, OUT) do { unsigned a0 = cvtpk(P[B_+0], P[B_+1]), a1 = cvtpk(P[B_+2], P[B_+3]);                          \
        unsigned b0 = cvtpk(P[B_+4], P[B_+5]), b1 = cvtpk(P[B_+6], P[B_+7]);                                             \
        auto r0 = __builtin_amdgcn_permlane32_swap(a0, b0, false, false); auto r1 = __builtin_amdgcn_permlane32_swap(a1, b1, false, false); \
        u32x4 w = {r0[0], r1[0], r0[1], r1[1]}; OUT = *reinterpret_cast<bf16x8*>(&w); } while (0)
            PK4(p0, 0, pa0); PK4(p0, 8, pa1); PK4(p1, 0, pa2); PK4(p1, 8, pa3);
#undef PK4
            SBAR(); pv_tile<0, false>(o, vb0, pa0, pa1, pa2, pa3, true);
            done = __all(R < EXIT);
        }
        if (lane == 0) flags[wid] = done ? 1u : 0u;
        __syncthreads();
        const u32x4 f0 = *(const u32x4*)flags, f1 = *(const u32x4*)(flags + 4);
        if ((f0.x & f0.y & f0.z & f0.w & f1.x & f1.y & f1.z & f1.w) != 0u) break;
    }
#undef SB_LOAD
    bf16* Ow = Oh + (size_t)qlo * OPB;
#pragma unroll
    for (int r = 0; r < 16; ++r) { const int orow = crow(r, hi);
#pragma unroll
        for (int d0 = 0; d0 < 4; ++d0) { const float v = o[d0][r]; const float vn = __int_as_float(__builtin_amdgcn_ds_swizzle(__float_as_int(v), 0x041F));
            if ((r32 & 1) == 0) *(unsigned*)(Ow + (size_t)orow * OPB + d0 * 32 + r32) = cvtpk(v, vn); } }
    __syncthreads();
}
}
constexpr int NWAVES = 8;
constexpr int BATCH = 2, SEQ = 4096, DM = 2048, FF = 5632, DIN = 6144, DEPTH = 4, HD = 128;
constexpr int M = BATCH * SEQ;
constexpr float RMS_EPS = 1e-6f;
constexpr float QK_C2 = 0.08838834764831845f * 1.4426950408889634f;
constexpr float SB_EXIT = 7.52316385e-37f;
constexpr size_t MiB = 1u << 20;
constexpr size_t WS_CTL = 0, CTL_ZERO_BYTES = 1 * MiB;
constexpr size_t WS_ROPE = 1 * MiB;
constexpr size_t WS_SSQ = 3 * MiB;
constexpr size_t WS_X = 4 * MiB;
constexpr size_t WS_XB = 68 * MiB;
constexpr size_t WS_H = 100 * MiB;
constexpr size_t WS_QKV = 188 * MiB;
constexpr size_t WS_MIX = 284 * MiB;
constexpr size_t WS_OD = 316 * MiB;
constexpr size_t WS_W = 380 * MiB;
constexpr size_t W_GU = (size_t)2 * FF * DM * 2, W_D = (size_t)DM * FF * 2, W_IN = (size_t)DIN * DM * 2, W_OUT = (size_t)DM * DM * 2;
constexpr size_t WO_GU1 = 0, WO_D1 = W_GU, WO_IN = WO_D1 + W_D, WO_OUT = WO_IN + W_IN, WO_GU2 = WO_OUT + W_OUT, WO_D2 = WO_GU2 + W_GU, W_LAYER = WO_D2 + W_D;
constexpr size_t WS_END = WS_W + DEPTH * W_LAYER;
static_assert(W_LAYER == 164 * MiB, "weights per layer");
constexpr int CW_TMO = 0, CW_CODE = 1, CW_BAR = 4096;
constexpr int CW_DCNT = 65536;
static_assert((CW_DCNT + 64 * (DEPTH * 8 * 16)) * 4 <= (int)CTL_ZERO_BYTES, "counters inside the per-call memset");
constexpr int RING_OFF = 0, RING_BYTES = 135168;
constexpr int LDSCTL_OFF = RING_BYTES, MISC_OFF = LDSCTL_OFF + 320;
constexpr int LDS_BYTES = 147456;
static_assert(MISC_OFF + 128 <= LDS_BYTES && 8 * 16640 <= RING_BYTES, "LDS map");

#define GAS __attribute__((address_space(1)))
#define LAS __attribute__((address_space(3)))
typedef unsigned short bf16;
typedef unsigned v4u __attribute__((ext_vector_type(4)));
typedef float f32x4 __attribute__((ext_vector_type(4)));
typedef short bf16x8 __attribute__((ext_vector_type(8)));
typedef GAS unsigned gu32;
typedef GAS unsigned long long gu64;
#define RLX_AGENT __ATOMIC_RELAXED, __HIP_MEMORY_SCOPE_AGENT
#define LDS_WAIT() asm volatile("s_waitcnt lgkmcnt(0)" ::: "memory")
#define VM_WAIT() asm volatile("s_waitcnt vmcnt(0)" ::: "memory")
__device__ __forceinline__ unsigned long long rt() { return __builtin_amdgcn_s_memrealtime(); }
#define XB_TMO      128
#define XB_XCNT(j)  (256  + 64 * (j))
#define XB_XSUB(j)  (1280 + 64 * (j))
#define XB_XGEN(j)  (2304 + 64 * (j))
#define XB_TOP      3328
#define XB_TOPGEN   3392
#define XCD_BAR_WORDS 3456
#define XB_SPIN_CAP (1u << 18)

__device__ __forceinline__ unsigned xb_ld(unsigned* p)              { return __hip_atomic_load(p, __ATOMIC_RELAXED, __HIP_MEMORY_SCOPE_AGENT); }
__device__ __forceinline__ unsigned xb_add(unsigned* p, unsigned v) { return __hip_atomic_fetch_add(p, v, __ATOMIC_RELAXED, __HIP_MEMORY_SCOPE_AGENT); }
__device__ __forceinline__ unsigned xb_xcc_id() { return (unsigned)__builtin_amdgcn_s_getreg((3 << 11) | 20) & 0xFu; }
#define XB_SPIN(cond, bar) do { unsigned _sp = 0; while (cond) { __builtin_amdgcn_s_sleep(1); \
    if ((++_sp & 255u) == 0u) { if (xb_ld(&(bar)[XB_TMO])) break; if (_sp > XB_SPIN_CAP) { atomicAdd(&(bar)[XB_TMO], 1u); break; } } } } while (0)

struct XcdBarrier {
    unsigned* bar; unsigned x;
    volatile LAS unsigned* st;
};

__device__ __forceinline__ XcdBarrier xcd_barrier_post(unsigned* bar, volatile LAS unsigned* st) {
    XcdBarrier b; b.bar = bar; b.x = xb_xcc_id(); b.st = st;
    if (threadIdx.x == 0) (void)xb_add(&bar[XB_XCNT(b.x)], 1u);
    return b;
}
__device__ __forceinline__ void xcd_barrier_complete(unsigned* bar, unsigned x, unsigned& nloc, unsigned& nx) {
    const unsigned G = gridDim.x * gridDim.y * gridDim.z;
    unsigned sum, cnt, mine, sp = 0u;
    for (;;) {
        sum = 0u; cnt = 0u; mine = 0u;
#pragma unroll
        for (unsigned j = 0; j < 16; ++j) { const unsigned c = xb_ld(&bar[XB_XCNT(j)]); sum += c; cnt += (c > 0u) ? 1u : 0u; mine = (j == x) ? c : mine; }
        if (sum == G) break;
        __builtin_amdgcn_s_sleep(1);
        if ((++sp & 255u) == 0u) { if (xb_ld(&bar[XB_TMO])) break; if (sp > XB_SPIN_CAP) { atomicAdd(&bar[XB_TMO], 1u); break; } }
    }
    nloc = mine > 0u ? mine : 1u; nx = cnt > 0u ? cnt : 1u;
}

__device__ __forceinline__ void xcd_barrier(const XcdBarrier& b) {
    asm volatile("s_waitcnt vmcnt(0)" ::: "memory");
    __syncthreads();
    if (threadIdx.x == 0) {
        unsigned* bar = b.bar;
        __builtin_amdgcn_s_waitcnt(0);
        unsigned nloc = b.st[0], nx = b.st[1];
        if (nloc == 0u) { xcd_barrier_complete(bar, b.x, nloc, nx); b.st[0] = nloc; b.st[1] = nx; }
        const unsigned old = xb_add(&bar[XB_XSUB(b.x)], 1u);
        const unsigned gen = old / nloc;
        if (old + 1u == (gen + 1u) * nloc) {
            __builtin_amdgcn_fence(__ATOMIC_RELEASE, "agent");
            asm volatile("s_waitcnt vmcnt(0)" ::: "memory");
            const unsigned og = xb_add(&bar[XB_TOP], 1u);
            const unsigned tg = og / nx;
            if (og + 1u == (tg + 1u) * nx) xb_add(&bar[XB_TOPGEN], 1u);
            else XB_SPIN(xb_ld(&bar[XB_TOPGEN]) == tg, bar);
            __builtin_amdgcn_fence(__ATOMIC_ACQUIRE, "agent");
            xb_add(&bar[XB_XGEN(b.x)], 1u);
            asm volatile("s_waitcnt vmcnt(0)" ::: "memory");
        } else {
            XB_SPIN(xb_ld(&bar[XB_XGEN(b.x)]) == gen, bar);
            __builtin_amdgcn_fence(__ATOMIC_ACQUIRE, "agent");
            asm volatile("s_waitcnt vmcnt(0)" ::: "memory");
        }
    }
    __syncthreads();
}

__device__ __forceinline__ float wave_sum(float v) { return pg8::wave_sum_nolane(v); }
__device__ __forceinline__ unsigned pk2(float lo, float hi) { return pg8::cvt_pk_bf16(lo, hi); }
__device__ __forceinline__ int w_rowmap(int mode, int n) {
    if (mode == 0) return n;
    if (mode == 3) { const int l = n & 255, g = l >> 7, bj = (l >> 6) & 1, i = l & 63; return (n & ~255) + 128 * bj + 64 * g + i; }
    return ((n >> 7) << 8) + (n & 127) + (mode == 2 ? 128 : 0);
}
__device__ __forceinline__ void p0_item(const float* W, int K, int N, const float* gain, bf16* dst, int mode, LAS float* scr, int item, int lane) {
    const int nblk = N / 64, kb = item / nblk, nb = item % nblk, k0 = 64 * kb, n0 = 64 * nb;
    const int kk = lane >> 4, nn = 4 * (lane & 15);
    f32x4 v[16]; float g[16];
#pragma unroll
    for (int i = 0; i < 16; ++i) { const int k = 4 * i + kk; v[i] = __builtin_nontemporal_load((const GAS f32x4*)(W + (size_t)(k0 + k) * N + n0 + nn));     g[i] = gain ? gain[k0 + k] : 1.0f; }
#pragma unroll
    for (int i = 0; i < 16; ++i) { const int k = 4 * i + kk; LAS float* s = scr + k * 65 + nn; s[0] = v[i][0] * g[i]; s[1] = v[i][1] * g[i]; s[2] = v[i][2] * g[i]; s[3] = v[i][3] * g[i]; }
    LDS_WAIT(); asm volatile("" ::: "memory");
    const int c = lane & 7;
#pragma unroll
    for (int j = 0; j < 8; ++j) { const int n = (lane >> 3) + 8 * j; const LAS float* s = scr + (8 * c) * 65 + n;
        v4u o; o.x = pk2(s[0 * 65], s[1 * 65]); o.y = pk2(s[2 * 65], s[3 * 65]); o.z = pk2(s[4 * 65], s[5 * 65]); o.w = pk2(s[6 * 65], s[7 * 65]);
        __builtin_nontemporal_store(o, (GAS v4u*)(dst + (size_t)w_rowmap(mode, n0 + n) * K + k0 + 8 * c)); }
    LDS_WAIT(); asm volatile("" ::: "memory");
}
__device__ __forceinline__ void rope_entry(int pos, int i, float& c, float& s) {
    const double R1 = 0.86596432336006535, R2 = R1 * R1, R4 = R2 * R2, R8 = R4 * R4, R16 = R8 * R8, R32 = R16 * R16;
    double f = 1.0; if (i & 1) f *= R1; if (i & 2) f *= R2; if (i & 4) f *= R4; if (i & 8) f *= R8; if (i & 16) f *= R16; if (i & 32) f *= R32;
    const float ff = (float)f;
    const float angf = (float)pos * ff;
    const double ang = (double)angf;
    const double TWO_PI_HI = 6.283185307179586, TWO_PI_LO = 2.4492935982947064e-16, INV_2PI = 0.15915494309189535;
    const double n = __builtin_rint(ang * INV_2PI);
    double r = __builtin_fma(-n, TWO_PI_HI, ang); r = __builtin_fma(-n, TWO_PI_LO, r);
    const double r2 = r * r;
    double sc = 1.0, ss = 1.0;
#pragma unroll
    for (int k = 15; k >= 1; --k) { sc = 1.0 - sc * r2 / (double)((2 * k - 1) * (2 * k)); ss = 1.0 - ss * r2 / (double)((2 * k) * (2 * k + 1)); }
    c = (float)sc; s = (float)(ss * r);
}

struct Args { const float* in[18]; float* out; unsigned char* ws; float linit[4]; int ph_lo, ph_hi; };
enum { I_X = 0, I_NF1, I_G1, I_U1, I_D1, I_NMIX, I_WIN, I_LQ1, I_LK1, I_LQ2, I_LK2, I_SUBLN, I_WOUT, I_NF2, I_G2, I_U2, I_D2, I_NFIN };

struct Ctx { int tid, lane, wave, bx, G, gw, NGW; unsigned char* ws; gu32* ctl; float* ROPE; float* SSQ; unsigned char* XL; bf16* XB; bf16* H; bf16* QKV; bf16* MIX; float* OD; };
__device__ __forceinline__ Ctx make_ctx(unsigned char* ws_in, int wave_s) {
    Ctx c; unsigned z0; asm volatile("v_mov_b32 %0, 0" : "=v"(z0)); int t = wave_s * 64 + (int)__builtin_amdgcn_mbcnt_hi(~0u, __builtin_amdgcn_mbcnt_lo(~0u, z0));     int b = blockIdx.x; asm volatile("" : "+s"(b)); unsigned char* ws = ws_in; asm volatile("" : "+s"(ws));
    c.tid = t; c.lane = t & 63; c.wave = __builtin_amdgcn_readfirstlane(t >> 6); c.bx = b; c.G = gridDim.x;
    const int vcu = (c.G % 8 == 0) ? (b % 8) * (c.G / 8) + b / 8 : b; c.gw = vcu * NWAVES + c.wave; c.NGW = c.G * NWAVES;
    c.ws = ws; c.ctl = (gu32*)(ws + WS_CTL); c.ROPE = (float*)(ws + WS_ROPE); c.SSQ = (float*)(ws + WS_SSQ); c.XL = ws + WS_X; c.XB = (bf16*)(ws + WS_XB); c.H = (bf16*)(ws + WS_H);
    c.QKV = (bf16*)(ws + WS_QKV); c.MIX = (bf16*)(ws + WS_MIX); c.OD = (float*)(ws + WS_OD);
    return c;
}
__device__ __forceinline__ int opaque_s(int x) { asm volatile("" : "+s"(x)); return x; }
#define INP(i) (args.in[opaque_s(i)])
constexpr int CV_GU = (DM / 64) * (FF / 64), CV_DN = (FF / 64) * (DM / 64), CV_IN = (DM / 64) * (DIN / 64), CV_OUT = (DM / 64) * (DM / 64);
constexpr int CV_LAYER = 4 * CV_GU + 2 * CV_DN + CV_IN + CV_OUT;
constexpr int CV_PRO = 2 * CV_GU + CV_DN;
constexpr int CV_T0 = CV_PRO + CV_IN + CV_OUT + 2 * CV_GU;
#define CONVERT_RANGE(id_lo, id_hi, widx, nw, wsb, scr, lane) do { \
    for (int it_ = (id_lo) + (widx); it_ < (id_hi); it_ += (nw)) { \
        const int layer_ = it_ / CV_LAYER; int r_ = it_ % CV_LAYER; \
        unsigned char* wl_ = (wsb) + WS_W + (size_t)layer_ * W_LAYER; \
        const float* src_; const float* gain_ = nullptr; int K_ = DM, N_ = FF, mode_; size_t wo_; \
        if (r_ < CV_GU) { src_ = INP(I_G1) + (size_t)layer_ * DM * FF; gain_ = INP(I_NF1) + layer_ * DM; mode_ = 1; wo_ = WO_GU1; } \
        else if ((r_ -= CV_GU) < CV_GU) { src_ = INP(I_U1) + (size_t)layer_ * DM * FF; gain_ = INP(I_NF1) + layer_ * DM; mode_ = 2; wo_ = WO_GU1; } \
        else if ((r_ -= CV_GU) < CV_DN) { src_ = INP(I_D1) + (size_t)layer_ * DM * FF; mode_ = 0; wo_ = WO_D1; K_ = FF; N_ = DM; } \
        else if ((r_ -= CV_DN) < CV_IN) { src_ = INP(I_WIN) + (size_t)layer_ * DM * DIN; gain_ = INP(I_NMIX) + layer_ * DM; mode_ = 3; wo_ = WO_IN; N_ = DIN; } \
        else if ((r_ -= CV_IN) < CV_OUT) { src_ = INP(I_WOUT) + (size_t)layer_ * DM * DM; mode_ = 0; wo_ = WO_OUT; N_ = DM; } \
        else if ((r_ -= CV_OUT) < CV_GU) { src_ = INP(I_G2) + (size_t)layer_ * DM * FF; gain_ = INP(I_NF2) + layer_ * DM; mode_ = 1; wo_ = WO_GU2; } \
        else if ((r_ -= CV_GU) < CV_GU) { src_ = INP(I_U2) + (size_t)layer_ * DM * FF; gain_ = INP(I_NF2) + layer_ * DM; mode_ = 2; wo_ = WO_GU2; } \
        else { r_ -= CV_GU; src_ = INP(I_D2) + (size_t)layer_ * DM * FF; mode_ = 0; wo_ = WO_D2; K_ = FF; N_ = DM; } \
        p0_item(src_, K_, N_, gain_, (bf16*)(wl_ + wo_), mode_, scr, r_, lane); \
    } } while (0)

__global__ void __launch_bounds__(NWAVES * 64, 2) mk_fwd(Args args) {
    extern __shared__ __attribute__((aligned(16))) unsigned char lds[];
    LAS unsigned char* L = (LAS unsigned char*)lds;
    volatile LAS unsigned* MISC = (volatile LAS unsigned*)(L + MISC_OFF);
    for (int u = threadIdx.x; u < (LDS_BYTES - LDSCTL_OFF) / 4; u += NWAVES * 64) ((LAS unsigned*)(L + LDSCTL_OFF))[u] = 0u;
    __syncthreads();
    const int wave_s = __builtin_amdgcn_readfirstlane(threadIdx.x >> 6);
    XcdBarrier bar = xcd_barrier_post((unsigned*)(args.ws + WS_CTL) + CW_BAR, MISC + 8);
    const int lo = args.ph_lo, hi = args.ph_hi; int pc = 0;
#define PH_ON() (lo <= pc && pc < hi)
#define PH_END() do { if (lo <= pc && pc + 1 < hi) xcd_barrier(bar); ++pc; } while (0)

    if (PH_ON()) {
        const Ctx c = make_ctx(args.ws, wave_s); const int lane = c.lane, gw = c.gw, NGW = c.NGW;
        LAS float* scr = (LAS float*)(L + RING_OFF + c.wave * 16640);
        CONVERT_RANGE(0, CV_PRO, gw, NGW, c.ws, scr, lane);
        for (int e = c.bx * (NWAVES * 64) + c.tid; e < SEQ * 64; e += c.G * NWAVES * 64) { float cs, sn; rope_entry(e >> 6, e & 63, cs, sn); c.ROPE[e] = cs; c.ROPE[SEQ * 64 + e] = sn; }
        const float* xin = INP(I_X);
        for (int m = gw; m < M; m += NGW) {
            const GAS f32x4* xr = (const GAS f32x4*)(xin + (size_t)m * DM) + lane; GAS unsigned long long* o8 = (GAS unsigned long long*)(c.XB + (size_t)m * DM) + lane;
            GAS unsigned* l4 = (GAS unsigned*)(c.XL + (size_t)m * DM) + lane; float s = 0.f;
#pragma unroll
            for (int j = 0; j < 8; ++j) { const f32x4 v = xr[64 * j]; const unsigned w0 = pk2(v[0], v[1]), w1 = pk2(v[2], v[3]);
                const float d0 = pg8::lo_clamp(v[0] - __uint_as_float(w0 << 16)), d1 = pg8::lo_clamp(v[1] - __uint_as_float(w0 & 0xffff0000u)), d2 = pg8::lo_clamp(v[2] - __uint_as_float(w1 << 16)), d3 = pg8::lo_clamp(v[3] - __uint_as_float(w1 & 0xffff0000u));
                s += (v[0] * v[0] + v[1] * v[1]) + (v[2] * v[2] + v[3] * v[3]);
                o8[64 * j] = (unsigned long long)w0 | ((unsigned long long)w1 << 32);
                int wl = __builtin_amdgcn_cvt_pk_fp8_f32(d0, d1, 0, false); wl = __builtin_amdgcn_cvt_pk_fp8_f32(d2, d3, wl, true); l4[64 * j] = (unsigned)wl; }
            s = wave_sum(s);
            if (lane < 8) c.SSQ[(size_t)m * 8 + lane] = (lane == 0) ? s : 0.f;
        }
    }
    PH_END();

    for (int step = 0; step < 2 * DEPTH; ++step) {
        const int layer = step >> 1, half = step & 1;
        if (PH_ON()) {
            const Ctx c = make_ctx(args.ws, wave_s); unsigned char* wl = c.ws + WS_W + (size_t)layer * W_LAYER;
            pg8::Gemm g{c.XB, (const bf16*)(wl + (half ? WO_GU2 : WO_GU1)), M, 2 * FF, DM}; pg8::StaticOrder S; S.init(M, 2 * FF, c.G, c.bx);
            pg8::EpiSwiGLU E{c.H, c.SSQ};
            if (c.bx >= 128) {
                const int lo_ = layer * CV_LAYER + (half ? CV_T0 : CV_PRO); int hi_ = half ? (layer + 1) * CV_LAYER + CV_PRO : layer * CV_LAYER + CV_T0; if (hi_ > DEPTH * CV_LAYER) hi_ = DEPTH * CV_LAYER;
                LAS float* scr_ = (LAS float*)(L + RING_OFF + c.wave * 16640);
                CONVERT_RANGE(lo_, hi_, (c.bx - 128) * NWAVES + c.wave, 128 * NWAVES, c.ws, scr_, c.lane);
                __syncthreads();
            }
            pg8::gemm_phase<pg8::EpiSwiGLU, pg8::StaticOrder, true, true>(L + RING_OFF, g, S, E, c.tid);
        }
        PH_END();
        if (PH_ON()) {
            const Ctx c = make_ctx(args.ws, wave_s); unsigned char* wl = c.ws + WS_W + (size_t)layer * W_LAYER;
            pg8::Gemm g{c.H, (const bf16*)(wl + (half ? WO_D2 : WO_D1)), M, DM, FF}; pg8::StaticOrder S; S.init(M, DM, c.G, c.bx);
            pg8::EpiResid E{c.XB, c.XL, c.SSQ, 0.5f};
            pg8::gemm_phase<pg8::EpiResid, pg8::StaticOrder, false, true>(L + RING_OFF, g, S, E, c.tid);
        }
        PH_END();
        if (half == 0) {
            if (PH_ON()) {
                const Ctx c = make_ctx(args.ws, wave_s); unsigned char* wl = c.ws + WS_W + (size_t)layer * W_LAYER;
                pg8::Gemm g{c.XB, (const bf16*)(wl + WO_IN), M, DIN, DM}; pg8::StaticOrder S; S.init(M, DIN, c.G, c.bx);
                pg8::EpiQKV E{c.QKV, c.SSQ, c.ROPE, QK_C2};
                pg8::gemm_phase<pg8::EpiQKV, pg8::StaticOrder, true, true>(L + RING_OFF, g, S, E, c.tid);
            }
            PH_END();
            if (PH_ON()) {
                {
                    using namespace dattn;
                    const Ctx c = make_ctx(args.ws, wave_s);
                    const int bh = c.bx & 7, j = c.bx >> 3, br = j >> 4, vh = (j >> 3) & 1, x = j & 7, b = bh >> 2, h = bh & 3;
                    const __hip_bfloat16* Qb = (const __hip_bfloat16*)c.QKV + (size_t)(b * SEQ) * DIN + 3072 + h * 256 + br * 128;
                    const __hip_bfloat16* Kb = (const __hip_bfloat16*)c.QKV + (size_t)(b * SEQ) * DIN + 4096 + h * 256 + br * 128;
                    const __hip_bfloat16* Vb = (const __hip_bfloat16*)c.QKV + (size_t)(b * SEQ) * DIN + 5120 + h * 256 + vh * 128;
                    float* Ob = c.OD + (size_t)br * M * 1024 + (size_t)(b * SEQ) * 1024 + h * 256 + vh * 128;
                    const int qa = x, qb2 = 15 - x;
                    BlockRef<__hip_bfloat16, float> c0{Qb + (size_t)qa * QB * QP, Kb, Vb, Ob + (size_t)qa * QB * OP, qa * QB};
                    BlockRef<__hip_bfloat16, float> c1{Qb + (size_t)qb2 * QB * QP, Kb, Vb, Ob + (size_t)qb2 * QB * OP, qb2 * QB};
                    Seam<__hip_bfloat16> S;
                    __syncthreads();
                    causal_swa_prime<__hip_bfloat16, float>(c0, SEQ, (char*)lds + RING_OFF, S, c.tid);
                    causal_swa_block<__hip_bfloat16, float>(c0, c1, SEQ, SEQ, (char*)lds + RING_OFF, S, c.tid);
                    causal_swa_block<__hip_bfloat16, float>(c1, c1, SEQ, SEQ, (char*)lds + RING_OFF, S, c.tid);
                }
                {
                    const Ctx c = make_ctx(args.ws, wave_s);
                    const int j = c.bx >> 3, bh = ((c.bx & 7) << 1) | (j >> 4), qb = j & 15, b = bh >> 3, h = bh & 7;
                    const __hip_bfloat16* Qh = (const __hip_bfloat16*)c.QKV + (size_t)(b * SEQ) * DIN + h * HD;
                    dattn::sb_unit<DM>(Qh, Qh + 1024, Qh + 2048, (__hip_bfloat16*)c.MIX + (size_t)(b * SEQ) * DM + h * HD, qb * dattn::QB, SB_EXIT, (char*)lds + RING_OFF, c.tid);
                }
            }
            PH_END();
            if (PH_ON()) {
                const Ctx c = make_ctx(args.ws, wave_s); const int lane = c.lane;
                const float linit = args.linit[opaque_s(layer)];
                const float* lq1 = INP(I_LQ1) + layer * HD; const float* lk1 = INP(I_LK1) + layer * HD; const float* lq2 = INP(I_LQ2) + layer * HD; const float* lk2 = INP(I_LK2) + layer * HD;
                const float s1 = wave_sum(lq1[lane] * lk1[lane] + lq1[lane + 64] * lk1[lane + 64]), s2 = wave_sum(lq2[lane] * lk2[lane] + lq2[lane + 64] * lk2[lane + 64]);
                const float lam = expf(s1) - expf(s2) + linit;
                const f32x4 gsub = *(const GAS f32x4*)(INP(I_SUBLN) + layer * 256 + 4 * lane);
                const float* OD = c.OD; bf16* MIX = c.MIX;
                for (int idx = c.gw; idx < M * 4; idx += 4 * c.NGW) {
                    f32x4 o1[4], o2[4];
#pragma unroll
                    for (int q = 0; q < 4; ++q) { const int id = idx + q * c.NGW, row = id >> 2, h = id & 3;
                        o1[q] = *(const GAS f32x4*)(OD + (size_t)row * 1024 + h * 256 + 4 * lane); o2[q] = *(const GAS f32x4*)(OD + (size_t)M * 1024 + (size_t)row * 1024 + h * 256 + 4 * lane); }
#pragma unroll
                    for (int q = 0; q < 4; ++q) { const int id = idx + q * c.NGW, row = id >> 2, h = id & 3;
                        const f32x4 d = o1[q] - o2[q] * lam;
                        const float ss = wave_sum((d[0] * d[0] + d[1] * d[1]) + (d[2] * d[2] + d[3] * d[3]));
                        const float r = (1.0f / sqrtf(ss * (1.0f / 256.0f) + RMS_EPS)) * (1.0f - linit);
                        const f32x4 y = d * gsub * r;
                        *(GAS unsigned long long*)(MIX + (size_t)row * DM + 1024 + h * 256 + 4 * lane) = (unsigned long long)pk2(y[0], y[1]) | ((unsigned long long)pk2(y[2], y[3]) << 32); }
                }
            }
            PH_END();
            if (PH_ON()) {
                const Ctx c = make_ctx(args.ws, wave_s); unsigned char* wl = c.ws + WS_W + (size_t)layer * W_LAYER;
                pg8::Gemm g{c.MIX, (const bf16*)(wl + WO_OUT), M, DM, DM}; pg8::StaticOrder S; S.init(M, DM, c.G, c.bx);
                pg8::EpiResid E{c.XB, c.XL, c.SSQ, 1.0f};
                pg8::gemm_phase<pg8::EpiResid, pg8::StaticOrder, false, true>(L + RING_OFF, g, S, E, c.tid);
            }
            PH_END();
        }
    }
    if (PH_ON()) {
        const Ctx c = make_ctx(args.ws, wave_s); const int lane = c.lane;
        const bool bad = (__hip_atomic_load(c.ctl + CW_BAR + XB_TMO, RLX_AGENT) != 0u);
        const float* gf = INP(I_NFIN); float* out = args.out;
        for (int m = c.gw; m < M; m += c.NGW) {
            const GAS unsigned long long* xr = (const GAS unsigned long long*)(c.XB + (size_t)m * DM) + lane; const GAS unsigned* xl = (const GAS unsigned*)(c.XL + (size_t)m * DM) + lane; GAS f32x4* o = (GAS f32x4*)(out + (size_t)m * DM) + lane; f32x4 v[8]; float s = 0.f;
#pragma unroll
            for (int j = 0; j < 8; ++j) { const unsigned long long w = xr[64 * j]; const int wl = (int)xl[64 * j]; const unsigned w0 = (unsigned)w, w1 = (unsigned)(w >> 32);
                const pg8::f32x2v_ la = __builtin_amdgcn_cvt_pk_f32_fp8(wl, false), lb = __builtin_amdgcn_cvt_pk_f32_fp8(wl, true);
                v[j] = (f32x4){__uint_as_float(w0 << 16) + la.x * pg8::LO_INV, __uint_as_float(w0 & 0xffff0000u) + la.y * pg8::LO_INV,
                               __uint_as_float(w1 << 16) + lb.x * pg8::LO_INV, __uint_as_float(w1 & 0xffff0000u) + lb.y * pg8::LO_INV};
                s += (v[j][0] * v[j][0] + v[j][1] * v[j][1]) + (v[j][2] * v[j][2] + v[j][3] * v[j][3]); }
            float r = 1.0f / sqrtf(wave_sum(s) * (1.0f / DM) + RMS_EPS); if (bad) r = __builtin_nanf("");
#pragma unroll
            for (int j = 0; j < 8; ++j) o[64 * j] = v[j] * *((const GAS f32x4*)gf + lane + 64 * j) * r;
        }
    }
    PH_END();
#undef PH_ON
#undef PH_END
}
constexpr int N_PHASES = 1 + 2 * DEPTH * 2 + DEPTH * 4 + 1;

#ifndef MK_MULTI
#define MK_MULTI 0
#endif
extern "C" void kernel_launch(void* const* d_in, const int* in_sizes, int n_in, void* d_out, int out_size, void* d_ws, size_t ws_size, hipStream_t stream) {
    static int grid = 0;
    if (grid == 0) {
        if (n_in != 18 || in_sizes[0] != M * DM || out_size != M * DM || ws_size < WS_END) { fprintf(stderr, "kernel_launch: shape/workspace mismatch (n_in %d, in0 %d, out %d, ws %zu < %zu)\n", n_in, n_in > 0 ? in_sizes[0] : -1, out_size, ws_size, (size_t)WS_END); grid = -1; return; }
        if (hipFuncSetAttribute((const void*)mk_fwd, hipFuncAttributeMaxDynamicSharedMemorySize, LDS_BYTES) != hipSuccess) { fprintf(stderr, "kernel_launch: hipFuncSetAttribute failed\n"); grid = -1; return; }
        int per_cu = 0;
        if (hipOccupancyMaxActiveBlocksPerMultiprocessor(&per_cu, (const void*)mk_fwd, NWAVES * 64, LDS_BYTES) != hipSuccess || per_cu < 1) fprintf(stderr, "kernel_launch: occupancy query reports %d\n", per_cu);
        (void)hipGetLastError();
        grid = 256;
    }
    if (grid < 0) return;
    (void)hipMemsetAsync((char*)d_ws + WS_CTL, 0, CTL_ZERO_BYTES, stream);
    Args a{};
    for (int i = 0; i < 18; ++i) a.in[i] = (const float*)d_in[i];
    a.out = (float*)d_out; a.ws = (unsigned char*)d_ws;
    for (int l = 0; l < DEPTH; ++l) a.linit[l] = (float)(0.8 - 0.6 * exp(-0.3 * (double)l));
#if MK_MULTI
    for (int p = 0; p < N_PHASES; ++p) { a.ph_lo = p; a.ph_hi = p + 1; hipLaunchKernelGGL(mk_fwd, dim3(grid), dim3(NWAVES * 64), LDS_BYTES, stream, a); }
#else
    a.ph_lo = 0; a.ph_hi = N_PHASES;
    hipLaunchKernelGGL(mk_fwd, dim3(grid), dim3(NWAVES * 64), LDS_BYTES, stream, a);
#endif
    const hipError_t le = hipPeekAtLastError();
    if (le != hipSuccess) fprintf(stderr, "kernel_launch: launch failed: %s\n", hipGetErrorName(le));
}
```

```cpp
#include <hip/hip_bf16.h>
#include <cmath>
#include <hip/hip_runtime.h>
#include <cstdio>
#include <cstdint>
namespace pg8 {
#define PG8_LAS __attribute__((address_space(3)))
typedef unsigned short bf16_t;
typedef short bf16x8 __attribute__((ext_vector_type(8)));
typedef float f32x4 __attribute__((ext_vector_type(4)));
typedef unsigned u32x4 __attribute__((ext_vector_type(4)));
constexpr int BM = 256, BK = 64, HALF = 128, HTB = HALF * BK * 2  , STAGE_BYTES = 8 * HTB, NXCD = 8, WGM = 4;

__host__ __device__ __forceinline__ int lds_byte(int r, int c) { const int st = (r >> 4) * 2 + (c >> 5), rr = r & 15, cc = c & 31, ob = rr * 64 + cc * 2; return st * 1024 + (ob ^ (((ob >> 9) & 1) << 5)); }
__host__ __device__ __forceinline__ void stage_rc(int b, int& R, int& C) { const int st = b / 1024, sb = b % 1024, swz = sb ^ (((sb >> 9) & 1) << 5); R = (st >> 1) * 16 + swz / 64; C = (st & 1) * 32 + (swz % 64) / 2; }
__host__ __device__ __forceinline__ int perm32(int rho) { const int n = rho >> 4, i = rho & 15; return 8 * (i >> 2) + 4 * n + (i & 3); }

struct Unit { int pm, pn; };
struct Gemm { const bf16_t* A; const bf16_t* Bt; int M, N, K; };

struct StaticOrder {
    int nM, nN, nwg, G, c;
    __host__ __device__ void init(int M, int N, int G_, int c_) { nM = M / BM; nN = N / BM; nwg = nM * nN; G = G_; c = c_; }
    __host__ __device__ bool next(int i, Unit& u) const {
        const long L = (long)i * G + c; if (L >= nwg) return false;
        int wgid = (int)L; { const int q = nwg / NXCD, r = nwg % NXCD, xcd = wgid % NXCD, off = wgid / NXCD; wgid = (xcd < r ? xcd * (q + 1) : r * (q + 1) + (xcd - r) * q) + off; }
        const int nig = WGM * nN, gid = wgid / nig, fm = gid * WGM, gsz = (nM - fm) < WGM ? (nM - fm) : WGM;
        u.pm = fm + ((wgid % nig) % gsz); u.pn = (wgid % nig) / gsz; return true;
    }
    __device__ __forceinline__ void a_ready(const Unit&) const {}
    __device__ __forceinline__ void done(const Unit&) const {}
};

typedef float f32x2_t_ __attribute__((ext_vector_type(2))); typedef __bf16 bf16x2_t_ __attribute__((ext_vector_type(2)));
__device__ __forceinline__ unsigned cvt_pk_bf16(float lo, float hi) { f32x2_t_ v = {lo, hi}; bf16x2_t_ b = __builtin_convertvector(v, bf16x2_t_); return __builtin_bit_cast(unsigned, b); }
constexpr int DM_ = 2048, FF_ = 5632, DIN_ = 6144, SEQ_ = 4096;
constexpr float RMS_EPS_ = 1e-6f;
template <int PAT> __device__ __forceinline__ float swz_xor(float v) { return __int_as_float(__builtin_amdgcn_ds_swizzle(__float_as_int(v), PAT)); }
__device__ __forceinline__ float half_swap_sum(float v) { auto rr = __builtin_amdgcn_permlane32_swap(__float_as_uint(v), __float_as_uint(v), false, false); return __uint_as_float(rr[0]) + __uint_as_float(rr[1]); }
__device__ __forceinline__ float wave_sum_nolane(float v) { v += swz_xor<0x041F>(v); v += swz_xor<0x081F>(v); v += swz_xor<0x101F>(v); v += swz_xor<0x201F>(v); v += swz_xor<0x401F>(v); return half_swap_sum(v); }
__device__ __forceinline__ float row_msq(const float* ssq, int row) {
    const f32x4 a = *(const f32x4*)(ssq + (size_t)row * 8), b = *(const f32x4*)(ssq + (size_t)row * 8 + 4);
    const float s = ((a[0] + a[1]) + (a[2] + a[3])) + ((b[0] + b[1]) + (b[2] + b[3]));
    return s * (1.0f / DM_) + RMS_EPS_;
}
__device__ __forceinline__ float row_rstd(const float* ssq, int row) {
    const f32x4 a = *(const f32x4*)(ssq + (size_t)row * 8), b = *(const f32x4*)(ssq + (size_t)row * 8 + 4);
    const float s = ((a[0] + a[1]) + (a[2] + a[3])) + ((b[0] + b[1]) + (b[2] + b[3]));
    return __builtin_amdgcn_rsqf(s * (1.0f / DM_) + RMS_EPS_);
}
struct EpiSwiGLU {
    static constexpr bool PERM = true, AFTER_DRAIN = false;
    bf16_t* H; const float* ssq;
    __device__ __forceinline__ void operator()(const f32x4 (&acc)[2][2][4][2], const Unit& u, int wr, int wc, int fr, int fq) const {
        const int row0 = u.pm * BM + wr * 64 + fr, col0 = u.pn * HALF + wc * 32 + 8 * fq;
        float rsv[8];
#pragma unroll
        for (int q = 0; q < 8; ++q) rsv[q] = row_msq(ssq, row0 + (q >> 2) * HALF + (q & 3) * 16);
#pragma unroll
        for (int ai = 0; ai < 2; ++ai)
#pragma unroll
            for (int m = 0; m < 4; ++m) { const int row = row0 + ai * HALF + m * 16; const float msq = rsv[ai * 4 + m], rsn = __builtin_amdgcn_rsqf(msq) * -1.4426950408889634f;
                f32x4 hv[2];
#pragma unroll
                for (int n = 0; n < 2; ++n) { const f32x4 g = acc[ai][0][m][n], up = acc[ai][1][m][n]; const f32x4 a = g * rsn; f32x4 e;
                    e[0] = __builtin_amdgcn_exp2f(a[0]); e[1] = __builtin_amdgcn_exp2f(a[1]); e[2] = __builtin_amdgcn_exp2f(a[2]); e[3] = __builtin_amdgcn_exp2f(a[3]);
                    const f32x4 d = e * msq + msq; f32x4 r; r[0] = __builtin_amdgcn_rcpf(d[0]); r[1] = __builtin_amdgcn_rcpf(d[1]); r[2] = __builtin_amdgcn_rcpf(d[2]); r[3] = __builtin_amdgcn_rcpf(d[3]);
                    hv[n] = (g * up) * r; }
                u32x4 w; w.x = cvt_pk_bf16(hv[0][0], hv[0][1]); w.y = cvt_pk_bf16(hv[0][2], hv[0][3]); w.z = cvt_pk_bf16(hv[1][0], hv[1][1]); w.w = cvt_pk_bf16(hv[1][2], hv[1][3]);
                *(u32x4*)(H + (size_t)row * FF_ + col0) = w; }
    }
};
struct EpiQKV {
    static constexpr bool PERM = true, AFTER_DRAIN = false;
    bf16_t* QKV; const float* ssq; const float* rope; float qscale;
    __device__ __forceinline__ void operator()(const f32x4 (&acc)[2][2][4][2], const Unit& u, int wr, int wc, int fr, int fq) const {
        const int sec = u.pn >> 2; const bool rp = (sec == 3) || (sec == 4); const float qs = (sec == 0) ? qscale : 1.0f;
        const int row0 = u.pm * BM + wr * 64 + fr, i0 = 32 * (wc & 1) + 8 * fq;
        float rsv[8];
#pragma unroll
        for (int q = 0; q < 8; ++q) rsv[q] = row_rstd(ssq, row0 + (q >> 2) * HALF + (q & 3) * 16) * qs;
        bf16_t* pbase = QKV + (size_t)row0 * DIN_ + u.pn * BM + (wc >> 1) * HALF + i0;
        if (!rp) {
#pragma unroll
            for (int ai = 0; ai < 2; ++ai)
#pragma unroll
                for (int m = 0; m < 4; ++m) { const float rs = rsv[ai * 4 + m];
#pragma unroll
                    for (int bj = 0; bj < 2; ++bj) { const f32x4 v0 = acc[ai][bj][m][0] * rs, v1 = acc[ai][bj][m][1] * rs;
                        u32x4 w; w.x = cvt_pk_bf16(v0[0], v0[1]); w.y = cvt_pk_bf16(v0[2], v0[3]); w.z = cvt_pk_bf16(v1[0], v1[1]); w.w = cvt_pk_bf16(v1[2], v1[3]);
                        *(u32x4*)(pbase + (size_t)(ai * HALF + m * 16) * DIN_ + bj * 64) = w; } }
        } else {
#pragma unroll
            for (int ai = 0; ai < 2; ++ai)
#pragma unroll
                for (int mp = 0; mp < 2; ++mp) {
                    f32x4 csv[2][2], snv[2][2];
#pragma unroll
                    for (int k = 0; k < 2; ++k) { const int pos = (row0 + ai * HALF + (2 * mp + k) * 16) & (SEQ_ - 1);
#pragma unroll
                        for (int n = 0; n < 2; ++n) { csv[k][n] = *(const f32x4*)(rope + (size_t)pos * 64 + i0 + 4 * n); snv[k][n] = *(const f32x4*)(rope + (size_t)SEQ_ * 64 + (size_t)pos * 64 + i0 + 4 * n); } }
                    asm volatile("" ::: "memory");
#pragma unroll
                    for (int k = 0; k < 2; ++k) { const int m = 2 * mp + k; const float rs = rsv[ai * 4 + m];
                        f32x4 o0[2], o1[2];
#pragma unroll
                        for (int n = 0; n < 2; ++n) { const f32x4 lo = acc[ai][0][m][n] * rs, hi = acc[ai][1][m][n] * rs; o0[n] = lo * csv[k][n] - hi * snv[k][n]; o1[n] = hi * csv[k][n] + lo * snv[k][n]; }
                        bf16_t* p = pbase + (size_t)(ai * HALF + m * 16) * DIN_;
                        u32x4 a, b; a.x = cvt_pk_bf16(o0[0][0], o0[0][1]); a.y = cvt_pk_bf16(o0[0][2], o0[0][3]); a.z = cvt_pk_bf16(o0[1][0], o0[1][1]); a.w = cvt_pk_bf16(o0[1][2], o0[1][3]);
                        b.x = cvt_pk_bf16(o1[0][0], o1[0][1]); b.y = cvt_pk_bf16(o1[0][2], o1[0][3]); b.z = cvt_pk_bf16(o1[1][0], o1[1][1]); b.w = cvt_pk_bf16(o1[1][2], o1[1][3]);
                        *(u32x4*)p = a; *(u32x4*)(p + 64) = b; }
                    asm volatile("" ::: "memory"); }
        }
    }
};
typedef float f32x2v_ __attribute__((ext_vector_type(2)));
constexpr float LO_SCALE = 512.0f, LO_INV = 1.0f / 512.0f, LO_MAX = 224.0f;
__device__ __forceinline__ float lo_clamp(float d) { return __builtin_fminf(__builtin_fmaxf(d * LO_SCALE, -LO_MAX), LO_MAX); }
struct EpiResid {
    static constexpr bool PERM = true, AFTER_DRAIN = true;
    bf16_t* XB; unsigned char* XL; float* ssq; float alpha;
    __device__ __forceinline__ void fused(f32x4 (&acc)[2][2][4][2], const Unit& u, int wr, int wc, int fr, int fq, PG8_LAS unsigned char* lds, int wid, int lane) const {
        typedef unsigned u32x2 __attribute__((ext_vector_type(2)));
        PG8_LAS float* P = (PG8_LAS float*)lds;
        const int col0 = u.pn * BM + wc * 32 + 8 * fq;
#pragma unroll
        for (int ai = 0; ai < 2; ++ai) {
            u32x4 ph[4][2]; u32x2 pl[4][2];
#pragma unroll
            for (int m = 0; m < 4; ++m) { const size_t off = (size_t)(u.pm * BM + ai * HALF + wr * 64 + m * 16 + fr) * DM_ + col0;
#pragma unroll
                for (int bj = 0; bj < 2; ++bj) { ph[m][bj] = *(const u32x4*)(XB + off + bj * HALF); pl[m][bj] = *(const u32x2*)(XL + off + bj * HALF); } }
            asm volatile("" ::: "memory");
#pragma unroll
            for (int m = 0; m < 4; ++m) { const int r = ai * HALF + wr * 64 + m * 16 + fr; const size_t off = (size_t)(u.pm * BM + r) * DM_ + col0; float s = 0.f;
#pragma unroll
                for (int bj = 0; bj < 2; ++bj) { const u32x4 a = ph[m][bj]; const u32x2 b = pl[m][bj]; u32x4 wh; int wl0 = 0, wl1 = 0;
#pragma unroll
                    for (int q = 0; q < 4; ++q) {
                        const f32x2v_ l = (q & 1) ? __builtin_amdgcn_cvt_pk_f32_fp8((int)(q < 2 ? b.x : b.y), true) : __builtin_amdgcn_cvt_pk_f32_fp8((int)(q < 2 ? b.x : b.y), false);
                        const float x0 = __uint_as_float(a[q] << 16) + l.x * LO_INV, x1 = __uint_as_float(a[q] & 0xffff0000u) + l.y * LO_INV;
                        const float v0 = x0 + acc[ai][bj][m][q >> 1][(q & 1) * 2] * alpha, v1 = x1 + acc[ai][bj][m][q >> 1][(q & 1) * 2 + 1] * alpha;
                        const unsigned h = cvt_pk_bf16(v0, v1); wh[q] = h;
                        const float d0 = lo_clamp(v0 - __uint_as_float(h << 16)), d1 = lo_clamp(v1 - __uint_as_float(h & 0xffff0000u));
                        if (q == 0) wl0 = __builtin_amdgcn_cvt_pk_fp8_f32(d0, d1, wl0, false); else if (q == 1) wl0 = __builtin_amdgcn_cvt_pk_fp8_f32(d0, d1, wl0, true);
                        else if (q == 2) wl1 = __builtin_amdgcn_cvt_pk_fp8_f32(d0, d1, wl1, false); else wl1 = __builtin_amdgcn_cvt_pk_fp8_f32(d0, d1, wl1, true);
                        s += v0 * v0 + v1 * v1; }
                    *(u32x4*)(XB + off + bj * HALF) = wh; u32x2 wl; wl.x = (unsigned)wl0; wl.y = (unsigned)wl1; *(u32x2*)(XL + off + bj * HALF) = wl; }
                s += swz_xor<0x401F>(s); s = half_swap_sum(s);
                if (fq == 0) P[r * 4 + wc] = s; }
            asm volatile("" ::: "memory"); }
        asm volatile("s_waitcnt lgkmcnt(0)" ::: "memory"); __builtin_amdgcn_s_barrier(); asm volatile("" ::: "memory");
        const int t = wid * 64 + lane;
        if (t < 256) { const f32x4 p = *(const PG8_LAS f32x4*)(P + t * 4); ssq[(size_t)(u.pm * BM + t) * 8 + u.pn] = (p[0] + p[1]) + (p[2] + p[3]); }
        asm volatile("s_waitcnt lgkmcnt(0)" ::: "memory"); __builtin_amdgcn_s_barrier(); asm volatile("" ::: "memory");
    }
};

template <class Epi, class Sched, bool ALIGN_EPI = false, bool SP2 = false>
__device__ __forceinline__ void gemm_phase(PG8_LAS unsigned char* lds, const Gemm g, const Sched& S, const Epi& E, int tid_in) {
    int tid_ = tid_in; asm volatile("" : "+v"(tid_));
    const int tid = tid_, wid = __builtin_amdgcn_readfirstlane(tid >> 6), lane = tid & 63, wr = wid >> 2, wc = wid & 3, fr = lane & 15, fq = lane >> 4;
    const int K = g.K, nt = K / BK;
    unsigned voffA[2], voffB[2];
#pragma unroll
    for (int i = 0; i < 2; ++i) { int R, C; stage_rc(tid * 16 + i * 8192, R, C); const int Rb = Epi::PERM ? ((R & ~31) + perm32(R & 31)) : R;
        voffA[i] = (unsigned)(R * K + C) * 2u; voffB[i] = (unsigned)(Rb * K + C) * 2u; }
    const size_t kstep = (size_t)(BK * 2);
    const size_t hstep = (size_t)HALF * K * 2;
    const size_t tstep = 2 * hstep;
    const unsigned ldsw = (unsigned)wid * 1024u;
    const int aoff = lds_byte(wr * 64 + fr, fq * 8), boff = lds_byte(wc * 32 + fr, fq * 8);
#define PG8_SA(b, h) (((b) * 2 + (h)) * HTB)
#define PG8_SB(b, h) ((4 + (b) * 2 + (h)) * HTB)
#define PG8_STAGE(bufoff, gbase, voff) do { _Pragma("unroll") for (int _i = 0; _i < 2; ++_i) \
        __builtin_amdgcn_global_load_lds((const unsigned*)((const char*)(gbase) + (voff)[_i]), (PG8_LAS unsigned*)(lds + (bufoff) + ldsw + _i * 8192), 16, 0, 0); } while (0)
#define PG8_LDA(dst, b, h) do { _Pragma("unroll") for (int m = 0; m < 4; ++m) _Pragma("unroll") for (int k = 0; k < 2; ++k) dst[m][k] = *(const PG8_LAS bf16x8*)(lds + PG8_SA(b, h) + aoff + m * 2048 + k * 1024); } while (0)
#define PG8_LDB(dst, b, h) do { _Pragma("unroll") for (int n = 0; n < 2; ++n) _Pragma("unroll") for (int k = 0; k < 2; ++k) dst[n][k] = *(const PG8_LAS bf16x8*)(lds + PG8_SB(b, h) + boff + n * 2048 + k * 1024); } while (0)
#define PG8_MMA(ai, bj, At, Bt) do { __builtin_amdgcn_s_setprio(1); _Pragma("unroll") for (int m = 0; m < 4; ++m) _Pragma("unroll") for (int n = 0; n < 2; ++n) _Pragma("unroll") for (int k = 0; k < 2; ++k) \
        acc[ai][bj][m][n] = __builtin_amdgcn_mfma_f32_16x16x32_bf16(Bt[n][k], At[m][k], acc[ai][bj][m][n], 0, 0, 0); __builtin_amdgcn_s_setprio(0); } while (0)
#define PG8_WAIT_V(n) asm volatile("s_waitcnt vmcnt(" #n ")" ::: "memory")
#define PG8_WAIT_L(n) asm volatile("s_waitcnt lgkmcnt(" #n ")" ::: "memory")
#define PG8_BAR __builtin_amdgcn_s_barrier()
#define PG8_SCHED __builtin_amdgcn_sched_barrier(0)
    Unit cur, nxt; int ui = 0;
    if (!S.next(0, cur)) return;
    f32x4 acc[2][2][4][2];
#pragma unroll
    for (int a = 0; a < 2; ++a)
#pragma unroll
        for (int b = 0; b < 2; ++b)
#pragma unroll
            for (int m = 0; m < 4; ++m)
#pragma unroll
                for (int n = 0; n < 2; ++n) acc[a][b][m][n] = (f32x4){0.f, 0.f, 0.f, 0.f};
    bf16x8 At[4][2], B0[2][2], B1[2][2];
    const char* cA = (const char*)g.A + (size_t)cur.pm * tstep; const char* cB = (const char*)g.Bt + (size_t)cur.pn * tstep;
    S.a_ready(cur);
    if constexpr (SP2) {
        PG8_STAGE(PG8_SB(0, 0), cB, voffB); PG8_STAGE(PG8_SB(0, 1), cB + hstep, voffB); PG8_STAGE(PG8_SA(0, 0), cA, voffA); PG8_STAGE(PG8_SA(0, 1), cA + hstep, voffA);
        if (wr == 1) PG8_BAR;
        PG8_WAIT_V(2); PG8_BAR;
        PG8_STAGE(PG8_SB(1, 0), cB + kstep, voffB); PG8_STAGE(PG8_SA(1, 0), cA + kstep, voffA); PG8_STAGE(PG8_SB(1, 1), cB + hstep + kstep, voffB);
        PG8_WAIT_V(6); PG8_BAR;
    } else {
        PG8_STAGE(PG8_SB(0, 0), cB, voffB); PG8_STAGE(PG8_SA(0, 0), cA, voffA); PG8_STAGE(PG8_SB(0, 1), cB + hstep, voffB); PG8_STAGE(PG8_SA(0, 1), cA + hstep, voffA);
        if (wr == 1) PG8_BAR;
        PG8_WAIT_V(4); PG8_BAR;
        PG8_STAGE(PG8_SB(1, 0), cB + kstep, voffB); PG8_STAGE(PG8_SA(1, 0), cA + kstep, voffA); PG8_STAGE(PG8_SB(1, 1), cB + hstep + kstep, voffB);
        PG8_WAIT_V(6); PG8_BAR;
    }
    for (;;) {
        const bool has_next = S.next(ui + 1, nxt);
        const char* nA = has_next ? (const char*)g.A + (size_t)nxt.pm * tstep : cA; const char* nB = has_next ? (const char*)g.Bt + (size_t)nxt.pn * tstep : cB;
        for (int t = 0; t < nt; t += 2) {
            const bool last = (t == nt - 2);
            const char* a1 = cA + (size_t)(t + 1) * kstep;
            const char* a2 = last ? nA : cA + (size_t)(t + 2) * kstep; const char* b2 = last ? nB : cB + (size_t)(t + 2) * kstep;
            const char* a3 = a2 + kstep; const char* b3 = b2 + kstep;
            if (last && has_next) S.a_ready(nxt);
            if constexpr (SP2) {
            PG8_LDB(B0, 0, 0); PG8_LDB(B1, 0, 1); PG8_SCHED; PG8_LDA(At, 0, 0); PG8_STAGE(PG8_SA(1, 1), a1 + hstep, voffA);
            PG8_WAIT_V(8); PG8_WAIT_L(0); PG8_BAR; PG8_MMA(0, 0, At, B0); PG8_MMA(0, 1, At, B1); PG8_BAR; PG8_SCHED;
            PG8_LDA(At, 0, 1); PG8_STAGE(PG8_SB(0, 0), b2, voffB); PG8_STAGE(PG8_SB(0, 1), b2 + hstep, voffB); PG8_STAGE(PG8_SA(0, 0), a2, voffA);
            PG8_WAIT_V(8); PG8_WAIT_L(0); PG8_BAR; PG8_MMA(1, 0, At, B0); PG8_MMA(1, 1, At, B1); PG8_BAR; PG8_SCHED;
            PG8_LDB(B0, 1, 0); PG8_LDB(B1, 1, 1); PG8_SCHED; PG8_LDA(At, 1, 0); PG8_STAGE(PG8_SA(0, 1), a2 + hstep, voffA);
            PG8_WAIT_V(8); PG8_WAIT_L(0); PG8_BAR; PG8_MMA(0, 0, At, B0); PG8_MMA(0, 1, At, B1); PG8_BAR; PG8_SCHED;
            PG8_LDA(At, 1, 1); PG8_STAGE(PG8_SB(1, 0), b3, voffB); PG8_STAGE(PG8_SB(1, 1), b3 + hstep, voffB); PG8_STAGE(PG8_SA(1, 0), a3, voffA);
            PG8_WAIT_V(8); PG8_WAIT_L(0); PG8_BAR; PG8_MMA(1, 0, At, B0); PG8_MMA(1, 1, At, B1); PG8_BAR; PG8_SCHED;
            } else {
            PG8_LDB(B0, 0, 0); PG8_SCHED; PG8_LDA(At, 0, 0); PG8_STAGE(PG8_SA(1, 1), a1 + hstep, voffA);
            PG8_WAIT_L(8); PG8_BAR; PG8_WAIT_L(0); PG8_MMA(0, 0, At, B0); PG8_BAR; PG8_SCHED;
            PG8_LDB(B1, 0, 1); PG8_STAGE(PG8_SB(0, 0), b2, voffB);
            PG8_BAR; PG8_WAIT_L(0); PG8_MMA(0, 1, At, B1); PG8_BAR;
            PG8_LDA(At, 0, 1); PG8_STAGE(PG8_SA(0, 0), a2, voffA);
            PG8_BAR; PG8_WAIT_L(0); PG8_MMA(1, 0, At, B0); PG8_BAR; PG8_SCHED;
            PG8_STAGE(PG8_SB(0, 1), b2 + hstep, voffB);
            PG8_WAIT_V(6); PG8_BAR; PG8_MMA(1, 1, At, B1); PG8_BAR;
            PG8_LDB(B0, 1, 0); PG8_SCHED; PG8_LDA(At, 1, 0); PG8_STAGE(PG8_SA(0, 1), a2 + hstep, voffA);
            PG8_WAIT_L(8); PG8_BAR; PG8_WAIT_L(0); PG8_MMA(0, 0, At, B0); PG8_BAR; PG8_SCHED;
            PG8_LDB(B1, 1, 1); PG8_STAGE(PG8_SB(1, 0), b3, voffB);
            PG8_BAR; PG8_WAIT_L(0); PG8_MMA(0, 1, At, B1); PG8_BAR;
            PG8_LDA(At, 1, 1); PG8_STAGE(PG8_SA(1, 0), a3, voffA);
            PG8_BAR; PG8_WAIT_L(0); PG8_MMA(1, 0, At, B0); PG8_BAR; PG8_SCHED;
            PG8_STAGE(PG8_SB(1, 1), b3 + hstep, voffB);
            PG8_WAIT_V(6); PG8_BAR; PG8_MMA(1, 1, At, B1); PG8_BAR;
            }
        }
        if constexpr (ALIGN_EPI) { if (wr == 0) PG8_BAR; }
        if constexpr (!Epi::AFTER_DRAIN) { E(acc, cur, wr, wc, fr, fq); S.done(cur); }
        if (!has_next) break;
#pragma unroll
        for (int a = 0; a < 2; ++a)
#pragma unroll
            for (int b = 0; b < 2; ++b)
#pragma unroll
                for (int m = 0; m < 4; ++m)
#pragma unroll
                    for (int n = 0; n < 2; ++n) acc[a][b][m][n] = (f32x4){0.f, 0.f, 0.f, 0.f};
        cur = nxt; cA = nA; cB = nB; ++ui;
        if constexpr (ALIGN_EPI) { if (wr == 1) PG8_BAR; }
    }
    PG8_WAIT_V(0);
    if constexpr (!ALIGN_EPI) { if (wr == 0) PG8_BAR; }
    PG8_BAR;
    if constexpr (Epi::AFTER_DRAIN) { E.fused(acc, cur, wr, wc, fr, fq, lds, wid, lane); S.done(cur); }
#undef PG8_SA
#undef PG8_SB
#undef PG8_STAGE
#undef PG8_LDA
#undef PG8_LDB
#undef PG8_MMA
#undef PG8_WAIT_V
#undef PG8_WAIT_L
#undef PG8_BAR
#undef PG8_SCHED
}
}
namespace dattn {
constexpr int D = 128;
constexpr int QP = 6144, KVP = 6144, OP = 1024;
constexpr float THR = 8.f;
constexpr bool WSKIP = false;
constexpr float SCALE = 0.08838834764831845f;
constexpr int NW = 8, QBLK = 32, KVBLK = 64, QB = NW * QBLK;
constexpr int SHM_V = KVBLK * D * 2, SHM_K = KVBLK * D * 2;
constexpr int LDS_BYTES = 2 * SHM_V + 2 * SHM_K + NW * 64 * 4;
using bf16 = __hip_bfloat16;
typedef short bf16x8 __attribute__((ext_vector_type(8)));
typedef short s16x4 __attribute__((ext_vector_type(4)));
typedef float f32x16 __attribute__((ext_vector_type(16)));
typedef float f32x4 __attribute__((ext_vector_type(4)));
typedef unsigned u32x4 __attribute__((ext_vector_type(4)));
template <class A, class Bt> struct same_t { static constexpr bool v = false; };
template <class A> struct same_t<A, A> { static constexpr bool v = true; };

#define KSWZ(row, colB) ((row) * 256 + ((colB) ^ (((row) & 7) << 4)))
#define SBAR() __builtin_amdgcn_sched_barrier(0)
__device__ __forceinline__ int v_st(int k, int c) { const int kk = (k & ~0xC) | ((k & 4) << 1) | ((k & 8) >> 1); return ((kk >> 3) * 4 + (c >> 5)) * 512 + ((kk & 7) * 32 + (c & 31)) * 2; }
__device__ __forceinline__ int v_rd_base(int lane) { return ((lane & 3) << 3) | (((lane >> 2) & 3) << 6) | (((lane >> 4) & 1) << 5) | (((lane >> 5) & 1) << 8); }
constexpr int v_rd_off(int d0, int ks, int half) { return d0 * 512 + ks * 4096 + half * 2048; }
__device__ __forceinline__ int crow(int r, int hi) { return (r & 3) + 8 * (r >> 2) + 4 * hi; }
__device__ __forceinline__ unsigned cvtpk(float lo, float hi) {
    unsigned r; asm volatile("v_cvt_pk_bf16_f32 %0, %1, %2" : "=v"(r) : "v"(lo), "v"(hi)); return r;
}
__device__ __forceinline__ bf16x8 pack8(f32x4 a, f32x4 b) {
    u32x4 w = {cvtpk(a[0], a[1]), cvtpk(a[2], a[3]), cvtpk(b[0], b[1]), cvtpk(b[2], b[3])};
    return *reinterpret_cast<bf16x8*>(&w);
}
template <class T> __device__ __forceinline__ bf16x8 load8(const T* p) {
    if constexpr (same_t<T, float>::v) { return pack8(*(const f32x4*)p, *(const f32x4*)(p + 4)); }
    else { return *reinterpret_cast<const bf16x8*>(p); }
}
__device__ __forceinline__ void mask_tile(f32x16& p0, f32x16& p1, int dq, unsigned W) {
    const float NEG = -__builtin_inff();
#pragma unroll
    for (int r = 0; r < 16; ++r) {
        const int c = (r & 3) + 8 * (r >> 2);
        if ((unsigned)(dq - c) >= W) p0[r] = NEG;
        if ((unsigned)(dq - c - 32) >= W) p1[r] = NEG;
    }
}
__device__ __forceinline__ void partialSM(f32x16& p0, f32x16& p1, float& m_reg, float& mn, float& alpha) {
    float pmax = p0[0]; for (int r = 1; r < 16; ++r) pmax = fmaxf(pmax, p0[r]); for (int r = 0; r < 16; ++r) pmax = fmaxf(pmax, p1[r]);
    { auto rr = __builtin_amdgcn_permlane32_swap(__float_as_uint(pmax), __float_as_uint(pmax), false, false);
      pmax = fmaxf(__uint_as_float(rr[0]), __uint_as_float(rr[1])); }
    constexpr float C2 = 1.4426950408889634f * SCALE;
    if (__builtin_expect(__all((pmax - m_reg) * SCALE <= THR), 1)) { mn = m_reg; alpha = 1.f; }
    else { mn = fmaxf(m_reg, pmax); alpha = __builtin_amdgcn_exp2f((m_reg - mn) * C2); m_reg = mn; }
    const float mnL = -mn * C2;
    for (int r = 0; r < 16; ++r) p0[r] = fmaf(p0[r], C2, mnL); for (int r = 0; r < 16; ++r) p1[r] = fmaf(p1[r], C2, mnL);
    for (int r = 0; r < 16; ++r) p0[r] = __builtin_amdgcn_exp2f(p0[r]);
}
__device__ __forceinline__ void finishSM(f32x16& p0, f32x16& p1, float alpha, float& l_reg, bf16x8& pa0, bf16x8& pa1, bf16x8& pa2, bf16x8& pa3) {
    for (int r = 0; r < 16; ++r) p1[r] = __builtin_amdgcn_exp2f(p1[r]);
    float ps = 0; for (int r = 0; r < 16; ++r) ps += p0[r]; for (int r = 0; r < 16; ++r) ps += p1[r];
    { auto rr = __builtin_amdgcn_permlane32_swap(__float_as_uint(ps), __float_as_uint(ps), false, false);
      ps = __uint_as_float(rr[0]) + __uint_as_float(rr[1]); }
    l_reg = l_reg * alpha + ps;
#define PK4(P, B_, OUT) do { unsigned a0 = cvtpk(P[B_+0], P[B_+1]), a1 = cvtpk(P[B_+2], P[B_+3]);                          \
        unsigned b0 = cvtpk(P[B_+4], P[B_+5]), b1 = cvtpk(P[B_+6], P[B_+7]);                                             \
        auto r0 = __builtin_amdgcn_permlane32_swap(a0, b0, false, false); auto r1 = __builtin_amdgcn_permlane32_swap(a1, b1, false, false); \
        u32x4 w = {r0[0], r1[0], r0[1], r1[1]}; OUT = *reinterpret_cast<bf16x8*>(&w); } while (0)
    PK4(p0, 0, pa0); PK4(p0, 8, pa1); PK4(p1, 0, pa2); PK4(p1, 8, pa3);
#undef PK4
}
template <int KB, bool SK>
__device__ __forceinline__ void qkt(f32x16& p0, f32x16& p1, const char* K_lds, int r32, int hi, const bf16x8* qr, bool act) {
    if (SK && !act) { const float NEG = -__builtin_inff();
#pragma unroll
        for (int r = 0; r < 16; ++r) { p0[r] = NEG; p1[r] = NEG; } return; }
    p0 = f32x16{}; p1 = f32x16{};
    const char* kb[4];
#pragma unroll
    for (int dd = 0; dd < 4; ++dd) kb[dd] = K_lds + KB * SHM_K + KSWZ(r32, (dd * 16 + hi * 8) * 2);
#pragma unroll
    for (int d0 = 0; d0 < 8; ++d0) { const char* a = kb[d0 & 3] + (d0 >> 2) * 128;
        bf16x8 b0 = *reinterpret_cast<const bf16x8*>(a);
        bf16x8 b1 = *reinterpret_cast<const bf16x8*>(a + 32 * 256);
        p0 = __builtin_amdgcn_mfma_f32_32x32x16_bf16(b0, qr[d0], p0, 0, 0, 0);
        p1 = __builtin_amdgcn_mfma_f32_32x32x16_bf16(b1, qr[d0], p1, 0, 0, 0); }
}
template <int VB, bool SK>
__device__ __forceinline__ void pv_tile(f32x16* o, int vb0, bf16x8 pa0, bf16x8 pa1, bf16x8 pa2, bf16x8 pa3, bool act) {
    if (SK && !act) return;
#define TRRD(dst, off) asm volatile("ds_read_b64_tr_b16 %0, %1 offset:%2" : "=&v"(dst) : "v"(vb0), "i"(off) : "memory")
#define PV_D0(d0) do { s16x4 l0, l1, l2, l3, h0, h1, h2, h3; constexpr int b_ = VB * SHM_V + v_rd_off(d0, 0, 0);     \
        TRRD(l0, b_); TRRD(h0, b_ + 2048); TRRD(l1, b_ + 4096); TRRD(h1, b_ + 6144); TRRD(l2, b_ + 8192); TRRD(h2, b_ + 10240); TRRD(l3, b_ + 12288); TRRD(h3, b_ + 14336); \
        asm volatile("s_waitcnt lgkmcnt(0)" ::: "memory"); SBAR();                 \
        o[d0] = __builtin_amdgcn_mfma_f32_32x32x16_bf16(pa0, (bf16x8){l0[0], l0[1], l0[2], l0[3], h0[0], h0[1], h0[2], h0[3]}, o[d0], 0, 0, 0);   \
        o[d0] = __builtin_amdgcn_mfma_f32_32x32x16_bf16(pa1, (bf16x8){l1[0], l1[1], l1[2], l1[3], h1[0], h1[1], h1[2], h1[3]}, o[d0], 0, 0, 0);   \
        o[d0] = __builtin_amdgcn_mfma_f32_32x32x16_bf16(pa2, (bf16x8){l2[0], l2[1], l2[2], l2[3], h2[0], h2[1], h2[2], h2[3]}, o[d0], 0, 0, 0);   \
        o[d0] = __builtin_amdgcn_mfma_f32_32x32x16_bf16(pa3, (bf16x8){l3[0], l3[1], l3[2], l3[3], h3[0], h3[1], h3[2], h3[3]}, o[d0], 0, 0, 0); } while (0)
    PV_D0(0); PV_D0(1); PV_D0(2); PV_D0(3);
#undef PV_D0
#undef TRRD
}

template <class TIn, class TOut> struct BlockRef { const TIn* Q; const TIn* K; const TIn* V; TOut* O; int P0; };
template <class TIn> struct Seam {
    bf16x8 qr[8];
    bf16x8 st_v0, st_v1, st_k0, st_k1; f32x4 sf0, sf1, sf2, sf3;
    f32x4 tq[16];
};
__device__ __forceinline__ int swa_jlo(int P0, int W) { const int lowk = P0 - W + 1; return lowk > 0 ? lowk / KVBLK : 0; }
#define ROW(p, k0, rr) ((p) + (size_t)((k0) + (rr)) * KVP + sc)
#define VMW() asm volatile("s_waitcnt vmcnt(0)" ::: "memory")
#define VMWN(n) asm volatile("s_waitcnt vmcnt(%0)" :: "i"(n) : "memory")
#define SLOAD_H(Kp, Vp, k0) do { S.st_v0 = load8<TIn>(ROW(Vp, k0, sr)); S.st_v1 = load8<TIn>(ROW(Vp, k0, 32 + sr));              \
                         S.st_k0 = load8<TIn>(ROW(Kp, k0, sr)); S.st_k1 = load8<TIn>(ROW(Kp, k0, 32 + sr)); } while (0)
#define SWRITE_HK(bf) do { *(bf16x8*)(K_lds + (bf) * SHM_K + kws) = S.st_k0; *(bf16x8*)(K_lds + (bf) * SHM_K + kws + 32 * 256) = S.st_k1; } while (0)
#define SWRITE_HV(bf) do { *(bf16x8*)(V_lds + (bf) * SHM_V + vst0) = S.st_v0; *(bf16x8*)(V_lds + (bf) * SHM_V + vst1) = S.st_v1; } while (0)
#define SWRITE_H(bf) do { SWRITE_HV(bf); SWRITE_HK(bf); } while (0)
#define SLOAD_F(p, k0) do { S.sf0 = *(const f32x4*)ROW(p, k0, sr); S.sf1 = *(const f32x4*)(ROW(p, k0, sr) + 4);                \
                            S.sf2 = *(const f32x4*)ROW(p, k0, 32 + sr); S.sf3 = *(const f32x4*)(ROW(p, k0, 32 + sr) + 4); } while (0)
#define SWRITE_KF(bf) do { *(bf16x8*)(K_lds + (bf) * SHM_K + kws) = pack8(S.sf0, S.sf1); *(bf16x8*)(K_lds + (bf) * SHM_K + kws + 32 * 256) = pack8(S.sf2, S.sf3); } while (0)
#define SWRITE_VF(bf) do { *(bf16x8*)(V_lds + (bf) * SHM_V + vst0) = pack8(S.sf0, S.sf1); *(bf16x8*)(V_lds + (bf) * SHM_V + vst1) = pack8(S.sf2, S.sf3); } while (0)
template <class TIn, class TOut>
__device__ __forceinline__ void causal_swa_prime(const BlockRef<TIn, TOut>& cur, int W, char* lds, Seam<TIn>& S, int tid_in) {
    constexpr bool F32 = same_t<TIn, float>::v;
    int tid_ = tid_in; asm volatile("" : "+v"(tid_));
    const int tid = tid_, wid = __builtin_amdgcn_readfirstlane(tid >> 6), lane = tid & 63, r32 = lane & 31, hi = lane >> 5;
    const int sr = tid >> 4, sc = (tid & 15) * 8, kws = KSWZ(sr, sc * 2); char* K_lds = lds + 2 * SHM_V;
    const int kb0 = swa_jlo(cur.P0, W) * KVBLK;
    for (int d0 = 0; d0 < 8; ++d0) S.qr[d0] = load8<TIn>(cur.Q + (size_t)(wid * QBLK + r32) * QP + d0 * 16 + hi * 8);
    if constexpr (F32) { SLOAD_F((const float*)cur.K, kb0); VMW(); SWRITE_KF(0); SBAR(); SLOAD_F((const float*)cur.V, kb0); }
    else { SLOAD_H(cur.K, cur.V, kb0); VMW(); SWRITE_HK(0); }
    __syncthreads();
}
template <class TIn, class TOut>
__device__ __forceinline__ void causal_swa_block(const BlockRef<TIn, TOut>& cur, const BlockRef<TIn, TOut>& nxt, int skv, int W, char* lds, Seam<TIn>& S, int tid_in) {
    constexpr bool F32 = same_t<TIn, float>::v;
    int tid_ = tid_in; asm volatile("" : "+v"(tid_));
    const int tid = tid_, wid = __builtin_amdgcn_readfirstlane(tid >> 6), lane = tid & 63, r32 = lane & 31, hi = lane >> 5;
    const int j_lo = swa_jlo(cur.P0, W);
    int j_hi = (cur.P0 + QB - 1) / KVBLK + 1; if (j_hi > skv / KVBLK) j_hi = skv / KVBLK;
    const int NT = j_hi - j_lo;
    const int kbn = swa_jlo(nxt.P0, W) * KVBLK;
    const int qlo = cur.P0 + wid * QBLK, qm = qlo + r32 - 4 * hi;
    char* V_lds = lds; char* K_lds = lds + 2 * SHM_V;
    float* ws = (float*)(lds + 2 * SHM_V + 2 * SHM_K) + wid * 64; float* li_l = ws, * al_l = ws + 32;
    float m_reg = -1e30f, l_reg = 0; f32x16 o[4] = {};
    const int sr = tid >> 4, sc = (tid & 15) * 8, vst0 = v_st(sr, sc), vst1 = v_st(32 + sr, sc), kws = KSWZ(sr, sc * 2);
    const int vb0 = (int)(uintptr_t)V_lds + v_rd_base(lane);
    const TIn* Kh = cur.K; const TIn* Vh = cur.V;
#define RESC(a) do { if (__any((a) < 1.f)) { if (hi == 0) al_l[r32] = (a); asm volatile("s_waitcnt lgkmcnt(0)" ::: "memory");              \
                     for (int d_ = 0; d_ < 4; ++d_) for (int r = 0; r < 16; ++r) o[d_][r] *= al_l[crow(r, hi)]; } } while (0)
#define KBASE(t) ((j_lo + (t)) * KVBLK)
#define ACT(t) (KBASE(t) <= qlo + QBLK - 1 && KBASE(t) + KVBLK - 1 >= qlo - W + 1)
#define MASKT(P0_, P1_, t) do { const int kb_ = KBASE(t); if ((!SK || ACT(t)) && (kb_ + KVBLK - 1 > qlo || kb_ <= qlo + QBLK - 1 - W)) mask_tile(P0_, P1_, qm - kb_, (unsigned)W); } while (0)
    constexpr int NQL = F32 ? 16 : 8;
    constexpr bool SK = WSKIP && !F32;
#define SEAM_K0() do { VMWN(NQL); if constexpr (F32) { SWRITE_KF(0); SBAR(); SLOAD_F((const float*)nxt.V, kbn); } else { SWRITE_HK(0); } SBAR(); } while (0)
    f32x16 pA0, pA1, pB0, pB1; float mnA, mnB, alA, alB; bf16x8 pa0, pa1, pa2, pa3;
    if constexpr (F32) { VMW(); SWRITE_VF(0); SBAR(); } else { SWRITE_HV(0); SBAR(); }
    if (NT > 1) { if constexpr (F32) SLOAD_F((const float*)Kh, KBASE(1)); else SLOAD_H(Kh, Vh, KBASE(1)); }
    SBAR(); qkt<0, SK>(pA0, pA1, K_lds, r32, hi, S.qr, ACT(0));
    if constexpr (F32) { if (NT > 1) { VMW(); SWRITE_KF(1); SBAR(); SLOAD_F((const float*)Vh, KBASE(1)); } }
    MASKT(pA0, pA1, 0); partialSM(pA0, pA1, m_reg, mnA, alA);
    if (NT > 1) { VMW(); if constexpr (F32) { SWRITE_VF(1); SBAR(); if (NT > 2) SLOAD_F((const float*)Kh, KBASE(2)); } else SWRITE_H(1); }
    __syncthreads();
#define HALF_STEP(PX0, PX1, mnX, alX, PY0, PY1, alY, t, KB, VB, SB) do {                                                      \
        SBAR(); qkt<KB, SK>(PX0, PX1, K_lds, r32, hi, S.qr, ACT(t));                                             \
        finishSM(PY0, PY1, alY, l_reg, pa0, pa1, pa2, pa3); SBAR();                                                           \
        if ((t) + 1 < NT) { if constexpr (F32) { VMW(); SWRITE_KF(SB); SBAR(); SLOAD_F((const float*)Vh, KBASE((t) + 1)); }  \
                            else { SLOAD_H(Kh, Vh, KBASE((t) + 1)); } SBAR(); }                                               \
        pv_tile<VB, SK>(o, vb0, pa0, pa1, pa2, pa3, ACT((t) - 1)); MASKT(PX0, PX1, (t)); partialSM(PX0, PX1, m_reg, mnX, alX);                                        \
        __syncthreads();                                                                                                      \
        if ((t) + 1 < NT) { VMW(); if constexpr (F32) { SWRITE_VF(SB); SBAR(); if ((t) + 2 < NT) SLOAD_F((const float*)Kh, KBASE((t) + 2)); } \
                            else { SWRITE_H(SB); } }                                                                          \
        RESC(alX); __syncthreads(); } while (0)
    for (int t = 1; t + 1 < NT; t += 2) {
        HALF_STEP(pB0, pB1, mnB, alB, pA0, pA1, alA, t, 1, 0, 0);
        HALF_STEP(pA0, pA1, mnA, alA, pB0, pB1, alB, t + 1, 0, 1, 1);
    }
    const bool even = (NT & 1) == 0;
    if (even) { SBAR(); qkt<1, SK>(pB0, pB1, K_lds, r32, hi, S.qr, ACT(NT - 1)); SBAR(); }
#define QROW(e) (nxt.Q + (size_t)(wid * QBLK + r32) * QP + ((e) >> 1) * 16 + hi * 8 + ((e) & 1) * 4)
    if constexpr (F32) { SLOAD_F((const float*)nxt.K, kbn); SBAR();
#pragma unroll
        for (int e = 0; e < 8; ++e) S.tq[e] = *(const f32x4*)QROW(e); }
    else { SLOAD_H(nxt.K, nxt.V, kbn); SBAR();
#pragma unroll
        for (int d0 = 0; d0 < 8; ++d0) S.qr[d0] = load8<TIn>(nxt.Q + (size_t)(wid * QBLK + r32) * QP + d0 * 16 + hi * 8); }
    SBAR();
    finishSM(pA0, pA1, alA, l_reg, pa0, pa1, pa2, pa3); SBAR();
    if constexpr (F32) {
#pragma unroll
        for (int e = 8; e < 16; ++e) S.tq[e] = *(const f32x4*)QROW(e); SBAR(); }
#undef QROW
    pv_tile<0, SK>(o, vb0, pa0, pa1, pa2, pa3, ACT(even ? NT - 2 : NT - 1));
    if (even) { MASKT(pB0, pB1, NT - 1); partialSM(pB0, pB1, m_reg, mnB, alB); __syncthreads(); RESC(alB);
        finishSM(pB0, pB1, alB, l_reg, pa0, pa1, pa2, pa3); SBAR(); pv_tile<1, SK>(o, vb0, pa0, pa1, pa2, pa3, ACT(NT - 1)); }
    SBAR(); SEAM_K0();
    if (hi == 0) li_l[r32] = l_reg; asm volatile("s_waitcnt lgkmcnt(0)" ::: "memory");
    float rli[16];
#pragma unroll
    for (int r = 0; r < 16; ++r) rli[r] = __builtin_amdgcn_rcpf(li_l[crow(r, hi)]);
    TOut* Ow = cur.O + (size_t)(wid * QBLK) * OP;
#pragma unroll
    for (int r = 0; r < 16; ++r) { const int orow = crow(r, hi);
#pragma unroll
        for (int d0 = 0; d0 < 4; ++d0) { const float v = o[d0][r] * rli[r];
            if constexpr (same_t<TOut, float>::v) { Ow[(size_t)orow * OP + d0 * 32 + r32] = v; }
            else { const float vn = __shfl_xor(v, 1);
                   if ((r32 & 1) == 0) *(unsigned*)(Ow + (size_t)orow * OP + d0 * 32 + r32) = cvtpk(v, vn); } } }
    if constexpr (F32) {
#pragma unroll
        for (int d0 = 0; d0 < 8; ++d0) S.qr[d0] = pack8(S.tq[2 * d0], S.tq[2 * d0 + 1]); }
    __syncthreads();
#undef RESC
#undef KBASE
#undef ACT
#undef MASKT
#undef SEAM_K0
#undef HALF_STEP
}
#undef ROW
#undef VMW
#undef VMWN
#undef SLOAD_H
#undef SWRITE_HK
#undef SWRITE_HV
#undef SWRITE_H
#undef SLOAD_F
#undef SWRITE_KF
#undef SWRITE_VF


}
namespace dattn {
template <bool MASK> __device__ __forceinline__ void sb_half(f32x16& p, float& Px, float R, int dq, int hi) {
    float om[16];
#pragma unroll
    for (int r = 0; r < 16; ++r) {
        const int c = (r & 3) + 8 * (r >> 2);
        float z = p[r]; if (MASK) z = (c < dq) ? z : -__builtin_inff();
        const float e = __builtin_amdgcn_exp2f(-z), b = __builtin_amdgcn_rcpf(1.0f + e); om[r] = 1.0f - b; p[r] = b;
    }
    float E[4];
#pragma unroll
    for (int g = 3; g >= 0; --g) {
        const float s0 = (om[4 * g] * om[4 * g + 1]) * (om[4 * g + 2] * om[4 * g + 3]);
        auto rr = __builtin_amdgcn_permlane32_swap(__float_as_uint(s0), __float_as_uint(s0), false, false);
        const float ga = __uint_as_float(rr[0]), gb = __uint_as_float(rr[1]);
        E[g] = (hi ? Px : Px * gb) * R; Px *= ga * gb;
    }
#pragma unroll
    for (int g = 0; g < 4; ++g) {
        const float c3 = E[g], c2 = c3 * om[4 * g + 3], c1 = c2 * om[4 * g + 2], c0 = c1 * om[4 * g + 1];
        p[4 * g + 3] *= c3; p[4 * g + 2] *= c2; p[4 * g + 1] *= c1; p[4 * g] *= c0;
    }
}
template <int OPB> __device__ __forceinline__ void sb_unit(const bf16* Qh, const bf16* Kh, const bf16* Vh, bf16* Oh, int P0, float EXIT, char* lds, int tid_in) {
    int tid_ = tid_in; asm volatile("" : "+v"(tid_));
    const int tid = tid_, wid = __builtin_amdgcn_readfirstlane(tid >> 6), lane = tid & 63, r32 = lane & 31, hi = lane >> 5;
    char* V_lds = lds; char* K_lds = lds + 2 * SHM_V; unsigned* flags = (unsigned*)(lds + 2 * SHM_V + 2 * SHM_K);
    const int sr = tid >> 4, sc = (tid & 15) * 8, vst0 = v_st(sr, sc), vst1 = v_st(32 + sr, sc), kws = KSWZ(sr, sc * 2);
    const int vb0 = (int)(uintptr_t)V_lds + v_rd_base(lane);
    const int qlo = P0 + wid * QBLK, qpos = qlo + r32;
    bf16x8 qr[8];
#pragma unroll
    for (int d0 = 0; d0 < 8; ++d0) qr[d0] = load8<bf16>(Qh + (size_t)qpos * KVP + d0 * 16 + hi * 8);
    const int NT = (P0 + QB) / KVBLK;
    bf16x8 st_k0, st_k1, st_v0, st_v1;
#define SB_LOAD(t) do { const size_t r0_ = (size_t)((t) * KVBLK + sr) * KVP + sc, r1_ = r0_ + (size_t)32 * KVP; \
        st_v0 = load8<bf16>(Vh + r0_); st_v1 = load8<bf16>(Vh + r1_); st_k0 = load8<bf16>(Kh + r0_); st_k1 = load8<bf16>(Kh + r1_); } while (0)
    SB_LOAD(NT - 1);
    float R = 1.0f; f32x16 o[4] = {}; bool done = false;
    for (int t = NT - 1; t >= 0; --t) {
        asm volatile("s_waitcnt vmcnt(0)" ::: "memory");
        *(bf16x8*)(V_lds + vst0) = st_v0; *(bf16x8*)(V_lds + vst1) = st_v1; *(bf16x8*)(K_lds + kws) = st_k0; *(bf16x8*)(K_lds + kws + 32 * 256) = st_k1;
        __syncthreads();
        if (t > 0) SB_LOAD(t - 1);
        const int kb = t * KVBLK;
        if (!done && kb <= qlo + QBLK - 2) {
            f32x16 p0, p1; bf16x8 pa0, pa1, pa2, pa3;
            SBAR(); qkt<0, false>(p0, p1, K_lds, r32, hi, qr, true); SBAR();
            float Px = 1.0f;
            sb_half<true>(p1, Px, R, qpos - kb - 4 * hi - 32, hi); SBAR(); sb_half<true>(p0, Px, R, qpos - kb - 4 * hi, hi);
            R *= Px;
#define PK4(P, B_, OUT) do { unsigned a0 = cvtpk(P[B_+0], P[B_+1]), a1 = cvtpk(P[B_+2], P[B_+3]);                          \
        unsigned b0 = cvtpk(P[B_+4], P[B_+5]), b1 = cvtpk(P[B_+6], P[B_+7]);                                             \
        auto r0 = __builtin_amdgcn_permlane32_swap(a0, b0, false, false); auto r1 = __builtin_amdgcn_permlane32_swap(a1, b1, false, false); \
        u32x4 w = {r0[0], r1[0], r0[1], r1[1]}; OUT = *reinterpret_cast<bf16x8*>(&w); } while (0)
            PK4(p0, 0, pa0); PK4(p0, 8, pa1); PK4(p1, 0, pa2); PK4(p1, 8, pa3);
#undef PK4
            SBAR(); pv_tile<0, false>(o, vb0, pa0, pa1, pa2, pa3, true);
            done = __all(R < EXIT);
        }
        if (lane == 0) flags[wid] = done ? 1u : 0u;
        __syncthreads();
        const u32x4 f0 = *(const u32x4*)flags, f1 = *(const u32x4*)(flags + 4);
        if ((f0.x & f0.y & f0.z & f0.w & f1.x & f1.y & f1.z & f1.w) != 0u) break;
    }
#undef SB_LOAD
    bf16* Ow = Oh + (size_t)qlo * OPB;
#pragma unroll
    for (int r = 0; r < 16; ++r) { const int orow = crow(r, hi);
#pragma unroll
        for (int d0 = 0; d0 < 4; ++d0) { const float v = o[d0][r]; const float vn = __int_as_float(__builtin_amdgcn_ds_swizzle(__float_as_int(v), 0x041F));
            if ((r32 & 1) == 0) *(unsigned*)(Ow + (size_t)orow * OPB + d0 * 32 + r32) = cvtpk(v, vn); } }
    __syncthreads();
}
}
constexpr int NWAVES = 8;
constexpr int BATCH = 2, SEQ = 4096, DM = 2048, FF = 5632, DIN = 6144, DEPTH = 4, HD = 128;
constexpr int M = BATCH * SEQ;
constexpr float RMS_EPS = 1e-6f;
constexpr float QK_C2 = 0.08838834764831845f * 1.4426950408889634f;
constexpr float SB_EXIT = 7.52316385e-37f;
constexpr size_t MiB = 1u << 20;
constexpr size_t WS_CTL = 0, CTL_ZERO_BYTES = 1 * MiB;
constexpr size_t WS_ROPE = 1 * MiB;
constexpr size_t WS_SSQ = 3 * MiB;
constexpr size_t WS_X = 4 * MiB;
constexpr size_t WS_XB = 68 * MiB;
constexpr size_t WS_H = 100 * MiB;
constexpr size_t WS_QKV = 188 * MiB;
constexpr size_t WS_MIX = 284 * MiB;
constexpr size_t WS_OD = 316 * MiB;
constexpr size_t WS_W = 380 * MiB;
constexpr size_t W_GU = (size_t)2 * FF * DM * 2, W_D = (size_t)DM * FF * 2, W_IN = (size_t)DIN * DM * 2, W_OUT = (size_t)DM * DM * 2;
constexpr size_t WO_GU1 = 0, WO_D1 = W_GU, WO_IN = WO_D1 + W_D, WO_OUT = WO_IN + W_IN, WO_GU2 = WO_OUT + W_OUT, WO_D2 = WO_GU2 + W_GU, W_LAYER = WO_D2 + W_D;
constexpr size_t WS_END = WS_W + DEPTH * W_LAYER;
static_assert(W_LAYER == 164 * MiB, "weights per layer");
constexpr int CW_TMO = 0, CW_CODE = 1, CW_BAR = 4096;
constexpr int CW_DCNT = 65536;
static_assert((CW_DCNT + 64 * (DEPTH * 8 * 16)) * 4 <= (int)CTL_ZERO_BYTES, "counters inside the per-call memset");
constexpr int RING_OFF = 0, RING_BYTES = 135168;
constexpr int LDSCTL_OFF = RING_BYTES, MISC_OFF = LDSCTL_OFF + 320;
constexpr int LDS_BYTES = 147456;
static_assert(MISC_OFF + 128 <= LDS_BYTES && 8 * 16640 <= RING_BYTES, "LDS map");

#define GAS __attribute__((address_space(1)))
#define LAS __attribute__((address_space(3)))
typedef unsigned short bf16;
typedef unsigned v4u __attribute__((ext_vector_type(4)));
typedef float f32x4 __attribute__((ext_vector_type(4)));
typedef short bf16x8 __attribute__((ext_vector_type(8)));
typedef GAS unsigned gu32;
typedef GAS unsigned long long gu64;
#define RLX_AGENT __ATOMIC_RELAXED, __HIP_MEMORY_SCOPE_AGENT
#define LDS_WAIT() asm volatile("s_waitcnt lgkmcnt(0)" ::: "memory")
#define VM_WAIT() asm volatile("s_waitcnt vmcnt(0)" ::: "memory")
__device__ __forceinline__ unsigned long long rt() { return __builtin_amdgcn_s_memrealtime(); }
#define XB_TMO      128
#define XB_XCNT(j)  (256  + 64 * (j))
#define XB_XSUB(j)  (1280 + 64 * (j))
#define XB_XGEN(j)  (2304 + 64 * (j))
#define XB_TOP      3328
#define XB_TOPGEN   3392
#define XCD_BAR_WORDS 3456
#define XB_SPIN_CAP (1u << 18)

__device__ __forceinline__ unsigned xb_ld(unsigned* p)              { return __hip_atomic_load(p, __ATOMIC_RELAXED, __HIP_MEMORY_SCOPE_AGENT); }
__device__ __forceinline__ unsigned xb_add(unsigned* p, unsigned v) { return __hip_atomic_fetch_add(p, v, __ATOMIC_RELAXED, __HIP_MEMORY_SCOPE_AGENT); }
__device__ __forceinline__ unsigned xb_xcc_id() { return (unsigned)__builtin_amdgcn_s_getreg((3 << 11) | 20) & 0xFu; }
#define XB_SPIN(cond, bar) do { unsigned _sp = 0; while (cond) { __builtin_amdgcn_s_sleep(1); \
    if ((++_sp & 255u) == 0u) { if (xb_ld(&(bar)[XB_TMO])) break; if (_sp > XB_SPIN_CAP) { atomicAdd(&(bar)[XB_TMO], 1u); break; } } } } while (0)

struct XcdBarrier {
    unsigned* bar; unsigned x;
    volatile LAS unsigned* st;
};

__device__ __forceinline__ XcdBarrier xcd_barrier_post(unsigned* bar, volatile LAS unsigned* st) {
    XcdBarrier b; b.bar = bar; b.x = xb_xcc_id(); b.st = st;
    if (threadIdx.x == 0) (void)xb_add(&bar[XB_XCNT(b.x)], 1u);
    return b;
}
__device__ __forceinline__ void xcd_barrier_complete(unsigned* bar, unsigned x, unsigned& nloc, unsigned& nx) {
    const unsigned G = gridDim.x * gridDim.y * gridDim.z;
    unsigned sum, cnt, mine, sp = 0u;
    for (;;) {
        sum = 0u; cnt = 0u; mine = 0u;
#pragma unroll
        for (unsigned j = 0; j < 16; ++j) { const unsigned c = xb_ld(&bar[XB_XCNT(j)]); sum += c; cnt += (c > 0u) ? 1u : 0u; mine = (j == x) ? c : mine; }
        if (sum == G) break;
        __builtin_amdgcn_s_sleep(1);
        if ((++sp & 255u) == 0u) { if (xb_ld(&bar[XB_TMO])) break; if (sp > XB_SPIN_CAP) { atomicAdd(&bar[XB_TMO], 1u); break; } }
    }
    nloc = mine > 0u ? mine : 1u; nx = cnt > 0u ? cnt : 1u;
}

__device__ __forceinline__ void xcd_barrier(const XcdBarrier& b) {
    asm volatile("s_waitcnt vmcnt(0)" ::: "memory");
    __syncthreads();
    if (threadIdx.x == 0) {
        unsigned* bar = b.bar;
        __builtin_amdgcn_s_waitcnt(0);
        unsigned nloc = b.st[0], nx = b.st[1];
        if (nloc == 0u) { xcd_barrier_complete(bar, b.x, nloc, nx); b.st[0] = nloc; b.st[1] = nx; }
        const unsigned old = xb_add(&bar[XB_XSUB(b.x)], 1u);
        const unsigned gen = old / nloc;
        if (old + 1u == (gen + 1u) * nloc) {
            __builtin_amdgcn_fence(__ATOMIC_RELEASE, "agent");
            asm volatile("s_waitcnt vmcnt(0)" ::: "memory");
            const unsigned og = xb_add(&bar[XB_TOP], 1u);
            const unsigned tg = og / nx;
            if (og + 1u == (tg + 1u) * nx) xb_add(&bar[XB_TOPGEN], 1u);
            else XB_SPIN(xb_ld(&bar[XB_TOPGEN]) == tg, bar);
            __builtin_amdgcn_fence(__ATOMIC_ACQUIRE, "agent");
            xb_add(&bar[XB_XGEN(b.x)], 1u);
            asm volatile("s_waitcnt vmcnt(0)" ::: "memory");
        } else {
            XB_SPIN(xb_ld(&bar[XB_XGEN(b.x)]) == gen, bar);
            __builtin_amdgcn_fence(__ATOMIC_ACQUIRE, "agent");
            asm volatile("s_waitcnt vmcnt(0)" ::: "memory");
        }
    }
    __syncthreads();
}

__device__ __forceinline__ float wave_sum(float v) { return pg8::wave_sum_nolane(v); }
__device__ __forceinline__ unsigned pk2(float lo, float hi) { return pg8::cvt_pk_bf16(lo, hi); }
__device__ __forceinline__ int w_rowmap(int mode, int n) {
    if (mode == 0) return n;
    if (mode == 3) { const int l = n & 255, g = l >> 7, bj = (l >> 6) & 1, i = l & 63; return (n & ~255) + 128 * bj + 64 * g + i; }
    return ((n >> 7) << 8) + (n & 127) + (mode == 2 ? 128 : 0);
}
__device__ __forceinline__ void p0_item(const float* W, int K, int N, const float* gain, bf16* dst, int mode, LAS float* scr, int item, int lane) {
    const int nblk = N / 64, kb = item / nblk, nb = item % nblk, k0 = 64 * kb, n0 = 64 * nb;
    const int kk = lane >> 4, nn = 4 * (lane & 15);
    f32x4 v[16]; float g[16];
#pragma unroll
    for (int i = 0; i < 16; ++i) { const int k = 4 * i + kk; v[i] = __builtin_nontemporal_load((const GAS f32x4*)(W + (size_t)(k0 + k) * N + n0 + nn));     g[i] = gain ? gain[k0 + k] : 1.0f; }
#pragma unroll
    for (int i = 0; i < 16; ++i) { const int k = 4 * i + kk; LAS float* s = scr + k * 65 + nn; s[0] = v[i][0] * g[i]; s[1] = v[i][1] * g[i]; s[2] = v[i][2] * g[i]; s[3] = v[i][3] * g[i]; }
    LDS_WAIT(); asm volatile("" ::: "memory");
    const int c = lane & 7;
#pragma unroll
    for (int j = 0; j < 8; ++j) { const int n = (lane >> 3) + 8 * j; const LAS float* s = scr + (8 * c) * 65 + n;
        v4u o; o.x = pk2(s[0 * 65], s[1 * 65]); o.y = pk2(s[2 * 65], s[3 * 65]); o.z = pk2(s[4 * 65], s[5 * 65]); o.w = pk2(s[6 * 65], s[7 * 65]);
        __builtin_nontemporal_store(o, (GAS v4u*)(dst + (size_t)w_rowmap(mode, n0 + n) * K + k0 + 8 * c)); }
    LDS_WAIT(); asm volatile("" ::: "memory");
}
__device__ __forceinline__ void rope_entry(int pos, int i, float& c, float& s) {
    const double R1 = 0.86596432336006535, R2 = R1 * R1, R4 = R2 * R2, R8 = R4 * R4, R16 = R8 * R8, R32 = R16 * R16;
    double f = 1.0; if (i & 1) f *= R1; if (i & 2) f *= R2; if (i & 4) f *= R4; if (i & 8) f *= R8; if (i & 16) f *= R16; if (i & 32) f *= R32;
    const float ff = (float)f;
    const float angf = (float)pos * ff;
    const double ang = (double)angf;
    const double TWO_PI_HI = 6.283185307179586, TWO_PI_LO = 2.4492935982947064e-16, INV_2PI = 0.15915494309189535;
    const double n = __builtin_rint(ang * INV_2PI);
    double r = __builtin_fma(-n, TWO_PI_HI, ang); r = __builtin_fma(-n, TWO_PI_LO, r);
    const double r2 = r * r;
    double sc = 1.0, ss = 1.0;
#pragma unroll
    for (int k = 15; k >= 1; --k) { sc = 1.0 - sc * r2 / (double)((2 * k - 1) * (2 * k)); ss = 1.0 - ss * r2 / (double)((2 * k) * (2 * k + 1)); }
    c = (float)sc; s = (float)(ss * r);
}

struct Args { const float* in[18]; float* out; unsigned char* ws; float linit[4]; int ph_lo, ph_hi; };
enum { I_X = 0, I_NF1, I_G1, I_U1, I_D1, I_NMIX, I_WIN, I_LQ1, I_LK1, I_LQ2, I_LK2, I_SUBLN, I_WOUT, I_NF2, I_G2, I_U2, I_D2, I_NFIN };

struct Ctx { int tid, lane, wave, bx, G, gw, NGW; unsigned char* ws; gu32* ctl; float* ROPE; float* SSQ; unsigned char* XL; bf16* XB; bf16* H; bf16* QKV; bf16* MIX; float* OD; };
__device__ __forceinline__ Ctx make_ctx(unsigned char* ws_in, int wave_s) {
    Ctx c; unsigned z0; asm volatile("v_mov_b32 %0, 0" : "=v"(z0)); int t = wave_s * 64 + (int)__builtin_amdgcn_mbcnt_hi(~0u, __builtin_amdgcn_mbcnt_lo(~0u, z0));     int b = blockIdx.x; asm volatile("" : "+s"(b)); unsigned char* ws = ws_in; asm volatile("" : "+s"(ws));
    c.tid = t; c.lane = t & 63; c.wave = __builtin_amdgcn_readfirstlane(t >> 6); c.bx = b; c.G = gridDim.x;
    const int vcu = (c.G % 8 == 0) ? (b % 8) * (c.G / 8) + b / 8 : b; c.gw = vcu * NWAVES + c.wave; c.NGW = c.G * NWAVES;
    c.ws = ws; c.ctl = (gu32*)(ws + WS_CTL); c.ROPE = (float*)(ws + WS_ROPE); c.SSQ = (float*)(ws + WS_SSQ); c.XL = ws + WS_X; c.XB = (bf16*)(ws + WS_XB); c.H = (bf16*)(ws + WS_H);
    c.QKV = (bf16*)(ws + WS_QKV); c.MIX = (bf16*)(ws + WS_MIX); c.OD = (float*)(ws + WS_OD);
    return c;
}
__device__ __forceinline__ int opaque_s(int x) { asm volatile("" : "+s"(x)); return x; }
#define INP(i) (args.in[opaque_s(i)])
constexpr int CV_GU = (DM / 64) * (FF / 64), CV_DN = (FF / 64) * (DM / 64), CV_IN = (DM / 64) * (DIN / 64), CV_OUT = (DM / 64) * (DM / 64);
constexpr int CV_LAYER = 4 * CV_GU + 2 * CV_DN + CV_IN + CV_OUT;
constexpr int CV_PRO = 2 * CV_GU + CV_DN;
constexpr int CV_T0 = CV_PRO + CV_IN + CV_OUT + 2 * CV_GU;
#define CONVERT_RANGE(id_lo, id_hi, widx, nw, wsb, scr, lane) do { \
    for (int it_ = (id_lo) + (widx); it_ < (id_hi); it_ += (nw)) { \
        const int layer_ = it_ / CV_LAYER; int r_ = it_ % CV_LAYER; \
        unsigned char* wl_ = (wsb) + WS_W + (size_t)layer_ * W_LAYER; \
        const float* src_; const float* gain_ = nullptr; int K_ = DM, N_ = FF, mode_; size_t wo_; \
        if (r_ < CV_GU) { src_ = INP(I_G1) + (size_t)layer_ * DM * FF; gain_ = INP(I_NF1) + layer_ * DM; mode_ = 1; wo_ = WO_GU1; } \
        else if ((r_ -= CV_GU) < CV_GU) { src_ = INP(I_U1) + (size_t)layer_ * DM * FF; gain_ = INP(I_NF1) + layer_ * DM; mode_ = 2; wo_ = WO_GU1; } \
        else if ((r_ -= CV_GU) < CV_DN) { src_ = INP(I_D1) + (size_t)layer_ * DM * FF; mode_ = 0; wo_ = WO_D1; K_ = FF; N_ = DM; } \
        else if ((r_ -= CV_DN) < CV_IN) { src_ = INP(I_WIN) + (size_t)layer_ * DM * DIN; gain_ = INP(I_NMIX) + layer_ * DM; mode_ = 3; wo_ = WO_IN; N_ = DIN; } \
        else if ((r_ -= CV_IN) < CV_OUT) { src_ = INP(I_WOUT) + (size_t)layer_ * DM * DM; mode_ = 0; wo_ = WO_OUT; N_ = DM; } \
        else if ((r_ -= CV_OUT) < CV_GU) { src_ = INP(I_G2) + (size_t)layer_ * DM * FF; gain_ = INP(I_NF2) + layer_ * DM; mode_ = 1; wo_ = WO_GU2; } \
        else if ((r_ -= CV_GU) < CV_GU) { src_ = INP(I_U2) + (size_t)layer_ * DM * FF; gain_ = INP(I_NF2) + layer_ * DM; mode_ = 2; wo_ = WO_GU2; } \
        else { r_ -= CV_GU; src_ = INP(I_D2) + (size_t)layer_ * DM * FF; mode_ = 0; wo_ = WO_D2; K_ = FF; N_ = DM; } \
        p0_item(src_, K_, N_, gain_, (bf16*)(wl_ + wo_), mode_, scr, r_, lane); \
    } } while (0)

__global__ void __launch_bounds__(NWAVES * 64, 2) mk_fwd(Args args) {
    extern __shared__ __attribute__((aligned(16))) unsigned char lds[];
    LAS unsigned char* L = (LAS unsigned char*)lds;
    volatile LAS unsigned* MISC = (volatile LAS unsigned*)(L + MISC_OFF);
    for (int u = threadIdx.x; u < (LDS_BYTES - LDSCTL_OFF) / 4; u += NWAVES * 64) ((LAS unsigned*)(L + LDSCTL_OFF))[u] = 0u;
    __syncthreads();
    const int wave_s = __builtin_amdgcn_readfirstlane(threadIdx.x >> 6);
    XcdBarrier bar = xcd_barrier_post((unsigned*)(args.ws + WS_CTL) + CW_BAR, MISC + 8);
    const int lo = args.ph_lo, hi = args.ph_hi; int pc = 0;
#define PH_ON() (lo <= pc && pc < hi)
#define PH_END() do { if (lo <= pc && pc + 1 < hi) xcd_barrier(bar); ++pc; } while (0)

    if (PH_ON()) {
        const Ctx c = make_ctx(args.ws, wave_s); const int lane = c.lane, gw = c.gw, NGW = c.NGW;
        LAS float* scr = (LAS float*)(L + RING_OFF + c.wave * 16640);
        CONVERT_RANGE(0, CV_PRO, gw, NGW, c.ws, scr, lane);
        for (int e = c.bx * (NWAVES * 64) + c.tid; e < SEQ * 64; e += c.G * NWAVES * 64) { float cs, sn; rope_entry(e >> 6, e & 63, cs, sn); c.ROPE[e] = cs; c.ROPE[SEQ * 64 + e] = sn; }
        const float* xin = INP(I_X);
        for (int m = gw; m < M; m += NGW) {
            const GAS f32x4* xr = (const GAS f32x4*)(xin + (size_t)m * DM) + lane; GAS unsigned long long* o8 = (GAS unsigned long long*)(c.XB + (size_t)m * DM) + lane;
            GAS unsigned* l4 = (GAS unsigned*)(c.XL + (size_t)m * DM) + lane; float s = 0.f;
#pragma unroll
            for (int j = 0; j < 8; ++j) { const f32x4 v = xr[64 * j]; const unsigned w0 = pk2(v[0], v[1]), w1 = pk2(v[2], v[3]);
                const float d0 = pg8::lo_clamp(v[0] - __uint_as_float(w0 << 16)), d1 = pg8::lo_clamp(v[1] - __uint_as_float(w0 & 0xffff0000u)), d2 = pg8::lo_clamp(v[2] - __uint_as_float(w1 << 16)), d3 = pg8::lo_clamp(v[3] - __uint_as_float(w1 & 0xffff0000u));
                s += (v[0] * v[0] + v[1] * v[1]) + (v[2] * v[2] + v[3] * v[3]);
                o8[64 * j] = (unsigned long long)w0 | ((unsigned long long)w1 << 32);
                int wl = __builtin_amdgcn_cvt_pk_fp8_f32(d0, d1, 0, false); wl = __builtin_amdgcn_cvt_pk_fp8_f32(d2, d3, wl, true); l4[64 * j] = (unsigned)wl; }
            s = wave_sum(s);
            if (lane < 8) c.SSQ[(size_t)m * 8 + lane] = (lane == 0) ? s : 0.f;
        }
    }
    PH_END();

    for (int step = 0; step < 2 * DEPTH; ++step) {
        const int layer = step >> 1, half = step & 1;
        if (PH_ON()) {
            const Ctx c = make_ctx(args.ws, wave_s); unsigned char* wl = c.ws + WS_W + (size_t)layer * W_LAYER;
            pg8::Gemm g{c.XB, (const bf16*)(wl + (half ? WO_GU2 : WO_GU1)), M, 2 * FF, DM}; pg8::StaticOrder S; S.init(M, 2 * FF, c.G, c.bx);
            pg8::EpiSwiGLU E{c.H, c.SSQ};
            if (c.bx >= 128) {
                const int lo_ = layer * CV_LAYER + (half ? CV_T0 : CV_PRO); int hi_ = half ? (layer + 1) * CV_LAYER + CV_PRO : layer * CV_LAYER + CV_T0; if (hi_ > DEPTH * CV_LAYER) hi_ = DEPTH * CV_LAYER;
                LAS float* scr_ = (LAS float*)(L + RING_OFF + c.wave * 16640);
                CONVERT_RANGE(lo_, hi_, (c.bx - 128) * NWAVES + c.wave, 128 * NWAVES, c.ws, scr_, c.lane);
                __syncthreads();
            }
            pg8::gemm_phase<pg8::EpiSwiGLU, pg8::StaticOrder, true, true>(L + RING_OFF, g, S, E, c.tid);
        }
        PH_END();
        if (PH_ON()) {
            const Ctx c = make_ctx(args.ws, wave_s); unsigned char* wl = c.ws + WS_W + (size_t)layer * W_LAYER;
            pg8::Gemm g{c.H, (const bf16*)(wl + (half ? WO_D2 : WO_D1)), M, DM, FF}; pg8::StaticOrder S; S.init(M, DM, c.G, c.bx);
            pg8::EpiResid E{c.XB, c.XL, c.SSQ, 0.5f};
            pg8::gemm_phase<pg8::EpiResid, pg8::StaticOrder, false, true>(L + RING_OFF, g, S, E, c.tid);
        }
        PH_END();
        if (half == 0) {
            if (PH_ON()) {
                const Ctx c = make_ctx(args.ws, wave_s); unsigned char* wl = c.ws + WS_W + (size_t)layer * W_LAYER;
                pg8::Gemm g{c.XB, (const bf16*)(wl + WO_IN), M, DIN, DM}; pg8::StaticOrder S; S.init(M, DIN, c.G, c.bx);
                pg8::EpiQKV E{c.QKV, c.SSQ, c.ROPE, QK_C2};
                pg8::gemm_phase<pg8::EpiQKV, pg8::StaticOrder, true, true>(L + RING_OFF, g, S, E, c.tid);
            }
            PH_END();
            if (PH_ON()) {
                {
                    using namespace dattn;
                    const Ctx c = make_ctx(args.ws, wave_s);
                    const int bh = c.bx & 7, j = c.bx >> 3, br = j >> 4, vh = (j >> 3) & 1, x = j & 7, b = bh >> 2, h = bh & 3;
                    const __hip_bfloat16* Qb = (const __hip_bfloat16*)c.QKV + (size_t)(b * SEQ) * DIN + 3072 + h * 256 + br * 128;
                    const __hip_bfloat16* Kb = (const __hip_bfloat16*)c.QKV + (size_t)(b * SEQ) * DIN + 4096 + h * 256 + br * 128;
                    const __hip_bfloat16* Vb = (const __hip_bfloat16*)c.QKV + (size_t)(b * SEQ) * DIN + 5120 + h * 256 + vh * 128;
                    float* Ob = c.OD + (size_t)br * M * 1024 + (size_t)(b * SEQ) * 1024 + h * 256 + vh * 128;
                    const int qa = x, qb2 = 15 - x;
                    BlockRef<__hip_bfloat16, float> c0{Qb + (size_t)qa * QB * QP, Kb, Vb, Ob + (size_t)qa * QB * OP, qa * QB};
                    BlockRef<__hip_bfloat16, float> c1{Qb + (size_t)qb2 * QB * QP, Kb, Vb, Ob + (size_t)qb2 * QB * OP, qb2 * QB};
                    Seam<__hip_bfloat16> S;
                    __syncthreads();
                    causal_swa_prime<__hip_bfloat16, float>(c0, SEQ, (char*)lds + RING_OFF, S, c.tid);
                    causal_swa_block<__hip_bfloat16, float>(c0, c1, SEQ, SEQ, (char*)lds + RING_OFF, S, c.tid);
                    causal_swa_block<__hip_bfloat16, float>(c1, c1, SEQ, SEQ, (char*)lds + RING_OFF, S, c.tid);
                }
                {
                    const Ctx c = make_ctx(args.ws, wave_s);
                    const int j = c.bx >> 3, bh = ((c.bx & 7) << 1) | (j >> 4), qb = j & 15, b = bh >> 3, h = bh & 7;
                    const __hip_bfloat16* Qh = (const __hip_bfloat16*)c.QKV + (size_t)(b * SEQ) * DIN + h * HD;
                    dattn::sb_unit<DM>(Qh, Qh + 1024, Qh + 2048, (__hip_bfloat16*)c.MIX + (size_t)(b * SEQ) * DM + h * HD, qb * dattn::QB, SB_EXIT, (char*)lds + RING_OFF, c.tid);
                }
            }
            PH_END();
            if (PH_ON()) {
                const Ctx c = make_ctx(args.ws, wave_s); const int lane = c.lane;
                const float linit = args.linit[opaque_s(layer)];
                const float* lq1 = INP(I_LQ1) + layer * HD; const float* lk1 = INP(I_LK1) + layer * HD; const float* lq2 = INP(I_LQ2) + layer * HD; const float* lk2 = INP(I_LK2) + layer * HD;
                const float s1 = wave_sum(lq1[lane] * lk1[lane] + lq1[lane + 64] * lk1[lane + 64]), s2 = wave_sum(lq2[lane] * lk2[lane] + lq2[lane + 64] * lk2[lane + 64]);
                const float lam = expf(s1) - expf(s2) + linit;
                const f32x4 gsub = *(const GAS f32x4*)(INP(I_SUBLN) + layer * 256 + 4 * lane);
                const float* OD = c.OD; bf16* MIX = c.MIX;
                for (int idx = c.gw; idx < M * 4; idx += 4 * c.NGW) {
                    f32x4 o1[4], o2[4];
#pragma unroll
                    for (int q = 0; q < 4; ++q) { const int id = idx + q * c.NGW, row = id >> 2, h = id & 3;
                        o1[q] = *(const GAS f32x4*)(OD + (size_t)row * 1024 + h * 256 + 4 * lane); o2[q] = *(const GAS f32x4*)(OD + (size_t)M * 1024 + (size_t)row * 1024 + h * 256 + 4 * lane); }
#pragma unroll
                    for (int q = 0; q < 4; ++q) { const int id = idx + q * c.NGW, row = id >> 2, h = id & 3;
                        const f32x4 d = o1[q] - o2[q] * lam;
                        const float ss = wave_sum((d[0] * d[0] + d[1] * d[1]) + (d[2] * d[2] + d[3] * d[3]));
                        const float r = (1.0f / sqrtf(ss * (1.0f / 256.0f) + RMS_EPS)) * (1.0f - linit);
                        const f32x4 y = d * gsub * r;
                        *(GAS unsigned long long*)(MIX + (size_t)row * DM + 1024 + h * 256 + 4 * lane) = (unsigned long long)pk2(y[0], y[1]) | ((unsigned long long)pk2(y[2], y[3]) << 32); }
                }
            }
            PH_END();
            if (PH_ON()) {
                const Ctx c = make_ctx(args.ws, wave_s); unsigned char* wl = c.ws + WS_W + (size_t)layer * W_LAYER;
                pg8::Gemm g{c.MIX, (const bf16*)(wl + WO_OUT), M, DM, DM}; pg8::StaticOrder S; S.init(M, DM, c.G, c.bx);
                pg8::EpiResid E{c.XB, c.XL, c.SSQ, 1.0f};
                pg8::gemm_phase<pg8::EpiResid, pg8::StaticOrder, false, true>(L + RING_OFF, g, S, E, c.tid);
            }
            PH_END();
        }
    }
    if (PH_ON()) {
        const Ctx c = make_ctx(args.ws, wave_s); const int lane = c.lane;
        const bool bad = (__hip_atomic_load(c.ctl + CW_BAR + XB_TMO, RLX_AGENT) != 0u);
        const float* gf = INP(I_NFIN); float* out = args.out;
        for (int m = c.gw; m < M; m += c.NGW) {
            const GAS unsigned long long* xr = (const GAS unsigned long long*)(c.XB + (size_t)m * DM) + lane; const GAS unsigned* xl = (const GAS unsigned*)(c.XL + (size_t)m * DM) + lane; GAS f32x4* o = (GAS f32x4*)(out + (size_t)m * DM) + lane; f32x4 v[8]; float s = 0.f;
#pragma unroll
            for (int j = 0; j < 8; ++j) { const unsigned long long w = xr[64 * j]; const int wl = (int)xl[64 * j]; const unsigned w0 = (unsigned)w, w1 = (unsigned)(w >> 32);
                const pg8::f32x2v_ la = __builtin_amdgcn_cvt_pk_f32_fp8(wl, false), lb = __builtin_amdgcn_cvt_pk_f32_fp8(wl, true);
                v[j] = (f32x4){__uint_as_float(w0 << 16) + la.x * pg8::LO_INV, __uint_as_float(w0 & 0xffff0000u) + la.y * pg8::LO_INV,
                               __uint_as_float(w1 << 16) + lb.x * pg8::LO_INV, __uint_as_float(w1 & 0xffff0000u) + lb.y * pg8::LO_INV};
                s += (v[j][0] * v[j][0] + v[j][1] * v[j][1]) + (v[j][2] * v[j][2] + v[j][3] * v[j][3]); }
            float r = 1.0f / sqrtf(wave_sum(s) * (1.0f / DM) + RMS_EPS); if (bad) r = __builtin_nanf("");
#pragma unroll
            for (int j = 0; j < 8; ++j) o[64 * j] = v[j] * *((const GAS f32x4*)gf + lane + 64 * j) * r;
        }
    }
    PH_END();
#undef PH_ON
#undef PH_END
}
constexpr int N_PHASES = 1 + 2 * DEPTH * 2 + DEPTH * 4 + 1;

#ifndef MK_MULTI
#define MK_MULTI 0
#endif
extern "C" void kernel_launch(void* const* d_in, const int* in_sizes, int n_in, void* d_out, int out_size, void* d_ws, size_t ws_size, hipStream_t stream) {
    static int grid = 0;
    if (grid == 0) {
        if (n_in != 18 || in_sizes[0] != M * DM || out_size != M * DM || ws_size < WS_END) { fprintf(stderr, "kernel_launch: shape/workspace mismatch (n_in %d, in0 %d, out %d, ws %zu < %zu)\n", n_in, n_in > 0 ? in_sizes[0] : -1, out_size, ws_size, (size_t)WS_END); grid = -1; return; }
        if (hipFuncSetAttribute((const void*)mk_fwd, hipFuncAttributeMaxDynamicSharedMemorySize, LDS_BYTES) != hipSuccess) { fprintf(stderr, "kernel_launch: hipFuncSetAttribute failed\n"); grid = -1; return; }
        int per_cu = 0;
        if (hipOccupancyMaxActiveBlocksPerMultiprocessor(&per_cu, (const void*)mk_fwd, NWAVES * 64, LDS_BYTES) != hipSuccess || per_cu < 1) fprintf(stderr, "kernel_launch: occupancy query reports %d\n", per_cu);
        (void)hipGetLastError();
        grid = 256;
    }
    if (grid < 0) return;
    (void)hipMemsetAsync((char*)d_ws + WS_CTL, 0, CTL_ZERO_BYTES, stream);
    Args a{};
    for (int i = 0; i < 18; ++i) a.in[i] = (const float*)d_in[i];
    a.out = (float*)d_out; a.ws = (unsigned char*)d_ws;
    for (int l = 0; l < DEPTH; ++l) a.linit[l] = (float)(0.8 - 0.6 * exp(-0.3 * (double)l));
#if MK_MULTI
    for (int p = 0; p < N_PHASES; ++p) { a.ph_lo = p; a.ph_hi = p + 1; hipLaunchKernelGGL(mk_fwd, dim3(grid), dim3(NWAVES * 64), LDS_BYTES, stream, a); }
#else
    a.ph_lo = 0; a.ph_hi = N_PHASES;
    hipLaunchKernelGGL(mk_fwd, dim3(grid), dim3(NWAVES * 64), LDS_BYTES, stream, a);
#endif
    const hipError_t le = hipPeekAtLastError();
    if (le != hipSuccess) fprintf(stderr, "kernel_launch: launch failed: %s\n", hipGetErrorName(le));
}
```
